# Optimizing an MI355X kernel written in HIP

```python
import jax
import jax.numpy as jnp
from jax import lax
import numpy as np

D_MODEL = 2048
BATCH = 16
SEQ = 2048
DEPTH = 2

GRID_W = 64
CTX_LEN = 256
HEAD_DIM = 128
BRANCH_W = D_MODEL // 2
NA_HEADS = BRANCH_W // HEAD_DIM
GQA_HEADS = BRANCH_W // HEAD_DIM
GQA_KV_HEADS = GQA_HEADS // 4
KV_W = GQA_KV_HEADS * HEAD_DIM
CONV_K = 3
MLP_HIDDEN = 4 * D_MODEL
N_BRANCH = 3
WIN_R = 8
WIN_C = 16
Q_BLOCK = 128
ROPE_THETA = 10000.0
NORM_EPS = 1e-6
NEG_INF = -1e30
ATTN_SCALE = HEAD_DIM ** -0.5
DN_ALPHA = (2 * DEPTH) ** 0.25
DN_BETA = (8 * DEPTH) ** -0.25

QA0 = 0
QB0 = QA0 + BRANCH_W
KA0 = QB0 + BRANCH_W
VA0 = KA0 + BRANCH_W
KB0 = VA0 + BRANCH_W
VB0 = KB0 + KV_W
CB0 = VB0 + KV_W
CC0 = CB0 + BRANCH_W
CX0 = CC0 + BRANCH_W
G0 = CX0 + BRANCH_W
IN_W = G0 + N_BRANCH * D_MODEL

kernel_name = 'hybrid_na_gqa_shortconv_dit_block'


def layer_norm(x):
    xf = x.astype(jnp.float32)
    mu = jnp.mean(xf, axis=-1, keepdims=True)
    var = jnp.mean(jnp.square(xf - mu), axis=-1, keepdims=True)
    return ((xf - mu) * lax.rsqrt(var + NORM_EPS)).astype(x.dtype)


def modulate(x, shift, scale):
    return layer_norm(x) * (1.0 + scale) + shift


def rms_norm(x, gain):
    xf = x.astype(jnp.float32)
    y = xf * lax.rsqrt(jnp.mean(jnp.square(xf), axis=-1, keepdims=True) + NORM_EPS)
    return y.astype(x.dtype) * gain


def split_heads(z, n_heads):
    b, n, _ = z.shape
    return z.reshape(b, n, n_heads, HEAD_DIM).transpose(0, 2, 1, 3)


def merge_heads(o):
    b, h, n, d = o.shape
    return o.transpose(0, 2, 1, 3).reshape(b, n, h * d)


def axial_rope_angles(n_tokens):
    t = jnp.arange(n_tokens)
    row = (t // GRID_W).astype(jnp.float32)
    col = (t % GRID_W).astype(jnp.float32)
    axis_dim = HEAD_DIM // 2
    freqs = ROPE_THETA ** (-jnp.arange(0, axis_dim, 2, dtype=jnp.float32) / axis_dim)
    return row[:, None] * freqs, col[:, None] * freqs


def rotate(x, ang):
    half = x.shape[-1] // 2
    x1, x2 = x[..., :half], x[..., half:]
    cos = jnp.cos(ang).astype(x.dtype)
    sin = jnp.sin(ang).astype(x.dtype)
    return jnp.concatenate([x1 * cos - x2 * sin, x1 * sin + x2 * cos], axis=-1)


def apply_axial_rope(x, ang_row, ang_col):
    half = HEAD_DIM // 2
    return jnp.concatenate([rotate(x[..., :half], ang_row), rotate(x[..., half:], ang_col)], axis=-1)


def grouped_attention(q, k, v):
    b, hq, n, d = q.shape
    hkv = k.shape[1]
    qg = q.reshape(b, hkv, hq // hkv, n, d)
    s = jnp.einsum('bkgqd,bksd->bkgqs', qg, k).astype(jnp.float32) * ATTN_SCALE
    p = jax.nn.softmax(s, axis=-1).astype(v.dtype)
    return jnp.einsum('bkgqs,bksd->bkgqd', p, v).reshape(b, hq, n, d)


def blocked_latent_attention(q, k, v, k_ctx, v_ctx):
    b, hq, s_len, d = q.shape
    hkv = k.shape[1]
    g = hq // hkv
    nb = s_len // Q_BLOCK
    k_all = jnp.concatenate([k, k_ctx], axis=2)
    v_all = jnp.concatenate([v, v_ctx], axis=2)
    qb = q.reshape(b, hkv, g, nb, Q_BLOCK, d).transpose(3, 0, 1, 2, 4, 5)

    def one_block(q_blk):
        sc = jnp.einsum('bkgqd,bksd->bkgqs', q_blk, k_all).astype(jnp.float32) * ATTN_SCALE
        p = jax.nn.softmax(sc, axis=-1).astype(v_all.dtype)
        return jnp.einsum('bkgqs,bksd->bkgqd', p, v_all)

    o = lax.map(one_block, qb)
    return o.transpose(1, 2, 3, 0, 4, 5).reshape(b, hq, s_len, d)


def neighbourhood_attention(q, k, v, k_ctx, v_ctx, rpb):
    b, h, s_len, d = q.shape
    rows = s_len // GRID_W
    wr = min(WIN_R, rows)
    r = jnp.arange(rows)
    row_start = jnp.clip(r - wr // 2, 0, rows - wr)
    key_rows = row_start[:, None] + jnp.arange(wr)[None, :]
    col = jnp.arange(GRID_W)
    col_start = jnp.clip(col - WIN_C // 2, 0, GRID_W - WIN_C)
    in_win = (col[None, :] >= col_start[:, None]) & (col[None, :] < col_start[:, None] + WIN_C)
    dr_idx = key_rows - r[:, None] + WIN_R - 1
    dc_idx = jnp.clip(col[None, :] - col[:, None], -(WIN_C - 1), WIN_C - 1) + WIN_C - 1
    bias = rpb[:, dr_idx[:, None, :, None], dc_idx[None, :, None, :]].astype(jnp.float32)
    bias = jnp.where(in_win[None, None, :, None, :], bias, NEG_INF)
    qg = q.reshape(b, h, rows, GRID_W, d)
    kg = k.reshape(b, h, rows, GRID_W, d)[:, :, key_rows]
    vg = v.reshape(b, h, rows, GRID_W, d)[:, :, key_rows]
    s_loc = jnp.einsum('bhrqd,bhrwkd->bhrqwk', qg, kg).astype(jnp.float32) * ATTN_SCALE + bias[None]
    n_loc = wr * GRID_W
    s_loc = s_loc.reshape(b, h, rows, GRID_W, n_loc)
    s_ctx = jnp.einsum('bhrqd,bhld->bhrql', qg, k_ctx).astype(jnp.float32) * ATTN_SCALE
    p = jax.nn.softmax(jnp.concatenate([s_loc, s_ctx], axis=-1), axis=-1).astype(v.dtype)
    p_loc = p[..., :n_loc].reshape(b, h, rows, GRID_W, wr, GRID_W)
    o = (jnp.einsum('bhrqwk,bhrwkd->bhrqd', p_loc, vg)
         + jnp.einsum('bhrql,bhld->bhrqd', p[..., n_loc:], v_ctx))
    return o.reshape(b, h, s_len, d)


def short_conv(u, w):
    return lax.conv_general_dilated(
        u, w[:, None, :], window_strides=(1,), padding=[(CONV_K // 2, CONV_K // 2)],
        dimension_numbers=('NWC', 'WIO', 'NWC'), feature_group_count=u.shape[-1])


def conv_branch(z, conv_w):
    b_gate, c_gate, u = z[..., CB0:CC0], z[..., CC0:CX0], z[..., CX0:G0]
    return b_gate * short_conv(c_gate * u, conv_w)


def merge_branches(z, o_na, o_gqa, y_conv, w_branch, w_o):
    g = jax.nn.sigmoid(z[..., G0:].astype(jnp.float32)).astype(z.dtype)
    g_na, g_gqa, g_conv = jnp.split(g, N_BRANCH, axis=-1)
    m = (g_na * (merge_heads(o_na) @ w_branch[0])
         + g_gqa * (merge_heads(o_gqa) @ w_branch[1])
         + g_conv * (y_conv @ w_branch[2]))
    return m @ w_o


def squared_relu_mlp(h, w_up, w_down):
    return jnp.square(jax.nn.relu(h @ w_up)) @ w_down


def token_mixer(h, hc, w_in, w_branch, w_o, rpb, q_gain, k_gain, conv_w, ang_row, ang_col, with_ctx_out):
    z = h @ w_in
    if with_ctx_out:
        zc = hc @ w_in
        zc_kv = zc[..., KA0:CB0]
    else:
        zc_kv = hc @ w_in[:, KA0:CB0]
    ka_c = split_heads(zc_kv[..., :BRANCH_W], NA_HEADS)
    va_c = split_heads(zc_kv[..., BRANCH_W:2 * BRANCH_W], NA_HEADS)
    kb_c = rms_norm(split_heads(zc_kv[..., 2 * BRANCH_W:2 * BRANCH_W + KV_W], GQA_KV_HEADS), k_gain)
    vb_c = split_heads(zc_kv[..., 2 * BRANCH_W + KV_W:], GQA_KV_HEADS)
    o_na = neighbourhood_attention(
        split_heads(z[..., QA0:QB0], NA_HEADS), split_heads(z[..., KA0:VA0], NA_HEADS),
        split_heads(z[..., VA0:KB0], NA_HEADS), ka_c, va_c, rpb)
    qb = apply_axial_rope(rms_norm(split_heads(z[..., QB0:KA0], GQA_HEADS), q_gain), ang_row, ang_col)
    kb = apply_axial_rope(rms_norm(split_heads(z[..., KB0:VB0], GQA_KV_HEADS), k_gain), ang_row, ang_col)
    o_gqa = blocked_latent_attention(qb, kb, split_heads(z[..., VB0:CB0], GQA_KV_HEADS), kb_c, vb_c)
    out = merge_branches(z, o_na, o_gqa, conv_branch(z, conv_w), w_branch, w_o)
    if not with_ctx_out:
        return out, None
    o_na_c = grouped_attention(split_heads(zc[..., QA0:QB0], NA_HEADS), ka_c, va_c)
    qb_c = rms_norm(split_heads(zc[..., QB0:KA0], GQA_HEADS), q_gain)
    o_gqa_c = grouped_attention(qb_c, kb_c, vb_c)
    out_c = merge_branches(zc, o_na_c, o_gqa_c, conv_branch(zc, conv_w), w_branch, w_o)
    return out, out_c


def setup_inputs(seed: int = 0) -> dict:
    key = jax.random.key(seed)
    ks = jax.random.split(key, 17)

    def nrm(k, shape, s):
        return jax.random.normal(k, shape, jnp.float32) * s

    return {
        'x': nrm(ks[0], (BATCH, SEQ, D_MODEL), 1.0),
        'c': nrm(ks[1], (BATCH, D_MODEL), 1.0),
        'ctx': nrm(ks[2], (BATCH, CTX_LEN, D_MODEL), 1.0),
        'c_ctx': nrm(ks[3], (D_MODEL,), 1.0),
        'w_mod': nrm(ks[4], (DEPTH, D_MODEL, 6 * D_MODEL), 0.5 * D_MODEL ** -0.5),
        'b_mod': nrm(ks[5], (DEPTH, 6 * D_MODEL), 0.02),
        'w_in': nrm(ks[6], (DEPTH, D_MODEL, IN_W), D_MODEL ** -0.5),
        'rpb': nrm(ks[7], (DEPTH, NA_HEADS, 2 * WIN_R - 1, 2 * WIN_C - 1), 0.1),
        'q_gain': 1.0 + nrm(ks[8], (DEPTH, HEAD_DIM), 0.02),
        'k_gain': 1.0 + nrm(ks[9], (DEPTH, HEAD_DIM), 0.02),
        'conv_w': nrm(ks[10], (DEPTH, CONV_K, BRANCH_W), CONV_K ** -0.5),
        'w_branch': nrm(ks[11], (DEPTH, N_BRANCH, BRANCH_W, D_MODEL), DN_BETA * BRANCH_W ** -0.5),
        'w_o': nrm(ks[12], (DEPTH, D_MODEL, D_MODEL), DN_BETA * D_MODEL ** -0.5),
        'w_up': nrm(ks[13], (DEPTH, D_MODEL, MLP_HIDDEN), D_MODEL ** -0.5),
        'w_down': nrm(ks[14], (DEPTH, MLP_HIDDEN, D_MODEL), DN_BETA * MLP_HIDDEN ** -0.5),
        'ln_g': 1.0 + nrm(ks[15], (DEPTH, 2, D_MODEL), 0.02),
        'ln_b': nrm(ks[16], (DEPTH, 2, D_MODEL), 0.02),
    }


def reference(x, c, ctx, c_ctx, w_mod, b_mod, w_in, rpb, q_gain, k_gain, conv_w,
              w_branch, w_o, w_up, w_down, ln_g, ln_b):
    ang_row, ang_col = axial_rope_angles(x.shape[1])
    c_act = jax.nn.silu(c)
    cc_act = jax.nn.silu(c_ctx)
    for l in range(DEPTH):
        with_ctx_out = l < DEPTH - 1
        mod = jnp.split((c_act @ w_mod[l] + b_mod[l])[:, None, :], 6, axis=-1)
        mod_c = jnp.split(cc_act @ w_mod[l] + b_mod[l], 6, axis=-1)
        h = modulate(x, mod[0], mod[1])
        hc = modulate(ctx, mod_c[0], mod_c[1])
        mix, mix_c = token_mixer(h, hc, w_in[l], w_branch[l], w_o[l], rpb[l], q_gain[l], k_gain[l],
                                 conv_w[l], ang_row, ang_col, with_ctx_out)
        x = layer_norm(DN_ALPHA * x + mod[2] * mix) * ln_g[l, 0] + ln_b[l, 0]
        h = modulate(x, mod[3], mod[4])
        x = layer_norm(DN_ALPHA * x + mod[5] * squared_relu_mlp(h, w_up[l], w_down[l])) * ln_g[l, 1] + ln_b[l, 1]
        if with_ctx_out:
            ctx = layer_norm(DN_ALPHA * ctx + mod_c[2] * mix_c) * ln_g[l, 0] + ln_b[l, 0]
            hc = modulate(ctx, mod_c[3], mod_c[4])
            ctx = layer_norm(DN_ALPHA * ctx + mod_c[5] * squared_relu_mlp(hc, w_up[l], w_down[l])) * ln_g[l, 1] + ln_b[l, 1]
    return x
```

```cpp
#include <hip/hip_runtime.h>
#include <cstdio>
#include <cstdint>
#include <cmath>

#define LAS __attribute__((address_space(3)))
#define GAS __attribute__((address_space(1)))
typedef unsigned short bf16_t;
typedef short bf16x8 __attribute__((ext_vector_type(8)));
typedef short s16x4 __attribute__((ext_vector_type(4)));
typedef float f32x4 __attribute__((ext_vector_type(4)));
typedef float f32x2 __attribute__((ext_vector_type(2)));
typedef float f32x16 __attribute__((ext_vector_type(16)));
typedef unsigned u32x4 __attribute__((ext_vector_type(4)));
typedef unsigned u32x2 __attribute__((ext_vector_type(2)));

#ifndef MK_PER_PHASE
#define MK_PER_PHASE 0
#endif

constexpr int DM = 2048, NB = 16, SEQ = 2048, CTXL = 256, HD = 128, HID = 8192, DEPTH = 2;
constexpr int QA0 = 0, QB0 = 1024, KA0 = 2048, VA0 = 3072, KB0 = 4096, VB0 = 4352, CB0 = 4608, CC0 = 5632, CX0 = 6656, G0 = 7680, INW = 13824;
constexpr int NLAT = NB * SEQ, NCTX = NB * CTXL, MALL = NLAT + NCTX;
constexpr int CHROWS = 16384, PAN_CH = 64, PAN_LAT = 128, PAN_CTX = 16;
constexpr float LN_EPS = 1e-6f, DN_ALPHA = 1.4142135623730951f, ATT_SCALE = 0.08838834764831845f;
constexpr int MODW = 6 * DM;

constexpr size_t MiB = 1u << 20;
constexpr size_t WS_CTL = 0, CTL_ZERO_BYTES = 1 * MiB;
constexpr size_t WS_MOD = 1 * MiB;
constexpr size_t WS_ROPE = 3 * MiB;
constexpr size_t WS_W = 4 * MiB;
constexpr size_t W_IN = 0, W_BR = 54 * MiB, W_O = 66 * MiB, W_UP = 74 * MiB, W_DN = 106 * MiB, W_LAYER = 138 * MiB;
constexpr size_t WS_CTXS = 280 * MiB;
constexpr size_t WS_H = 312 * MiB;
constexpr size_t WS_ZC = 456 * MiB;
constexpr size_t WS_Z = 564 * MiB;
constexpr size_t WS_END = 996 * MiB;
static_assert(WS_W + 2 * W_LAYER <= WS_CTXS && WS_H + (size_t)MALL * DM * 2 <= WS_ZC && WS_ZC + (size_t)NCTX * INW * 2 <= WS_Z && WS_Z + (size_t)CHROWS * INW * 2 <= WS_END, "ws map");
static_assert((size_t)(CHROWS + NCTX) * HID * 2 <= WS_END - WS_Z, "U overlay");
constexpr int CW_TMO = 0, CW_BAR = 4096;

constexpr int RING_BYTES = 131072;
constexpr int SCR_BYTES = 139264;
constexpr int LDSCTL_OFF = SCR_BYTES, MISC_OFF = LDSCTL_OFF + 64;
constexpr int LDS_BYTES = 147456;

#define RLX_AGENT __ATOMIC_RELAXED, __HIP_MEMORY_SCOPE_AGENT
#define LDS_WAIT() asm volatile("s_waitcnt lgkmcnt(0)" ::: "memory")
#define VM_WAIT() asm volatile("s_waitcnt vmcnt(0)" ::: "memory")
__device__ __forceinline__ unsigned cvt_pk_bf16(float lo, float hi) { unsigned r; asm volatile("v_cvt_pk_bf16_f32 %0, %1, %2" : "=v"(r) : "v"(lo), "v"(hi)); return r; }
__device__ __forceinline__ float bflo(unsigned w) { return __uint_as_float(w << 16); }
__device__ __forceinline__ float bfhi(unsigned w) { return __uint_as_float(w & 0xffff0000u); }
__device__ __forceinline__ int lane_id_opaque() { int l; asm volatile("v_mbcnt_lo_u32_b32 %0, -1, 0\n\tv_mbcnt_hi_u32_b32 %0, -1, %0" : "=v"(l)); return l; }
__device__ __forceinline__ float shfl_xor_l(float v, int mask, int lane) { return __uint_as_float((unsigned)__builtin_amdgcn_ds_bpermute((lane ^ mask) << 2, (int)__float_as_uint(v))); }
__device__ __forceinline__ float wave_sum(float v, int lane) {
#pragma unroll
    for (int o = 1; o < 64; o <<= 1) v += shfl_xor_l(v, o, lane);
    return v;
}

#define XB_TMO      128
#define XB_XCNT(j)  (256  + 64 * (j))
#define XB_XSUB(j)  (1280 + 64 * (j))
#define XB_XGEN(j)  (2304 + 64 * (j))
#define XB_TOP      3328
#define XB_TOPGEN   3392
#define XCD_BAR_WORDS 3456
#define XB_SPIN_CAP (1u << 20)
__device__ __forceinline__ unsigned xb_ld(unsigned* p)              { return __hip_atomic_load(p, __ATOMIC_RELAXED, __HIP_MEMORY_SCOPE_AGENT); }
__device__ __forceinline__ unsigned xb_add(unsigned* p, unsigned v) { return __hip_atomic_fetch_add(p, v, __ATOMIC_RELAXED, __HIP_MEMORY_SCOPE_AGENT); }
__device__ __forceinline__ unsigned xb_xcc_id() { return (unsigned)__builtin_amdgcn_s_getreg((3 << 11) | 20) & 0xFu; }
#define XB_SPIN(cond, bar) do { unsigned _sp = 0; while (cond) { __builtin_amdgcn_s_sleep(1); \
    if ((++_sp & 255u) == 0u) { if (xb_ld(&(bar)[XB_TMO])) break; if (_sp > XB_SPIN_CAP) { atomicAdd(&(bar)[XB_TMO], 1u); break; } } } } while (0)
struct XcdBarrier { unsigned* bar; unsigned x; volatile LAS unsigned* st; };
__device__ __forceinline__ XcdBarrier xcd_barrier_post(unsigned* bar, volatile LAS unsigned* st) {
    XcdBarrier b; b.bar = bar; b.x = xb_xcc_id(); b.st = st;
    if (threadIdx.x == 0) (void)xb_add(&bar[XB_XCNT(b.x)], 1u);
    return b;
}
__device__ __forceinline__ void xcd_barrier_complete(unsigned* bar, unsigned x, unsigned& nloc, unsigned& nx) {
    const unsigned G = gridDim.x * gridDim.y * gridDim.z;
    unsigned sum, cnt, mine, sp = 0u;
    for (;;) {
        sum = 0u; cnt = 0u; mine = 0u;
#pragma unroll
        for (unsigned j = 0; j < 16; ++j) { const unsigned c = xb_ld(&bar[XB_XCNT(j)]); sum += c; cnt += (c > 0u) ? 1u : 0u; mine = (j == x) ? c : mine; }
        if (sum == G) break;
        __builtin_amdgcn_s_sleep(1);
        if ((++sp & 255u) == 0u) { if (xb_ld(&bar[XB_TMO])) break; if (sp > XB_SPIN_CAP) { atomicAdd(&bar[XB_TMO], 1u); break; } }
    }
    nloc = mine > 0u ? mine : 1u; nx = cnt > 0u ? cnt : 1u;
}
__device__ __forceinline__ void xcd_barrier(const XcdBarrier& b, const bool leader) {
    asm volatile("s_waitcnt vmcnt(0)" ::: "memory");
    __syncthreads();
    if (leader) {
        unsigned* bar = b.bar;
        __builtin_amdgcn_s_waitcnt(0);
        unsigned nloc = b.st[0], nx = b.st[1];
        if (nloc == 0u) { xcd_barrier_complete(bar, b.x, nloc, nx); b.st[0] = nloc; b.st[1] = nx; }
        const unsigned old = xb_add(&bar[XB_XSUB(b.x)], 1u);
        const unsigned gen = old / nloc;
        if (old + 1u == (gen + 1u) * nloc) {
            __builtin_amdgcn_fence(__ATOMIC_RELEASE, "agent");
            asm volatile("s_waitcnt vmcnt(0)" ::: "memory");
            const unsigned og = xb_add(&bar[XB_TOP], 1u);
            const unsigned tg = og / nx;
            if (og + 1u == (tg + 1u) * nx) xb_add(&bar[XB_TOPGEN], 1u);
            else XB_SPIN(xb_ld(&bar[XB_TOPGEN]) == tg, bar);
            __builtin_amdgcn_fence(__ATOMIC_ACQUIRE, "agent");
            xb_add(&bar[XB_XGEN(b.x)], 1u);
            asm volatile("s_waitcnt vmcnt(0)" ::: "memory");
        } else {
            XB_SPIN(xb_ld(&bar[XB_XGEN(b.x)]) == gen, bar);
            __builtin_amdgcn_fence(__ATOMIC_ACQUIRE, "agent");
            asm volatile("s_waitcnt vmcnt(0)" ::: "memory");
        }
    }
    __syncthreads();
}

namespace pg8 {
constexpr int BM = 256, BK = 64, HALF = 128, HTB = HALF * BK * 2, STAGE_BYTES = 8 * HTB;
__host__ __device__ __forceinline__ int lds_byte(int r, int c) { const int st = (r >> 4) * 2 + (c >> 5), rr = r & 15, cc = c & 31, ob = rr * 64 + cc * 2; return st * 1024 + (ob ^ (((ob >> 9) & 1) << 5)); }
__host__ __device__ __forceinline__ void stage_rc(int b, int& R, int& C) { const int st = b / 1024, sb = b % 1024, swz = sb ^ (((sb >> 9) & 1) << 5); R = (st >> 1) * 16 + swz / 64; C = (st & 1) * 32 + (swz % 64) / 2; }
__host__ __device__ __forceinline__ int perm32(int rho) { const int n = rho >> 4, i = rho & 15; return 8 * (i >> 2) + 4 * n + (i & 3); }
struct Unit { int pm, pn, seg; };
__device__ __forceinline__ void tile_map(int L, int nwg, int nM, int nN, int& pm, int& pn) {
    const int q = nwg / 8, r = nwg % 8, xcd = L % 8, off = L / 8;
    const int wgid = (xcd < r ? xcd * (q + 1) : r * (q + 1) + (xcd - r) * q) + off;
    const int nig = 8 * nN, gid = wgid / nig, fm = gid * 8, gsz = (nM - fm) < 8 ? (nM - fm) : 8;
    pm = fm + ((wgid % nig) % gsz); pn = (wgid % nig) / gsz;
}

template <class P>
__device__ __forceinline__ void gemm_phase(LAS unsigned char* lds, const P& p, const int tid) {
    const int wid = __builtin_amdgcn_readfirstlane(tid >> 6), lane = tid & 63, wr = wid >> 2, wc = wid & 3, fr = lane & 15, fq = lane >> 4;
    constexpr int nt = P::NT;
    unsigned voffA[2], voffB[2];
#pragma unroll
    for (int i = 0; i < 2; ++i) { int R, C; stage_rc(tid * 16 + i * 8192, R, C); const int Rb = P::PERM ? ((R & ~31) + perm32(R & 31)) : R;
        voffA[i] = (unsigned)(R * p.lda + C) * 2u; voffB[i] = (unsigned)(Rb * p.ldb + C) * 2u; }
    const size_t kstep = (size_t)(BK * 2);
    const size_t hstepA = (size_t)HALF * p.lda * 2, hstepB = (size_t)HALF * p.ldb * 2;
    const unsigned ldsw = (unsigned)wid * 1024u;
    const int aoff = lds_byte(wr * 64 + fr, fq * 8), boff = lds_byte(wc * 32 + fr, fq * 8);
#define PG8_SA(b, h) (((b) * 2 + (h)) * HTB)
#define PG8_SB(b, h) ((4 + (b) * 2 + (h)) * HTB)
#define PG8_STAGE(bufoff, gbase, voff) do { _Pragma("unroll") for (int _i = 0; _i < 2; ++_i) \
        __builtin_amdgcn_global_load_lds((const unsigned*)((const char*)(gbase) + (voff)[_i]), (LAS unsigned*)(lds + (bufoff) + ldsw + _i * 8192), 16, 0, 0); } while (0)
#define PG8_LDA(dst, b, h) do { _Pragma("unroll") for (int m = 0; m < 4; ++m) _Pragma("unroll") for (int k = 0; k < 2; ++k) dst[m][k] = *(const LAS bf16x8*)(lds + PG8_SA(b, h) + aoff + m * 2048 + k * 1024); } while (0)
#define PG8_LDB(dst, b, h) do { _Pragma("unroll") for (int n = 0; n < 2; ++n) _Pragma("unroll") for (int k = 0; k < 2; ++k) dst[n][k] = *(const LAS bf16x8*)(lds + PG8_SB(b, h) + boff + n * 2048 + k * 1024); } while (0)
#define PG8_MMA(ai, bj, At, Bt) do { __builtin_amdgcn_s_setprio(1); _Pragma("unroll") for (int m = 0; m < 4; ++m) _Pragma("unroll") for (int n = 0; n < 2; ++n) _Pragma("unroll") for (int k = 0; k < 2; ++k) \
        acc[ai][bj][m][n] = __builtin_amdgcn_mfma_f32_16x16x32_bf16(Bt[n][k], At[m][k], acc[ai][bj][m][n], 0, 0, 0); __builtin_amdgcn_s_setprio(0); } while (0)
#define PG8_WAIT_V(n) asm volatile("s_waitcnt vmcnt(" #n ")" ::: "memory")
#define PG8_WAIT_L(n) asm volatile("s_waitcnt lgkmcnt(" #n ")" ::: "memory")
#define PG8_BAR __builtin_amdgcn_s_barrier()
#define PG8_SCHED __builtin_amdgcn_sched_barrier(0)
    Unit cur, nxt; int ui = 0;
    if (!p.next(0, cur)) return;
    f32x4 acc[2][2][4][2];
#pragma unroll
    for (int a = 0; a < 2; ++a)
#pragma unroll
        for (int b = 0; b < 2; ++b)
#pragma unroll
            for (int m = 0; m < 4; ++m)
#pragma unroll
                for (int n = 0; n < 2; ++n) acc[a][b][m][n] = (f32x4){0.f, 0.f, 0.f, 0.f};
    bf16x8 At[4][2], B0[2][2], B1[2][2];
    const char* cA = p.a_ptr(cur); const char* cB = p.b_ptr(cur);
    PG8_STAGE(PG8_SB(0, 0), cB, voffB); PG8_STAGE(PG8_SB(0, 1), cB + hstepB, voffB); PG8_STAGE(PG8_SA(0, 0), cA, voffA); PG8_STAGE(PG8_SA(0, 1), cA + hstepA, voffA);
    if (wr == 1) PG8_BAR;
    PG8_WAIT_V(2); PG8_BAR;
    PG8_STAGE(PG8_SB(1, 0), cB + kstep, voffB); PG8_STAGE(PG8_SA(1, 0), cA + kstep, voffA); PG8_STAGE(PG8_SB(1, 1), cB + hstepB + kstep, voffB);
    PG8_WAIT_V(6); PG8_BAR;
    for (;;) {
        const bool has_next = p.next(ui + 1, nxt);
        const char* nA = has_next ? p.a_ptr(nxt) : cA; const char* nB = has_next ? p.b_ptr(nxt) : cB;
        for (int t = 0; t < nt; t += 2) {
            const bool last = (t == nt - 2);
            const char* a1 = cA + (size_t)(t + 1) * kstep;
            const char* a2 = last ? nA : cA + (size_t)(t + 2) * kstep; const char* b2 = last ? nB : cB + (size_t)(t + 2) * kstep;
            const char* a3 = a2 + kstep; const char* b3 = b2 + kstep;
            PG8_LDB(B0, 0, 0); PG8_LDB(B1, 0, 1); PG8_SCHED; PG8_LDA(At, 0, 0); PG8_STAGE(PG8_SA(1, 1), a1 + hstepA, voffA);
            PG8_WAIT_V(8); PG8_WAIT_L(0); PG8_BAR; PG8_MMA(0, 0, At, B0); PG8_MMA(0, 1, At, B1); PG8_BAR; PG8_SCHED;
            PG8_LDA(At, 0, 1); PG8_STAGE(PG8_SB(0, 0), b2, voffB); PG8_STAGE(PG8_SB(0, 1), b2 + hstepB, voffB); PG8_STAGE(PG8_SA(0, 0), a2, voffA);
            PG8_WAIT_V(8); PG8_WAIT_L(0); PG8_BAR; PG8_MMA(1, 0, At, B0); PG8_MMA(1, 1, At, B1); PG8_BAR; PG8_SCHED;
            PG8_LDB(B0, 1, 0); PG8_LDB(B1, 1, 1); PG8_SCHED; PG8_LDA(At, 1, 0); PG8_STAGE(PG8_SA(0, 1), a2 + hstepA, voffA);
            PG8_WAIT_V(8); PG8_WAIT_L(0); PG8_BAR; PG8_MMA(0, 0, At, B0); PG8_MMA(0, 1, At, B1); PG8_BAR; PG8_SCHED;
            PG8_LDA(At, 1, 1); PG8_STAGE(PG8_SB(1, 0), b3, voffB); PG8_STAGE(PG8_SB(1, 1), b3 + hstepB, voffB); PG8_STAGE(PG8_SA(1, 0), a3, voffA);
            PG8_WAIT_V(8); PG8_WAIT_L(0); PG8_BAR; PG8_MMA(1, 0, At, B0); PG8_MMA(1, 1, At, B1); PG8_BAR; PG8_SCHED;
        }
        if (wr == 0) PG8_BAR;
        p.epi(acc, cur, wr, wc, fr, fq);
        if (!has_next) break;
        if (!p.keep(cur)) {
#pragma unroll
            for (int a = 0; a < 2; ++a)
#pragma unroll
                for (int b = 0; b < 2; ++b)
#pragma unroll
                    for (int m = 0; m < 4; ++m)
#pragma unroll
                        for (int n = 0; n < 2; ++n) acc[a][b][m][n] = (f32x4){0.f, 0.f, 0.f, 0.f};
        }
        cur = nxt; cA = nA; cB = nB; ++ui;
        if (wr == 1) PG8_BAR;
    }
    PG8_WAIT_V(0);
    PG8_BAR;
#undef PG8_SA
#undef PG8_SB
#undef PG8_STAGE
#undef PG8_LDA
#undef PG8_LDB
#undef PG8_MMA
#undef PG8_WAIT_V
#undef PG8_WAIT_L
#undef PG8_BAR
#undef PG8_SCHED
}
}
using pg8::Unit;

struct TwoPart {
    int lat0, nNa, nMb, nNb, pn0b, G, c;
    __device__ __forceinline__ bool map(int L, Unit& u) const {
        const int nA = PAN_CH * nNa, nB = nMb * nNb; int pm, pn;
        if (L < nA) { pg8::tile_map(L, nA, PAN_CH, nNa, pm, pn); u.pm = lat0 + pm; u.pn = pn; return true; }
        if (L < nA + nB) { pg8::tile_map(L - nA, nB, nMb, nNb, pm, pn); u.pm = PAN_LAT + pm; u.pn = pn0b + pn; return true; }
        return false;
    }
};
__device__ __forceinline__ float sigmoid_c(float x) { x = fminf(fmaxf(x, -30.f), 30.f); return __builtin_amdgcn_rcpf(1.f + __builtin_amdgcn_exp2f(-1.4426950408889634f * x)); }

struct GInProj {
    static constexpr int NT = DM / 64; static constexpr bool PERM = true;
    const bf16_t* H; const bf16_t* W; bf16_t* Z; bf16_t* ZC; TwoPart tp; int lda, ldb;
    __device__ __forceinline__ bool next(int i, Unit& u) const { u.seg = 0; return tp.map(i * tp.G + tp.c, u); }
    __device__ __forceinline__ const char* a_ptr(const Unit& u) const { return (const char*)(H + (size_t)u.pm * 256 * DM); }
    __device__ __forceinline__ const char* b_ptr(const Unit& u) const { return (const char*)(W + (size_t)u.pn * 256 * DM); }
    __device__ __forceinline__ bool keep(const Unit&) const { return false; }
    __device__ __forceinline__ void epi(const f32x4 (&acc)[2][2][4][2], const Unit& u, int wr, int wc, int fr, int fq) const {
        bf16_t* base = (u.pm < PAN_LAT) ? Z + (size_t)(u.pm - tp.lat0) * 256 * INW : ZC + (size_t)(u.pm - PAN_LAT) * 256 * INW;
        const int row0 = wr * 64 + fr, col0 = u.pn * 256 + wc * 32 + 8 * fq; const bool gate = u.pn >= G0 / 256;
#pragma unroll
        for (int ai = 0; ai < 2; ++ai)
#pragma unroll
            for (int m = 0; m < 4; ++m) { bf16_t* rowp = base + (size_t)(row0 + ai * 128 + m * 16) * INW + col0;
#pragma unroll
                for (int bj = 0; bj < 2; ++bj) { f32x4 v0 = acc[ai][bj][m][0], v1 = acc[ai][bj][m][1];
                    if (gate) { v0 = (f32x4){sigmoid_c(v0[0]), sigmoid_c(v0[1]), sigmoid_c(v0[2]), sigmoid_c(v0[3])}; v1 = (f32x4){sigmoid_c(v1[0]), sigmoid_c(v1[1]), sigmoid_c(v1[2]), sigmoid_c(v1[3])}; }
                    u32x4 w; w.x = cvt_pk_bf16(v0[0], v0[1]); w.y = cvt_pk_bf16(v0[2], v0[3]); w.z = cvt_pk_bf16(v1[0], v1[1]); w.w = cvt_pk_bf16(v1[2], v1[3]);
                    *(u32x4*)(rowp + bj * 128) = w; } }
    }
};

struct GBranch {
    static constexpr int NT = 1024 / 64; static constexpr bool PERM = true;
    const bf16_t* Z; const bf16_t* ZC; const bf16_t* W; bf16_t* Hout; TwoPart tp; int lda, ldb;
    __device__ __forceinline__ bool next(int i, Unit& u) const { const int t = i / 3; u.seg = i - 3 * t; return tp.map(t * tp.G + tp.c, u); }
    __device__ __forceinline__ const bf16_t* zrow(const Unit& u) const { return (u.pm < PAN_LAT) ? Z + (size_t)(u.pm - tp.lat0) * 256 * INW : ZC + (size_t)(u.pm - PAN_LAT) * 256 * INW; }
    __device__ __forceinline__ const char* a_ptr(const Unit& u) const { return (const char*)(zrow(u) + (u.seg == 0 ? QA0 : (u.seg == 1 ? QB0 : CB0))); }
    __device__ __forceinline__ const char* b_ptr(const Unit& u) const { return (const char*)(W + (size_t)u.pn * 256 * 3072 + u.seg * 1024); }
    __device__ __forceinline__ bool keep(const Unit& u) const { return u.seg < 2; }
    __device__ __forceinline__ void epi(f32x4 (&acc)[2][2][4][2], const Unit& u, int wr, int wc, int fr, int fq) const {
        const bf16_t* zb = zrow(u) + G0; const int row0 = wr * 64 + fr, col0 = u.pn * 256 + wc * 32 + 8 * fq;
        const int seg = u.seg;
#pragma unroll
        for (int ai = 0; ai < 2; ++ai)
#pragma unroll
            for (int m = 0; m < 4; ++m) { const bf16_t* zr = zb + (size_t)(row0 + ai * 128 + m * 16) * INW + col0;
                if (seg < 2) {
#pragma unroll
                    for (int bj = 0; bj < 2; ++bj) { const u32x4 gp = *(const u32x4*)(zr + seg * 2048 + bj * 128), gn = *(const u32x4*)(zr + (seg + 1) * 2048 + bj * 128);
                        f32x4 r0, r1;
                        r0[0] = bflo(gp.x) * __builtin_amdgcn_rcpf(bflo(gn.x)); r0[1] = bfhi(gp.x) * __builtin_amdgcn_rcpf(bfhi(gn.x));
                        r0[2] = bflo(gp.y) * __builtin_amdgcn_rcpf(bflo(gn.y)); r0[3] = bfhi(gp.y) * __builtin_amdgcn_rcpf(bfhi(gn.y));
                        r1[0] = bflo(gp.z) * __builtin_amdgcn_rcpf(bflo(gn.z)); r1[1] = bfhi(gp.z) * __builtin_amdgcn_rcpf(bfhi(gn.z));
                        r1[2] = bflo(gp.w) * __builtin_amdgcn_rcpf(bflo(gn.w)); r1[3] = bfhi(gp.w) * __builtin_amdgcn_rcpf(bfhi(gn.w));
                        acc[ai][bj][m][0] *= r0; acc[ai][bj][m][1] *= r1; }
                } else {
                    bf16_t* orow = Hout + (size_t)(u.pm * 256 + row0 + ai * 128 + m * 16) * DM + col0;
#pragma unroll
                    for (int bj = 0; bj < 2; ++bj) { const u32x4 g = *(const u32x4*)(zr + 2 * 2048 + bj * 128);
                        const f32x4 v0 = acc[ai][bj][m][0] * (f32x4){bflo(g.x), bfhi(g.x), bflo(g.y), bfhi(g.y)}, v1 = acc[ai][bj][m][1] * (f32x4){bflo(g.z), bfhi(g.z), bflo(g.w), bfhi(g.w)};
                        u32x4 w; w.x = cvt_pk_bf16(v0[0], v0[1]); w.y = cvt_pk_bf16(v0[2], v0[3]); w.z = cvt_pk_bf16(v1[0], v1[1]); w.w = cvt_pk_bf16(v1[2], v1[3]);
                        *(u32x4*)(orow + bj * 128) = w; }
                }
                asm volatile("" ::: "memory"); }
    }
};

__device__ __forceinline__ void epi_residual(const f32x4 (&acc)[2][2][4][2], const float* res, float* out, const float* modv, int pn, int wr, int wc, int fr, int fq) {
    const int row0 = wr * 64 + fr, col0 = pn * 256 + wc * 32 + 4 * fq;
    f32x4 gv[2][2];
#pragma unroll
    for (int bj = 0; bj < 2; ++bj)
#pragma unroll
        for (int n = 0; n < 2; ++n) gv[bj][n] = *(const f32x4*)(modv + col0 + bj * 128 + n * 16);
#pragma unroll
    for (int ai = 0; ai < 2; ++ai)
#pragma unroll
        for (int m = 0; m < 4; ++m) { const size_t off = (size_t)(row0 + ai * 128 + m * 16) * DM + col0;
#pragma unroll
            for (int bj = 0; bj < 2; ++bj)
#pragma unroll
                for (int n = 0; n < 2; ++n) { const f32x4 r = *(const f32x4*)(res + off + bj * 128 + n * 16);
                    *(f32x4*)(out + off + bj * 128 + n * 16) = r * DN_ALPHA + gv[bj][n] * acc[ai][bj][m][n]; }
            asm volatile("" ::: "memory"); }
}
struct GRes {
    static constexpr bool PERM = false;
    const bf16_t* A_lat; const bf16_t* A_ctx;
    int a_lat0; const bf16_t* W; const float* res_lat; const float* res_ctx; float* out_lat; float* out_ctx; const float* mod; int modj; TwoPart tp; int lda, ldb;
    __device__ __forceinline__ bool nextu(int i, Unit& u) const { u.seg = 0; return tp.map(i * tp.G + tp.c, u); }
    __device__ __forceinline__ const char* a_ptr(const Unit& u) const { return (const char*)((u.pm < PAN_LAT) ? A_lat + (size_t)(u.pm - a_lat0) * 256 * lda : A_ctx + (size_t)(u.pm - PAN_LAT) * 256 * lda); }
    __device__ __forceinline__ const char* b_ptr(const Unit& u) const { return (const char*)(W + (size_t)u.pn * 256 * ldb); }
    __device__ __forceinline__ bool keep(const Unit&) const { return false; }
    __device__ __forceinline__ void epi(const f32x4 (&acc)[2][2][4][2], const Unit& u, int wr, int wc, int fr, int fq) const {
        if (u.pm < PAN_LAT) epi_residual(acc, res_lat + (size_t)u.pm * 256 * DM, out_lat + (size_t)u.pm * 256 * DM, mod + (size_t)(u.pm >> 3) * MODW + modj * DM, u.pn, wr, wc, fr, fq);
        else epi_residual(acc, res_ctx + (size_t)(u.pm - PAN_LAT) * 256 * DM, out_ctx + (size_t)(u.pm - PAN_LAT) * 256 * DM, mod + (size_t)16 * MODW + modj * DM, u.pn, wr, wc, fr, fq);
    }
};
struct GWo : GRes { static constexpr int NT = DM / 64; __device__ __forceinline__ bool next(int i, Unit& u) const { return nextu(i, u); } };
struct GDown : GRes { static constexpr int NT = HID / 64; __device__ __forceinline__ bool next(int i, Unit& u) const { return nextu(i, u); } };

struct GUp {
    static constexpr int NT = DM / 64; static constexpr bool PERM = true;
    const bf16_t* H; const bf16_t* W; bf16_t* U; TwoPart tp; int lda, ldb;
    __device__ __forceinline__ bool next(int i, Unit& u) const { u.seg = 0; return tp.map(i * tp.G + tp.c, u); }
    __device__ __forceinline__ const char* a_ptr(const Unit& u) const { return (const char*)(H + (size_t)u.pm * 256 * DM); }
    __device__ __forceinline__ const char* b_ptr(const Unit& u) const { return (const char*)(W + (size_t)u.pn * 256 * DM); }
    __device__ __forceinline__ bool keep(const Unit&) const { return false; }
    __device__ __forceinline__ void epi(const f32x4 (&acc)[2][2][4][2], const Unit& u, int wr, int wc, int fr, int fq) const {
        bf16_t* base = U + (size_t)((u.pm < PAN_LAT) ? (u.pm - tp.lat0) : (PAN_CH + u.pm - PAN_LAT)) * 256 * HID;
        const int row0 = wr * 64 + fr, col0 = u.pn * 256 + wc * 32 + 8 * fq;
#pragma unroll
        for (int ai = 0; ai < 2; ++ai)
#pragma unroll
            for (int m = 0; m < 4; ++m) { bf16_t* rowp = base + (size_t)(row0 + ai * 128 + m * 16) * HID + col0;
#pragma unroll
                for (int bj = 0; bj < 2; ++bj) { f32x4 v0 = acc[ai][bj][m][0], v1 = acc[ai][bj][m][1];
                    v0 = __builtin_elementwise_max(v0, (f32x4){0.f, 0.f, 0.f, 0.f}); v1 = __builtin_elementwise_max(v1, (f32x4){0.f, 0.f, 0.f, 0.f}); v0 = v0 * v0; v1 = v1 * v1;
                    u32x4 w; w.x = cvt_pk_bf16(v0[0], v0[1]); w.y = cvt_pk_bf16(v0[2], v0[3]); w.z = cvt_pk_bf16(v1[0], v1[1]); w.w = cvt_pk_bf16(v1[2], v1[3]);
                    *(u32x4*)(rowp + bj * 128) = w; } }
    }
};

namespace att {
constexpr int NW = 8, QBLK = 32, KVBLK = 64, LDZ = INW;
constexpr float SCALE = ATT_SCALE, THR = 8.f, NEG = -1e30f;
constexpr int SHM_V = 16384, SHM_K = 16384, OFF_WS = 65536, OFF_TAB = OFF_WS + 2048, LDS_ATTN = OFF_TAB + 15 * 512;
static_assert(LDS_ATTN <= SCR_BYTES, "attention LDS");
struct AUnit { const bf16_t* Q; const bf16_t* P0; const bf16_t* P1; int nfirst, NT, vofs; int r0, lo; const float* rpb; };
#define KSWZ(row, colB) ((row) * 256 + ((colB) ^ (((row) & 7) << 4)))
#define SBAR() __builtin_amdgcn_sched_barrier(0)
__device__ __forceinline__ int crow(int r, int hi) { return (r & 3) + 8 * (r >> 2) + 4 * hi; }
__device__ __forceinline__ void partialSM(f32x16& p0, f32x16& p1, float& m_reg, float& mn, float& alpha) {
  constexpr float C = SCALE * 1.4426950408889634f;
  float pmax = p0[0];
#pragma unroll
  for (int r = 1; r < 16; ++r) pmax = fmaxf(pmax, p0[r]);
#pragma unroll
  for (int r = 0; r < 16; ++r) pmax = fmaxf(pmax, p1[r]);
  { auto rr = __builtin_amdgcn_permlane32_swap(__float_as_uint(pmax), __float_as_uint(pmax), false, false);
    pmax = fmaxf(__uint_as_float(rr[0]), __uint_as_float(rr[1])); }
  if (__builtin_expect(__all(pmax - m_reg <= THR / SCALE), 1)) { mn = m_reg; alpha = 1.f; }
  else { mn = fmaxf(m_reg, pmax); alpha = __builtin_amdgcn_exp2f((m_reg - mn) * C); m_reg = mn; }
  float mnC = -mn * C;
#pragma unroll
  for (int r = 0; r < 16; ++r) p0[r] = fmaf(p0[r], C, mnC);
#pragma unroll
  for (int r = 0; r < 16; ++r) p1[r] = fmaf(p1[r], C, mnC);
#pragma unroll
  for (int r = 0; r < 16; ++r) p0[r] = __builtin_amdgcn_exp2f(p0[r]);
}
__device__ __forceinline__ void finishSM(f32x16& p0, f32x16& p1, float alpha, float& l_reg, bf16x8& pa0, bf16x8& pa1, bf16x8& pa2, bf16x8& pa3) {
#pragma unroll
  for (int r = 0; r < 16; ++r) p1[r] = __builtin_amdgcn_exp2f(p1[r]);
  float ps = 0;
#pragma unroll
  for (int r = 0; r < 16; ++r) ps += p0[r];
#pragma unroll
  for (int r = 0; r < 16; ++r) ps += p1[r];
  { auto rr = __builtin_amdgcn_permlane32_swap(__float_as_uint(ps), __float_as_uint(ps), false, false);
    ps = __uint_as_float(rr[0]) + __uint_as_float(rr[1]); }
  l_reg = l_reg * alpha + ps;
#define PK4(P, BASE, OUT) do { unsigned a0 = cvt_pk_bf16(P[BASE + 0], P[BASE + 1]), a1 = cvt_pk_bf16(P[BASE + 2], P[BASE + 3]);   \
    unsigned b0 = cvt_pk_bf16(P[BASE + 4], P[BASE + 5]), b1 = cvt_pk_bf16(P[BASE + 6], P[BASE + 7]);                              \
    auto r0 = __builtin_amdgcn_permlane32_swap(a0, b0, false, false); auto r1 = __builtin_amdgcn_permlane32_swap(a1, b1, false, false); \
    u32x4 w = {r0[0], r1[0], r0[1], r1[1]}; OUT = *reinterpret_cast<bf16x8*>(&w); } while (0)
  PK4(p0, 0, pa0); PK4(p0, 8, pa1); PK4(p1, 0, pa2); PK4(p1, 8, pa3);
#undef PK4
}
__device__ __forceinline__ void qkt(f32x16& p0, f32x16& p1, const char* Ks, const bf16x8* qr, int r32, int hi) {
  p0 = f32x16{}; p1 = f32x16{};
#pragma unroll
  for (int d0 = 0; d0 < 8; ++d0) { int cb = (d0 * 16 + hi * 8) * 2;
    bf16x8 b0 = *reinterpret_cast<const bf16x8*>(Ks + KSWZ(r32, cb));
    bf16x8 b1 = *reinterpret_cast<const bf16x8*>(Ks + KSWZ(32 + r32, cb));
    p0 = __builtin_amdgcn_mfma_f32_32x32x16_bf16(b0, qr[d0], p0, 0, 0, 0);
    p1 = __builtin_amdgcn_mfma_f32_32x32x16_bf16(b1, qr[d0], p1, 0, 0, 0); }
}
__device__ __forceinline__ int v_st(int k, int c) { const int kk = (k & ~0xC) | ((k & 4) << 1) | ((k & 8) >> 1); return ((kk >> 3) * 4 + (c >> 5)) * 512 + ((kk & 7) * 32 + (c & 31)) * 2; }
__device__ __forceinline__ int v_rd_base(int lane) { return ((lane & 3) << 3) | (((lane >> 2) & 3) << 6) | (((lane >> 4) & 1) << 5) | (((lane >> 5) & 1) << 8); }
constexpr int v_rd_off(int d0, int ks, int half) { return d0 * 512 + ks * 4096 + half * 2048; }
template <int OFF> __device__ __forceinline__ s16x4 tr_read(int vb) {
  s16x4 r; asm volatile("ds_read_b64_tr_b16 %0, %1 offset:%2" : "=&v"(r) : "v"(vb), "i"(OFF) : "memory"); return r;
}
template <int D0> __device__ __forceinline__ void pv_one(f32x16& od, int vb, bf16x8 pa0, bf16x8 pa1, bf16x8 pa2, bf16x8 pa3) {
  const s16x4 l0 = tr_read<v_rd_off(D0, 0, 0)>(vb), h0 = tr_read<v_rd_off(D0, 0, 1)>(vb), l1 = tr_read<v_rd_off(D0, 1, 0)>(vb), h1 = tr_read<v_rd_off(D0, 1, 1)>(vb);
  const s16x4 l2 = tr_read<v_rd_off(D0, 2, 0)>(vb), h2 = tr_read<v_rd_off(D0, 2, 1)>(vb), l3 = tr_read<v_rd_off(D0, 3, 0)>(vb), h3 = tr_read<v_rd_off(D0, 3, 1)>(vb);
  asm volatile("s_waitcnt lgkmcnt(0)" ::: "memory"); SBAR();
#define PK(L, H) (bf16x8){L[0], L[1], L[2], L[3], H[0], H[1], H[2], H[3]}
  od = __builtin_amdgcn_mfma_f32_32x32x16_bf16(pa0, PK(l0, h0), od, 0, 0, 0);
  od = __builtin_amdgcn_mfma_f32_32x32x16_bf16(pa1, PK(l1, h1), od, 0, 0, 0);
  od = __builtin_amdgcn_mfma_f32_32x32x16_bf16(pa2, PK(l2, h2), od, 0, 0, 0);
  od = __builtin_amdgcn_mfma_f32_32x32x16_bf16(pa3, PK(l3, h3), od, 0, 0, 0);
#undef PK
}
__device__ __forceinline__ void pv_d0(f32x16* o, int vb, bf16x8 pa0, bf16x8 pa1, bf16x8 pa2, bf16x8 pa3) {
  pv_one<0>(o[0], vb, pa0, pa1, pa2, pa3); pv_one<1>(o[1], vb, pa0, pa1, pa2, pa3); pv_one<2>(o[2], vb, pa0, pa1, pa2, pa3); pv_one<3>(o[3], vb, pa0, pa1, pa2, pa3);
}
__device__ __forceinline__ void na_fix(f32x16& p0, f32x16& p1, int j, int lo, int qrow, int rsq, const float* tabl  , int cs4  ) {
  if (j < 4) return;
  const int kr = lo + (j - 4);
  if (kr < rsq || kr >= rsq + 8) {
#pragma unroll
    for (int r = 0; r < 16; ++r) { p0[r] = NEG; p1[r] = NEG; }
    return;
  }
  const float* tb = tabl + (kr - qrow + 7) * 128;
#pragma unroll
  for (int r = 0; r < 16; ++r) { const int kcc = (r & 3) + 8 * (r >> 2);
    const float b0 = tb[kcc], b1 = tb[kcc + 32];
    p0[r] = ((unsigned)(kcc - cs4) < 16u) ? p0[r] + b0 : NEG; p1[r] = ((unsigned)(kcc + 32 - cs4) < 16u) ? p1[r] + b1 : NEG; }
}

template <bool NA>
__device__ __forceinline__ void attn_unit(const AUnit& U, char* lds, int tid) {
  asm volatile("" : "+v"(tid));
  const int wid = tid >> 6, lane = tid & 63, r32 = lane & 31, hi = lane >> 5;
  char* V_lds = lds; char* K_lds = lds + 2 * SHM_V;
  float* ws = (float*)(lds + OFF_WS) + wid * 64; float* li_l = ws; float* al_l = ws + 32;
  float* tab = (float*)(lds + OFF_TAB);
  float m_reg = NEG, l_reg = 0; f32x16 o[4] = {}; bf16x8 qr[8];
  const bf16_t* Qw = U.Q + (size_t)(wid * QBLK + r32) * LDZ + hi * 8;
#pragma unroll
  for (int d0 = 0; d0 < 8; ++d0) qr[d0] = *reinterpret_cast<const bf16x8*>(Qw + d0 * 16);
  int qrow = 0, rsq = 0, cs4 = 0; const float* tabl = tab;
  if constexpr (NA) {
    const int wu = __builtin_amdgcn_readfirstlane(wid);
    qrow = U.r0 + (wu >> 1); rsq = min(max(qrow - 4, 0), 24);
    const int qc = (wu & 1) * 32 + r32, cs = min(max(qc - 8, 0), 48);
    cs4 = cs - 4 * hi;
    tabl = tab + (4 * hi - qc + 64);
    for (int e = tid; e < 15 * 128; e += 512) { const int dri = e >> 7, dc = (e & 127) - 64; tab[e] = (dc >= -15 && dc <= 15) ? U.rpb[dri * 31 + dc + 15] * (1.0f / SCALE) : 0.f; }
  }
  const int sr = tid >> 4, sc = (tid & 15) * 8, vst0 = v_st(sr, sc), vst1 = v_st(32 + sr, sc);
  const int vb0 = (int)(uintptr_t)V_lds + v_rd_base(lane);
  struct { bf16x8 vs0, vs1, ks0, ks1; } sr_[1];
  const int nfirst = U.nfirst, vofs = U.vofs; const bf16_t* P0 = U.P0; const bf16_t* P1 = U.P1;
#define TILEP(j) (((j) < nfirst ? P0 + (size_t)(j) * 64 * LDZ : P1 + (size_t)((j) - nfirst) * 64 * LDZ) + (size_t)sr * LDZ + sc)
#define SLOAD(i, j) do { const bf16_t* kp_ = TILEP(j); sr_[i].vs0 = *reinterpret_cast<const bf16x8*>(kp_ + vofs); sr_[i].vs1 = *reinterpret_cast<const bf16x8*>(kp_ + 32 * LDZ + vofs); \
    sr_[i].ks0 = *reinterpret_cast<const bf16x8*>(kp_); sr_[i].ks1 = *reinterpret_cast<const bf16x8*>(kp_ + 32 * LDZ); } while (0)
#define SWRITE(b, i) do { *(bf16x8*)(V_lds + (b) * SHM_V + vst0) = sr_[i].vs0; *(bf16x8*)(V_lds + (b) * SHM_V + vst1) = sr_[i].vs1; int kc_ = sc * 2; \
    *(bf16x8*)(K_lds + (b) * SHM_K + KSWZ(sr, kc_)) = sr_[i].ks0; *(bf16x8*)(K_lds + (b) * SHM_K + KSWZ(32 + sr, kc_)) = sr_[i].ks1; } while (0)
#define SWAIT() asm volatile("s_waitcnt vmcnt(0)" ::: "memory")
#define RESC(a) do { if (__any((a) < 1.f)) { if (hi == 0) al_l[r32] = (a); asm volatile("s_waitcnt lgkmcnt(0)" ::: "memory"); \
    _Pragma("unroll") for (int d = 0; d < 4; ++d) _Pragma("unroll") for (int r = 0; r < 16; ++r) o[d][r] *= al_l[crow(r, hi)]; } } while (0)
#define NAFIX(PA, PB, j) do { if constexpr (NA) na_fix(PA, PB, (j), U.lo, qrow, rsq, tabl, cs4); } while (0)
  f32x16 pA0, pA1, pB0, pB1; float mnA, mnB, alA, alB; bf16x8 pa0, pa1, pa2, pa3; const int NT = U.NT;
  constexpr int SE = 0, SO = 0;
  SLOAD(SE, 0); asm volatile("s_waitcnt vmcnt(0)" ::: "memory"); SWRITE(0, SE); __syncthreads();
  qkt(pA0, pA1, K_lds, qr, r32, hi); NAFIX(pA0, pA1, 0); partialSM(pA0, pA1, m_reg, mnA, alA);
  SLOAD(SO, 1);
  SWAIT(); SWRITE(1, SO); __syncthreads();
  for (int j = 1; j + 1 < NT; j += 2) {
    SBAR(); qkt(pB0, pB1, K_lds + SHM_K, qr, r32, hi);
    finishSM(pA0, pA1, alA, l_reg, pa0, pa1, pa2, pa3); SBAR();
    SLOAD(SE, j + 1); SBAR();
    pv_d0(o, vb0, pa0, pa1, pa2, pa3); NAFIX(pB0, pB1, j); partialSM(pB0, pB1, m_reg, mnB, alB);
    __syncthreads(); SWAIT(); SWRITE(0, SE);
    RESC(alB); __syncthreads();
    SBAR(); qkt(pA0, pA1, K_lds, qr, r32, hi);
    finishSM(pB0, pB1, alB, l_reg, pa0, pa1, pa2, pa3); SBAR();
    SLOAD(SO, j + 2); SBAR();
    pv_d0(o, vb0 + SHM_V, pa0, pa1, pa2, pa3); NAFIX(pA0, pA1, j + 1); partialSM(pA0, pA1, m_reg, mnA, alA);
    __syncthreads(); SWAIT(); SWRITE(1, SO);
    RESC(alA); __syncthreads();
  }
  SBAR(); qkt(pB0, pB1, K_lds + SHM_K, qr, r32, hi);
  finishSM(pA0, pA1, alA, l_reg, pa0, pa1, pa2, pa3); SBAR();
  pv_d0(o, vb0, pa0, pa1, pa2, pa3); NAFIX(pB0, pB1, NT - 1); partialSM(pB0, pB1, m_reg, mnB, alB);
  __syncthreads(); RESC(alB);
  finishSM(pB0, pB1, alB, l_reg, pa0, pa1, pa2, pa3); SBAR();
  pv_d0(o, vb0 + SHM_V, pa0, pa1, pa2, pa3);
  if (hi == 0) li_l[r32] = l_reg; asm volatile("s_waitcnt lgkmcnt(0)" ::: "memory");
  float rli[16];
#pragma unroll
  for (int r = 0; r < 16; ++r) rli[r] = __builtin_amdgcn_rcpf(li_l[crow(r, hi)]);
  __syncthreads();
  bf16_t* ost = (bf16_t*)(lds + wid * 8192);
#pragma unroll
  for (int r = 0; r < 16; ++r) { const int orow = crow(r, hi);
#pragma unroll
    for (int d0 = 0; d0 < 4; ++d0) { const unsigned w = cvt_pk_bf16(o[d0][r] * rli[r], 0.f); ost[orow * 128 + d0 * 32 + r32] = (bf16_t)(w & 0xffffu); } }
  asm volatile("s_waitcnt lgkmcnt(0)" ::: "memory");
  bf16_t* Ow = (bf16_t*)U.Q + (size_t)(wid * QBLK) * LDZ;
#pragma unroll
  for (int i = 0; i < 8; ++i) { const int id = i * 64 + lane, row = id >> 4, c16 = id & 15;
    *(u32x4*)(Ow + (size_t)row * LDZ + c16 * 8) = *(const u32x4*)(ost + row * 128 + c16 * 8); }
  __syncthreads();
#undef TILEP
#undef SLOAD
#undef SWRITE
#undef SWAIT
#undef RESC
#undef NAFIX
}
}

struct Args { const float* in[17]; float* out; unsigned char* ws; int ph_lo, ph_hi; };
static_assert(sizeof(Args) == 17 * 8 + 8 + 8 + 8, "Args has no padding");


__device__ __forceinline__ void transpose_item(const float* W, int N, bf16_t* WT, int ldt, LAS float* scr, int kb, int nb, int lane) {
    const int k0 = 64 * kb, n0 = 32 * nb;
#pragma unroll 8
    for (int i = 0; i < 32; ++i) { const int kk = 2 * i + (lane >> 5); scr[kk * 33 + (lane & 31)] = W[(size_t)(k0 + kk) * N + n0 + (lane & 31)]; }
    LDS_WAIT(); asm volatile("" ::: "memory");
    const int c = lane & 7;
#pragma unroll
    for (int j = 0; j < 4; ++j) { const int n = (lane >> 3) + 8 * j; const LAS float* s = scr + (8 * c) * 33 + n;
        u32x4 o; o.x = cvt_pk_bf16(s[0 * 33], s[1 * 33]); o.y = cvt_pk_bf16(s[2 * 33], s[3 * 33]); o.z = cvt_pk_bf16(s[4 * 33], s[5 * 33]); o.w = cvt_pk_bf16(s[6 * 33], s[7 * 33]);
        *(u32x4*)(WT + (size_t)(n0 + n) * ldt + k0 + 8 * c) = o; }
    LDS_WAIT(); asm volatile("" ::: "memory");
}

__device__ __forceinline__ void row_stats(const f32x4 (&v)[8], float& mean, float& rstd, int lane) {
    float s = 0.f;
#pragma unroll
    for (int j = 0; j < 8; ++j) s += (v[j].x + v[j].y) + (v[j].z + v[j].w);
    mean = wave_sum(s, lane) * (1.f / DM); float s2 = 0.f;
#pragma unroll
    for (int j = 0; j < 8; ++j) { const f32x4 d = v[j] - mean; s2 += (d.x * d.x + d.y * d.y) + (d.z * d.z + d.w * d.w); }
    rstd = 1.0f / sqrtf(wave_sum(s2, lane) * (1.f / DM) + LN_EPS);
}
template <int MODE>
__device__ __forceinline__ void ln_row(const float* src, float* dst, bf16_t* hrow, const float* g, const float* b, const float* shift, const float* scale, int lane) {
    f32x4 v[8];
#pragma unroll
    for (int j = 0; j < 8; ++j) v[j] = ((const f32x4*)src)[lane + 64 * j];
    float mean, rstd; row_stats(v, mean, rstd, lane);
    if (MODE >= 1) {
#pragma unroll
        for (int j = 0; j < 8; ++j) { const f32x4 gg = ((const f32x4*)g)[lane + 64 * j], bb = ((const f32x4*)b)[lane + 64 * j]; v[j] = (v[j] - mean) * rstd * gg + bb; ((f32x4*)dst)[lane + 64 * j] = v[j]; }
        if (MODE == 2) return;
        row_stats(v, mean, rstd, lane);
    }
#pragma unroll
    for (int j = 0; j < 8; ++j) { const f32x4 sc = ((const f32x4*)scale)[lane + 64 * j], sh = ((const f32x4*)shift)[lane + 64 * j];
        const f32x4 h = (v[j] - mean) * rstd * (sc + 1.0f) + sh; u32x2 w; w.x = cvt_pk_bf16(h.x, h.y); w.y = cvt_pk_bf16(h.z, h.w); ((u32x2*)hrow)[lane + 64 * j] = w; }
}

__device__ __forceinline__ void load16(const bf16_t* p, float (&v)[16]) {
    const u32x4 a = *(const u32x4*)p, b = *(const u32x4*)(p + 8);
    v[0] = bflo(a.x); v[1] = bfhi(a.x); v[2] = bflo(a.y); v[3] = bfhi(a.y); v[4] = bflo(a.z); v[5] = bfhi(a.z); v[6] = bflo(a.w); v[7] = bfhi(a.w);
    v[8] = bflo(b.x); v[9] = bfhi(b.x); v[10] = bflo(b.y); v[11] = bfhi(b.y); v[12] = bflo(b.z); v[13] = bfhi(b.z); v[14] = bflo(b.w); v[15] = bfhi(b.w);
}
__device__ __forceinline__ void store16(bf16_t* p, const float (&v)[16]) {
    u32x4 a, b; a.x = cvt_pk_bf16(v[0], v[1]); a.y = cvt_pk_bf16(v[2], v[3]); a.z = cvt_pk_bf16(v[4], v[5]); a.w = cvt_pk_bf16(v[6], v[7]);
    b.x = cvt_pk_bf16(v[8], v[9]); b.y = cvt_pk_bf16(v[10], v[11]); b.z = cvt_pk_bf16(v[12], v[13]); b.w = cvt_pk_bf16(v[14], v[15]);
    *(u32x4*)p = a; *(u32x4*)(p + 8) = b;
}
__device__ __forceinline__ void qk_norm_rope(bf16_t* p, const float* gain, const float* ropec, const float* ropes, int pos, int lane) {
    float v[16]; load16(p, v);
    float ss = 0.f;
#pragma unroll
    for (int j = 0; j < 16; ++j) ss += v[j] * v[j];
    ss += shfl_xor_l(ss, 1, lane); ss += shfl_xor_l(ss, 2, lane); ss += shfl_xor_l(ss, 4, lane);
    const float rinv = 1.0f / sqrtf(ss * (1.f / 128.f) + LN_EPS);
    const int l8 = lane & 7;
#pragma unroll
    for (int j = 0; j < 16; ++j) v[j] = v[j] * rinv * gain[l8 * 16 + j];
    if (pos >= 0) {
        const int ti = ((l8 & 4) ? 32 + (pos & 63) : (pos >> 6)) * 32 + 16 * (l8 & 1);
#pragma unroll
        for (int j = 0; j < 16; ++j) { const float pr = shfl_xor_l(v[j], 2, lane); const float c = ropec[ti + j], s = ropes[ti + j]; v[j] = v[j] * c + ((l8 & 2) ? pr : -pr) * s; }
    }
    store16(p, v);
}
__device__ __forceinline__ void prep_row(bf16_t* zr, int pos, int seqlen, bool rope, bool do_q, bool do_conv, const float* qg, const float* kg, const float* cw, const float* ropec, const float* ropes, int lane) {
    if (do_q) qk_norm_rope(zr + QB0 + lane * 16, qg, ropec, ropes, rope ? pos : -1, lane);
    if (lane < 16) qk_norm_rope(zr + KB0 + lane * 16, kg, ropec, ropes, rope ? pos : -1, lane);
    if (do_conv) {
        const int ch = lane * 16; float bg[16], c1[16], u1[16], accv[16];
        load16(zr + CB0 + ch, bg); load16(zr + CC0 + ch, c1); load16(zr + CX0 + ch, u1);
#pragma unroll
        for (int j = 0; j < 16; ++j) accv[j] = cw[1024 + ch + j] * (c1[j] * u1[j]);
        if (pos > 0) { load16(zr - INW + CC0 + ch, c1); load16(zr - INW + CX0 + ch, u1);
#pragma unroll
            for (int j = 0; j < 16; ++j) accv[j] += cw[ch + j] * (c1[j] * u1[j]); }
        if (pos < seqlen - 1) { load16(zr + INW + CC0 + ch, c1); load16(zr + INW + CX0 + ch, u1);
#pragma unroll
            for (int j = 0; j < 16; ++j) accv[j] += cw[2048 + ch + j] * (c1[j] * u1[j]); }
#pragma unroll
        for (int j = 0; j < 16; ++j) accv[j] *= bg[j];
        store16(zr + CB0 + ch, accv);
    }
}

typedef const __attribute__((address_space(4))) Args* KArgs;
#define PHASE_CTX \
    KArgs ap = (KArgs)__builtin_amdgcn_kernarg_segment_ptr(); asm volatile("" : "+s"(ap)); \
    const int lane = lane_id_opaque(); const int wave = wave_s; int tid = wave_s * 64 + lane; asm volatile("" : "+v"(tid)); \
    const int G = gridDim.x, bx = blockIdx.x, vcu = (G % 8 == 0) ? (bx % 8) * (G / 8) + bx / 8 : bx; \
    const int gw = vcu * 8 + wave, NGW = G * 8; \
    unsigned char* ws = ap->ws; (void)lane; (void)gw; (void)NGW;
#define WSP(T, off) ((T*)(ws + (off)))

__global__ void __launch_bounds__(512, 2) mk_fwd(Args args) {
    extern __shared__ __attribute__((aligned(16))) unsigned char lds[];
    LAS unsigned char* const ldsl = (LAS unsigned char*)lds;
    {
        const int t0 = threadIdx.x;
        for (int u = t0; u < (LDS_BYTES - LDSCTL_OFF) / 4; u += 512) ((LAS unsigned*)(ldsl + LDSCTL_OFF))[u] = 0u;
    }
    __syncthreads();
    const int wave_s = __builtin_amdgcn_readfirstlane((int)threadIdx.x >> 6);
    const int lo = args.ph_lo, hi = args.ph_hi;
    XcdBarrier bar; bar.bar = (unsigned*)(args.ws + WS_CTL) + CW_BAR; bar.x = 0; bar.st = (volatile LAS unsigned*)(ldsl + MISC_OFF + 32);
    if (hi - lo > 1) bar = xcd_barrier_post((unsigned*)(args.ws + WS_CTL) + CW_BAR, (volatile LAS unsigned*)(ldsl + MISC_OFF + 32));
    int pid = 0;
#define PHASE_BEGIN if (lo <= pid && pid < hi) { PHASE_CTX
#define PHASE_END   if (pid + 1 < hi) xcd_barrier(bar, tid == 0); } ++pid;

    PHASE_BEGIN
    {
        const float* c_in = ap->in[1]; const float* cctx_in = ap->in[3]; const float* w_mod = ap->in[4]; const float* b_mod = ap->in[5];
        float* MOD = WSP(float, WS_MOD); float* ROPEC = WSP(float, WS_ROPE); float* ROPES = ROPEC + 96 * 32;
        if (bx < 192) {
            const int l = bx / 96, n0 = (bx % 96) * 128;
            LAS float* cact = (LAS float*)ldsl;
            for (int i = tid; i < 17 * DM; i += 512) { const int b = i >> 11, k = i & 2047; const float v = (b < 16) ? c_in[b * DM + k] : cctx_in[k]; cact[i] = v / (1.0f + __expf(-v)); }
            __syncthreads();
            const int c4 = tid & 31, kg = tid >> 5;
            f32x4 acc[17];
#pragma unroll
            for (int b = 0; b < 17; ++b) acc[b] = (f32x4){0.f, 0.f, 0.f, 0.f};
            const float* wp = w_mod + ((size_t)l * DM + kg * 128) * MODW + n0 + 4 * c4;
            for (int kk = 0; kk < 128; kk += 4) {
                const f32x4 w0 = *(const f32x4*)(wp + (size_t)(kk + 0) * MODW), w1 = *(const f32x4*)(wp + (size_t)(kk + 1) * MODW), w2 = *(const f32x4*)(wp + (size_t)(kk + 2) * MODW), w3 = *(const f32x4*)(wp + (size_t)(kk + 3) * MODW);
#pragma unroll
                for (int b = 0; b < 17; ++b) { const f32x4 a = *(const LAS f32x4*)(cact + b * DM + kg * 128 + kk); acc[b] += w0 * a.x + w1 * a.y + w2 * a.z + w3 * a.w; }
            }
            __syncthreads();
            LAS float* part = (LAS float*)ldsl;
            const int tid2 = wave_s * 64 + lane_id_opaque(), c4b = tid2 & 31, kgb = tid2 >> 5;
#pragma unroll
            for (int b = 0; b < 17; ++b) *(LAS f32x4*)(part + (kgb * 17 + b) * 128 + 4 * c4b) = acc[b];
            __syncthreads();
            for (int o = tid2; o < 17 * 128; o += 512) { const int b = o >> 7, n = o & 127; float sacc = b_mod[l * MODW + n0 + n];
#pragma unroll
                for (int g = 0; g < 16; ++g) sacc += part[(g * 17 + b) * 128 + n];
                MOD[((size_t)l * 17 + b) * MODW + n0 + n] = sacc; }
            __syncthreads();
        } else if (bx == 192) {
            for (int i = tid; i < 96 * 32; i += 512) { const int pos = i >> 5, fi = i & 31; const float p = (float)(pos < 32 ? pos : pos - 32);
                const float freq = powf(10000.0f, -(float)(2 * fi) / 64.0f); const float ang = p * freq; ROPEC[i] = cosf(ang); ROPES[i] = sinf(ang); }
        }
        const float* w_in = ap->in[6]; const float* w_branch = ap->in[11]; const float* w_o = ap->in[12]; const float* w_up = ap->in[13]; const float* w_down = ap->in[14];
        LAS float* scr = (LAS float*)(ldsl + wave * 16384);
        constexpr int I_IN = (DM / 64) * (INW / 32), I_BR = (1024 / 64) * (DM / 32), I_O = (DM / 64) * (DM / 32), I_UP = (DM / 64) * (HID / 32), I_DN = (HID / 64) * (DM / 32);
        constexpr int I_LAYER = I_IN + 3 * I_BR + I_O + I_UP + I_DN;
        for (int it = gw; it < 2 * I_LAYER; it += NGW) {
            const int l = it / I_LAYER; int r = it - l * I_LAYER; unsigned char* wl = ws + WS_W + (size_t)l * W_LAYER;
            if (r < I_IN) { transpose_item(w_in + (size_t)l * DM * INW, INW, (bf16_t*)(wl + W_IN), DM, scr, r / (INW / 32), r % (INW / 32), lane); continue; } r -= I_IN;
            if (r < 3 * I_BR) { const int i = r / I_BR, rr = r % I_BR; transpose_item(w_branch + ((size_t)l * 3 + i) * 1024 * DM, DM, (bf16_t*)(wl + W_BR) + i * 1024, 3072, scr, rr / (DM / 32), rr % (DM / 32), lane); continue; } r -= 3 * I_BR;
            if (r < I_O) { transpose_item(w_o + (size_t)l * DM * DM, DM, (bf16_t*)(wl + W_O), DM, scr, r / (DM / 32), r % (DM / 32), lane); continue; } r -= I_O;
            if (r < I_UP) { transpose_item(w_up + (size_t)l * DM * HID, HID, (bf16_t*)(wl + W_UP), DM, scr, r / (HID / 32), r % (HID / 32), lane); continue; } r -= I_UP;
            transpose_item(w_down + (size_t)l * HID * DM, DM, (bf16_t*)(wl + W_DN), HID, scr, r / (DM / 32), r % (DM / 32), lane);
        }
    }
    PHASE_END

    PHASE_BEGIN
    {
        const float* x_in = ap->in[0]; const float* ctx_in = ap->in[2]; const float* MOD = WSP(float, WS_MOD); bf16_t* H = WSP(bf16_t, WS_H);
        for (int m = gw; m < MALL; m += NGW) {
            const bool lat = m < NLAT; const int bi = lat ? (m >> 11) : 16;
            const float* src = lat ? x_in + (size_t)m * DM : ctx_in + (size_t)(m - NLAT) * DM;
            const float* md = MOD + (size_t)bi * MODW;
            ln_row<0>(src, nullptr, H + (size_t)m * DM, nullptr, nullptr, md, md + DM, lane);
        }
    }
    PHASE_END

    for (int l = 0; l < DEPTH; ++l) {
        const bool with_ctx = (l == 0);
        for (int ch = 0; ch < 2; ++ch) {
            const bool ctx_here = (ch == 0);
            PHASE_BEGIN
            {
                GInProj P; P.H = WSP(bf16_t, WS_H); P.W = (const bf16_t*)(ws + WS_W + (size_t)l * W_LAYER + W_IN); P.Z = WSP(bf16_t, WS_Z); P.ZC = WSP(bf16_t, WS_ZC); P.lda = DM; P.ldb = DM;
                P.tp = TwoPart{ch * PAN_CH, INW / 256, ctx_here ? PAN_CTX : 0, with_ctx ? INW / 256 : (CB0 - KA0) / 256, with_ctx ? 0 : KA0 / 256, G, bx};
                pg8::gemm_phase<GInProj>(ldsl, P, tid);
            }
            PHASE_END
            PHASE_BEGIN
            {
                const float* qg = ap->in[8] + l * 128; const float* kg = ap->in[9] + l * 128; const float* cw = ap->in[10] + (size_t)l * 3 * 1024;
                const float* ROPEC = WSP(float, WS_ROPE); const float* ROPES = ROPEC + 96 * 32; bf16_t* Z = WSP(bf16_t, WS_Z); bf16_t* ZC = WSP(bf16_t, WS_ZC);
                const int nrows = CHROWS + (ctx_here ? NCTX : 0);
                for (int m = gw; m < nrows; m += NGW) {
                    if (m < CHROWS) prep_row(Z + (size_t)m * INW, m & 2047, SEQ, true, true, true, qg, kg, cw, ROPEC, ROPES, lane);
                    else { const int mc = m - CHROWS; prep_row(ZC + (size_t)mc * INW, mc & 255, CTXL, false, with_ctx, with_ctx, qg, kg, cw, ROPEC, ROPES, lane); }
                }
            }
            PHASE_END
            PHASE_BEGIN
            {
                bf16_t* Z = WSP(bf16_t, WS_Z); bf16_t* ZC = WSP(bf16_t, WS_ZC); const float* rpb = ap->in[7];
                const int n_dense = 512 + ((with_ctx && ctx_here) ? 256 : 0);
                for (int id = bx; id < n_dense; id += G) {
                    att::AUnit A; A.r0 = 0; A.lo = 0; A.rpb = nullptr;
                    if (id < 512) {
                        const int bl = id >> 6, qh = (id >> 3) & 7, qb = id & 7, b = ch * 8 + bl;
                        A.Q = Z + ((size_t)(bl * SEQ + qb * 256) * INW + QB0 + qh * 128);
                        A.P0 = Z + ((size_t)(bl * SEQ) * INW + KB0 + (qh >> 2) * 128); A.P1 = ZC + ((size_t)(b * CTXL) * INW + KB0 + (qh >> 2) * 128);
                        A.nfirst = 32; A.NT = 36; A.vofs = VB0 - KB0;
                    } else {
                        const int i2 = id - 512, b = i2 >> 4, hh = i2 & 15; const bf16_t* zb = ZC + (size_t)(b * CTXL) * INW;
                        if (hh < 8) { A.Q = zb + QA0 + hh * 128; A.P0 = zb + KA0 + hh * 128; A.vofs = VA0 - KA0; }
                        else { const int qh = hh - 8; A.Q = zb + QB0 + qh * 128; A.P0 = zb + KB0 + (qh >> 2) * 128; A.vofs = VB0 - KB0; }
                        A.P1 = A.P0; A.nfirst = 4; A.NT = 4;
                    }
                    att::attn_unit<false>(A, (char*)lds, tid);
                }
                for (int id = bx; id < 512; id += G) {
                    int bl, h, r0;
                    if (id < 384) { bl = id / 48; const int rem = id % 48; h = rem / 6; r0 = 4 + 4 * (rem % 6); }
                    else { const int i2 = id - 384; bl = i2 >> 4; h = (i2 >> 1) & 7; r0 = (i2 & 1) ? 28 : 0; }
                    const int b = ch * 8 + bl; const bool edge = (r0 == 0 || r0 == 28); const int lo_ = (r0 == 0) ? 0 : (r0 == 28 ? 24 : r0 - 4);
                    att::AUnit A; A.Q = Z + ((size_t)(bl * SEQ + r0 * 64) * INW + QA0 + h * 128);
                    A.P0 = ZC + ((size_t)(b * CTXL) * INW + KA0 + h * 128); A.P1 = Z + ((size_t)(bl * SEQ + lo_ * 64) * INW + KA0 + h * 128);
                    A.nfirst = 4; A.NT = 4 + (edge ? 8 : 12); A.vofs = VA0 - KA0; A.r0 = r0; A.lo = lo_; A.rpb = rpb + ((size_t)l * 8 + h) * 15 * 31;
                    att::attn_unit<true>(A, (char*)lds, tid);
                }
            }
            PHASE_END
            PHASE_BEGIN
            {
                GBranch P; P.Z = WSP(bf16_t, WS_Z); P.ZC = WSP(bf16_t, WS_ZC); P.W = (const bf16_t*)(ws + WS_W + (size_t)l * W_LAYER + W_BR); P.Hout = WSP(bf16_t, WS_H); P.lda = INW; P.ldb = 3072;
                P.tp = TwoPart{ch * PAN_CH, DM / 256, (with_ctx && ctx_here) ? PAN_CTX : 0, DM / 256, 0, G, bx};
                pg8::gemm_phase<GBranch>(ldsl, P, tid);
            }
            PHASE_END
            PHASE_BEGIN
            {
                GWo P; P.A_lat = WSP(bf16_t, WS_H); P.A_ctx = P.A_lat + (size_t)NLAT * DM; P.a_lat0 = 0; P.W = (const bf16_t*)(ws + WS_W + (size_t)l * W_LAYER + W_O); P.lda = DM; P.ldb = DM;
                P.res_lat = (l == 0) ? ap->in[0] : (const float*)ap->out; P.res_ctx = ap->in[2]; P.out_lat = ap->out; P.out_ctx = WSP(float, WS_CTXS); P.mod = WSP(float, WS_MOD) + (size_t)l * 17 * MODW; P.modj = 2;
                P.tp = TwoPart{ch * PAN_CH, DM / 256, (with_ctx && ctx_here) ? PAN_CTX : 0, DM / 256, 0, G, bx};
                pg8::gemm_phase<GWo>(ldsl, P, tid);
            }
            PHASE_END
        }
        PHASE_BEGIN
        {
            const int nrows = with_ctx ? MALL : NLAT; const float* g = ap->in[15] + (size_t)(l * 2 + 0) * DM; const float* bb = ap->in[16] + (size_t)(l * 2 + 0) * DM;
            float* OUT = ap->out; float* CTXS = WSP(float, WS_CTXS); bf16_t* H = WSP(bf16_t, WS_H); const float* MODL = WSP(float, WS_MOD) + (size_t)l * 17 * MODW;
            for (int m = gw; m < nrows; m += NGW) {
                const bool lat = m < NLAT; const int bi = lat ? (m >> 11) : 16;
                float* row = lat ? OUT + (size_t)m * DM : CTXS + (size_t)(m - NLAT) * DM; const float* md = MODL + (size_t)bi * MODW;
                ln_row<1>(row, row, H + (size_t)m * DM, g, bb, md + 3 * DM, md + 4 * DM, lane);
            }
        }
        PHASE_END
        for (int ch = 0; ch < 2; ++ch) {
            const bool ctx_here = (ch == 0) && with_ctx;
            PHASE_BEGIN
            {
                GUp P; P.H = WSP(bf16_t, WS_H); P.W = (const bf16_t*)(ws + WS_W + (size_t)l * W_LAYER + W_UP); P.U = WSP(bf16_t, WS_Z); P.lda = DM; P.ldb = DM;
                P.tp = TwoPart{ch * PAN_CH, HID / 256, ctx_here ? PAN_CTX : 0, HID / 256, 0, G, bx};
                pg8::gemm_phase<GUp>(ldsl, P, tid);
            }
            PHASE_END
            PHASE_BEGIN
            {
                GDown P; P.A_lat = WSP(bf16_t, WS_Z); P.A_ctx = P.A_lat + (size_t)CHROWS * HID; P.a_lat0 = ch * PAN_CH; P.W = (const bf16_t*)(ws + WS_W + (size_t)l * W_LAYER + W_DN); P.lda = HID; P.ldb = HID;
                P.res_lat = ap->out; P.res_ctx = WSP(float, WS_CTXS); P.out_lat = ap->out; P.out_ctx = WSP(float, WS_CTXS); P.mod = WSP(float, WS_MOD) + (size_t)l * 17 * MODW; P.modj = 5;
                P.tp = TwoPart{ch * PAN_CH, DM / 256, ctx_here ? PAN_CTX : 0, DM / 256, 0, G, bx};
                pg8::gemm_phase<GDown>(ldsl, P, tid);
            }
            PHASE_END
        }
        PHASE_BEGIN
        {
            const int nrows = with_ctx ? MALL : NLAT; const float* g = ap->in[15] + (size_t)(l * 2 + 1) * DM; const float* bb = ap->in[16] + (size_t)(l * 2 + 1) * DM;
            float* OUT = ap->out; float* CTXS = WSP(float, WS_CTXS); bf16_t* H = WSP(bf16_t, WS_H); const float* MODN = WSP(float, WS_MOD) + (size_t)(l + 1) * 17 * MODW;
            for (int m = gw; m < nrows; m += NGW) {
                const bool lat = m < NLAT; const int bi = lat ? (m >> 11) : 16;
                float* row = lat ? OUT + (size_t)m * DM : CTXS + (size_t)(m - NLAT) * DM;
                if (l + 1 < DEPTH) { const float* md = MODN + (size_t)bi * MODW; ln_row<1>(row, row, H + (size_t)m * DM, g, bb, md, md + DM, lane); }
                else ln_row<2>(row, row, nullptr, g, bb, nullptr, nullptr, lane);
            }
        }
        PHASE_END
    }
#undef PHASE_BEGIN
#undef PHASE_END
}
constexpr int N_PHASES = 2 + DEPTH * (2 * 5 + 1 + 2 * 2 + 1);

extern "C" void kernel_launch(void* const* d_in, const int* in_sizes, int n_in, void* d_out, int out_size, void* d_ws, size_t ws_size, hipStream_t stream) {
    static int grid = 0;
    if (grid == 0) {
        if (n_in != 17 || in_sizes[0] != NLAT * DM || out_size != NLAT * DM || ws_size < WS_END) { fprintf(stderr, "kernel_launch: shape / workspace mismatch (ws %zu, need %zu)\n", ws_size, (size_t)WS_END); grid = -1; return; }
        int dev = 0, cus = 0, per_cu = 0;
        if (hipGetDevice(&dev) != hipSuccess || hipDeviceGetAttribute(&cus, hipDeviceAttributeMultiprocessorCount, dev) != hipSuccess) { grid = -1; return; }
        if (hipFuncSetAttribute((const void*)mk_fwd, hipFuncAttributeMaxDynamicSharedMemorySize, LDS_BYTES) != hipSuccess) { fprintf(stderr, "kernel_launch: hipFuncSetAttribute failed\n"); grid = -1; return; }
        if (hipOccupancyMaxActiveBlocksPerMultiprocessor(&per_cu, (const void*)mk_fwd, 512, LDS_BYTES) != hipSuccess || per_cu < 1) fprintf(stderr, "kernel_launch: occupancy query says %d\n", per_cu);
        (void)hipGetLastError();
        grid = cus;
    }
    if (grid < 0) return;
    if (hipMemsetAsync((char*)d_ws + WS_CTL, 0, CTL_ZERO_BYTES, stream) != hipSuccess) return;
    Args a{};
    for (int i = 0; i < 17; ++i) a.in[i] = (const float*)d_in[i];
    a.out = (float*)d_out; a.ws = (unsigned char*)d_ws;
#if MK_PER_PHASE
    for (int p = 0; p < N_PHASES; ++p) { a.ph_lo = p; a.ph_hi = p + 1; hipLaunchKernelGGL(mk_fwd, dim3(grid), dim3(512), LDS_BYTES, stream, a); }
#else
    a.ph_lo = 0; a.ph_hi = N_PHASES;
    hipLaunchKernelGGL(mk_fwd, dim3(grid), dim3(512), LDS_BYTES, stream, a);
#endif
    const hipError_t le = hipPeekAtLastError();
    if (le != hipSuccess) fprintf(stderr, "kernel_launch: launch failed: %s\n", hipGetErrorName(le));
}
```

```cpp
#include <hip/hip_runtime.h>
#include <cstdio>
#include <cstdint>
#include <cmath>

#define LAS __attribute__((address_space(3)))
#define GAS __attribute__((address_space(1)))
typedef unsigned short bf16_t;
typedef short bf16x8 __attribute__((ext_vector_type(8)));
typedef short s16x4 __attribute__((ext_vector_type(4)));
typedef float f32x4 __attribute__((ext_vector_type(4)));
typedef float f32x2 __attribute__((ext_vector_type(2)));
typedef float f32x16 __attribute__((ext_vector_type(16)));
typedef unsigned u32x4 __attribute__((ext_vector_type(4)));
typedef unsigned u32x2 __attribute__((ext_vector_type(2)));

#ifndef PROBE_DUP
#define PROBE_DUP 0
#endif
#ifndef MK_PER_PHASE
#define MK_PER_PHASE 0
#endif

constexpr int DM = 2048, NB = 16, SEQ = 2048, CTXL = 256, HD = 128, HID = 8192, DEPTH = 2;
constexpr int QA0 = 0, QB0 = 1024, KA0 = 2048, VA0 = 3072, KB0 = 4096, VB0 = 4352, CB0 = 4608, CC0 = 5632, CX0 = 6656, G0 = 7680, INW = 13824;
constexpr int NLAT = NB * SEQ, NCTX = NB * CTXL, MALL = NLAT + NCTX;
constexpr int CHROWS = 16384, PAN_CH = 64, PAN_LAT = 128, PAN_CTX = 16;
constexpr float LN_EPS = 1e-6f, DN_ALPHA = 1.4142135623730951f, ATT_SCALE = 0.08838834764831845f;
constexpr int MODW = 6 * DM;

constexpr size_t MiB = 1u << 20;
constexpr size_t WS_CTL = 0, CTL_ZERO_BYTES = 1 * MiB;
constexpr size_t WS_MOD = 1 * MiB;
constexpr size_t WS_ROPE = 3 * MiB;
constexpr size_t WS_STATS = 3 * MiB + 512 * 1024;
constexpr size_t WS_W = 4 * MiB;
constexpr size_t W_IN = 0, W_BR = 54 * MiB, W_O = 66 * MiB, W_UP = 74 * MiB, W_DN = 106 * MiB, W_LAYER = 138 * MiB;
constexpr size_t WS_CTXS = 280 * MiB;
constexpr size_t WS_H = 312 * MiB;
constexpr size_t WS_ZC = 456 * MiB;
constexpr size_t WS_Z = 564 * MiB;
constexpr size_t WS_END = 996 * MiB;
static_assert(WS_W + 2 * W_LAYER <= WS_CTXS && WS_H + (size_t)MALL * DM * 2 <= WS_ZC && WS_ZC + (size_t)NCTX * INW * 2 <= WS_Z && WS_Z + (size_t)CHROWS * INW * 2 <= WS_END, "ws map");
static_assert((size_t)(CHROWS + NCTX) * HID * 2 <= WS_END - WS_Z, "U overlay");
constexpr int CW_TMO = 0, CW_BAR = 4096;

constexpr int RING_BYTES = 131072;
constexpr int SCR_BYTES = 139264;
constexpr int LDSCTL_OFF = SCR_BYTES, MISC_OFF = LDSCTL_OFF + 64;
constexpr int LDS_BYTES = 147456;

#define RLX_AGENT __ATOMIC_RELAXED, __HIP_MEMORY_SCOPE_AGENT
#define LDS_WAIT() asm volatile("s_waitcnt lgkmcnt(0)" ::: "memory")
#define VM_WAIT() asm volatile("s_waitcnt vmcnt(0)" ::: "memory")
__device__ __forceinline__ unsigned cvt_pk_bf16(float lo, float hi) { unsigned r; asm volatile("v_cvt_pk_bf16_f32 %0, %1, %2" : "=v"(r) : "v"(lo), "v"(hi)); return r; }
__device__ __forceinline__ float bflo(unsigned w) { return __uint_as_float(w << 16); }
__device__ __forceinline__ float bfhi(unsigned w) { return __uint_as_float(w & 0xffff0000u); }
__device__ __forceinline__ int lane_id_opaque() { int l; asm volatile("v_mbcnt_lo_u32_b32 %0, -1, 0\n\tv_mbcnt_hi_u32_b32 %0, -1, %0" : "=v"(l)); return l; }
__device__ __forceinline__ float shfl_xor_l(float v, int mask, int lane) { return __uint_as_float((unsigned)__builtin_amdgcn_ds_bpermute((lane ^ mask) << 2, (int)__float_as_uint(v))); }
__device__ __forceinline__ float wave_sum(float v, int lane) {
#pragma unroll
    for (int o = 1; o < 64; o <<= 1) v += shfl_xor_l(v, o, lane);
    return v;
}

#define XB_TMO      128
#define XB_XCNT(j)  (256  + 64 * (j))
#define XB_XSUB(j)  (1280 + 64 * (j))
#define XB_XGEN(j)  (2304 + 64 * (j))
#define XB_TOP      3328
#define XB_TOPGEN   3392
#define XCD_BAR_WORDS 3456
#define XB_SPIN_CAP (1u << 20)
__device__ __forceinline__ unsigned xb_ld(unsigned* p)              { return __hip_atomic_load(p, __ATOMIC_RELAXED, __HIP_MEMORY_SCOPE_AGENT); }
__device__ __forceinline__ unsigned xb_add(unsigned* p, unsigned v) { return __hip_atomic_fetch_add(p, v, __ATOMIC_RELAXED, __HIP_MEMORY_SCOPE_AGENT); }
__device__ __forceinline__ unsigned xb_xcc_id() { return (unsigned)__builtin_amdgcn_s_getreg((3 << 11) | 20) & 0xFu; }
#define XB_SPIN(cond, bar) do { unsigned _sp = 0; while (cond) { __builtin_amdgcn_s_sleep(1); \
    if ((++_sp & 255u) == 0u) { if (xb_ld(&(bar)[XB_TMO])) break; if (_sp > XB_SPIN_CAP) { atomicAdd(&(bar)[XB_TMO], 1u); break; } } } } while (0)
struct XcdBarrier { unsigned* bar; unsigned x; volatile LAS unsigned* st; };
__device__ __forceinline__ XcdBarrier xcd_barrier_post(unsigned* bar, volatile LAS unsigned* st) {
    XcdBarrier b; b.bar = bar; b.x = xb_xcc_id(); b.st = st;
    if (threadIdx.x == 0) (void)xb_add(&bar[XB_XCNT(b.x)], 1u);
    return b;
}
__device__ __forceinline__ void xcd_barrier_complete(unsigned* bar, unsigned x, unsigned& nloc, unsigned& nx) {
    const unsigned G = gridDim.x * gridDim.y * gridDim.z;
    unsigned sum, cnt, mine, sp = 0u;
    for (;;) {
        sum = 0u; cnt = 0u; mine = 0u;
#pragma unroll
        for (unsigned j = 0; j < 16; ++j) { const unsigned c = xb_ld(&bar[XB_XCNT(j)]); sum += c; cnt += (c > 0u) ? 1u : 0u; mine = (j == x) ? c : mine; }
        if (sum == G) break;
        __builtin_amdgcn_s_sleep(1);
        if ((++sp & 255u) == 0u) { if (xb_ld(&bar[XB_TMO])) break; if (sp > XB_SPIN_CAP) { atomicAdd(&bar[XB_TMO], 1u); break; } }
    }
    nloc = mine > 0u ? mine : 1u; nx = cnt > 0u ? cnt : 1u;
}
__device__ __forceinline__ void xcd_barrier(const XcdBarrier& b, const bool leader) {
    asm volatile("s_waitcnt vmcnt(0)" ::: "memory");
    __syncthreads();
    if (leader) {
        unsigned* bar = b.bar;
        __builtin_amdgcn_s_waitcnt(0);
        unsigned nloc = b.st[0], nx = b.st[1];
        if (nloc == 0u) { xcd_barrier_complete(bar, b.x, nloc, nx); b.st[0] = nloc; b.st[1] = nx; }
        const unsigned old = xb_add(&bar[XB_XSUB(b.x)], 1u);
        const unsigned gen = old / nloc;
        if (old + 1u == (gen + 1u) * nloc) {
            __builtin_amdgcn_fence(__ATOMIC_RELEASE, "agent");
            asm volatile("s_waitcnt vmcnt(0)" ::: "memory");
            const unsigned og = xb_add(&bar[XB_TOP], 1u);
            const unsigned tg = og / nx;
            if (og + 1u == (tg + 1u) * nx) xb_add(&bar[XB_TOPGEN], 1u);
            else XB_SPIN(xb_ld(&bar[XB_TOPGEN]) == tg, bar);
            __builtin_amdgcn_fence(__ATOMIC_ACQUIRE, "agent");
            xb_add(&bar[XB_XGEN(b.x)], 1u);
            asm volatile("s_waitcnt vmcnt(0)" ::: "memory");
        } else {
            XB_SPIN(xb_ld(&bar[XB_XGEN(b.x)]) == gen, bar);
            __builtin_amdgcn_fence(__ATOMIC_ACQUIRE, "agent");
            asm volatile("s_waitcnt vmcnt(0)" ::: "memory");
        }
    }
    __syncthreads();
}

namespace pg8 {
constexpr int BM = 256, BK = 64, HALF = 128, HTB = HALF * BK * 2, STAGE_BYTES = 8 * HTB;
__host__ __device__ __forceinline__ int lds_byte(int r, int c) { const int st = (r >> 4) * 2 + (c >> 5), rr = r & 15, cc = c & 31, ob = rr * 64 + cc * 2; return st * 1024 + (ob ^ (((ob >> 9) & 1) << 5)); }
__host__ __device__ __forceinline__ void stage_rc(int b, int& R, int& C) { const int st = b / 1024, sb = b % 1024, swz = sb ^ (((sb >> 9) & 1) << 5); R = (st >> 1) * 16 + swz / 64; C = (st & 1) * 32 + (swz % 64) / 2; }
__host__ __device__ __forceinline__ int perm32(int rho) { const int n = rho >> 4, i = rho & 15; return 8 * (i >> 2) + 4 * n + (i & 3); }
struct Unit { int pm, pn, seg; };
__device__ __forceinline__ void tile_map(int L, int nwg, int nM, int nN, int& pm, int& pn) {
    const int q = nwg / 8, r = nwg % 8, xcd = L % 8, off = L / 8;
    const int wgid = (xcd < r ? xcd * (q + 1) : r * (q + 1) + (xcd - r) * q) + off;
    const int nig = 8 * nN, gid = wgid / nig, fm = gid * 8, gsz = (nM - fm) < 8 ? (nM - fm) : 8;
    pm = fm + ((wgid % nig) % gsz); pn = (wgid % nig) / gsz;
}

template <class P>
__device__ __forceinline__ void gemm_phase(LAS unsigned char* lds, const P& p, const int tid) {
    const int wid = __builtin_amdgcn_readfirstlane(tid >> 6), lane = tid & 63, wr = wid >> 2, wc = wid & 3, fr = lane & 15, fq = lane >> 4;
    constexpr int nt = P::NT;
    unsigned voffA[2], voffB[2];
#pragma unroll
    for (int i = 0; i < 2; ++i) { int R, C; stage_rc(tid * 16 + i * 8192, R, C); const int Rb = P::PERM ? ((R & ~31) + perm32(R & 31)) : R;
        voffA[i] = (unsigned)(R * p.lda + C) * 2u; voffB[i] = (unsigned)(Rb * p.ldb + C) * 2u; }
    const size_t kstep = (size_t)(BK * 2);
    const size_t hstepA = (size_t)HALF * p.lda * 2, hstepB = (size_t)HALF * p.ldb * 2;
    const unsigned ldsw = (unsigned)wid * 1024u;
    const int aoff = lds_byte(wr * 64 + fr, fq * 8), boff = lds_byte(wc * 32 + fr, fq * 8);
#define PG8_SA(b, h) (((b) * 2 + (h)) * HTB)
#define PG8_SB(b, h) ((4 + (b) * 2 + (h)) * HTB)
#define PG8_STAGE(bufoff, gbase, voff) do { _Pragma("unroll") for (int _i = 0; _i < 2; ++_i) \
        __builtin_amdgcn_global_load_lds((const unsigned*)((const char*)(gbase) + (voff)[_i]), (LAS unsigned*)(lds + (bufoff) + ldsw + _i * 8192), 16, 0, 0); } while (0)
#define PG8_LDA(dst, b, h) do { _Pragma("unroll") for (int m = 0; m < 4; ++m) _Pragma("unroll") for (int k = 0; k < 2; ++k) dst[m][k] = *(const LAS bf16x8*)(lds + PG8_SA(b, h) + aoff + m * 2048 + k * 1024); } while (0)
#define PG8_LDB(dst, b, h) do { _Pragma("unroll") for (int n = 0; n < 2; ++n) _Pragma("unroll") for (int k = 0; k < 2; ++k) dst[n][k] = *(const LAS bf16x8*)(lds + PG8_SB(b, h) + boff + n * 2048 + k * 1024); } while (0)
#define PG8_MMA(ai, bj, At, Bt) do { __builtin_amdgcn_s_setprio(1); _Pragma("unroll") for (int m = 0; m < 4; ++m) _Pragma("unroll") for (int n = 0; n < 2; ++n) _Pragma("unroll") for (int k = 0; k < 2; ++k) \
        acc[ai][bj][m][n] = __builtin_amdgcn_mfma_f32_16x16x32_bf16(Bt[n][k], At[m][k], acc[ai][bj][m][n], 0, 0, 0); __builtin_amdgcn_s_setprio(0); } while (0)
#define PG8_WAIT_V(n) asm volatile("s_waitcnt vmcnt(" #n ")" ::: "memory")
#define PG8_WAIT_L(n) asm volatile("s_waitcnt lgkmcnt(" #n ")" ::: "memory")
#define PG8_BAR __builtin_amdgcn_s_barrier()
#define PG8_SCHED __builtin_amdgcn_sched_barrier(0)
    Unit cur, nxt; int ui = 0;
    if (!p.next(0, cur)) return;
    f32x4 acc[2][2][4][2];
#pragma unroll
    for (int a = 0; a < 2; ++a)
#pragma unroll
        for (int b = 0; b < 2; ++b)
#pragma unroll
            for (int m = 0; m < 4; ++m)
#pragma unroll
                for (int n = 0; n < 2; ++n) acc[a][b][m][n] = (f32x4){0.f, 0.f, 0.f, 0.f};
    bf16x8 At[4][2], B0[2][2], B1[2][2];
    const char* cA = p.a_ptr(cur); const char* cB = p.b_ptr(cur);
    PG8_STAGE(PG8_SB(0, 0), cB, voffB); PG8_STAGE(PG8_SB(0, 1), cB + hstepB, voffB); PG8_STAGE(PG8_SA(0, 0), cA, voffA); PG8_STAGE(PG8_SA(0, 1), cA + hstepA, voffA);
    if (wr == 1) PG8_BAR;
    PG8_WAIT_V(2); PG8_BAR;
    PG8_STAGE(PG8_SB(1, 0), cB + kstep, voffB); PG8_STAGE(PG8_SA(1, 0), cA + kstep, voffA); PG8_STAGE(PG8_SB(1, 1), cB + hstepB + kstep, voffB);
    PG8_WAIT_V(6); PG8_BAR;
    for (;;) {
        const bool has_next = p.next(ui + 1, nxt);
        const char* nA = has_next ? p.a_ptr(nxt) : cA; const char* nB = has_next ? p.b_ptr(nxt) : cB;
        for (int t = 0; t < nt; t += 2) {
            const bool last = (t == nt - 2);
            const char* a1 = cA + (size_t)(t + 1) * kstep;
            const char* a2 = last ? nA : cA + (size_t)(t + 2) * kstep; const char* b2 = last ? nB : cB + (size_t)(t + 2) * kstep;
            const char* a3 = a2 + kstep; const char* b3 = b2 + kstep;
            PG8_LDB(B0, 0, 0); PG8_LDB(B1, 0, 1); PG8_SCHED; PG8_LDA(At, 0, 0); PG8_STAGE(PG8_SA(1, 1), a1 + hstepA, voffA);
            PG8_WAIT_V(8); PG8_WAIT_L(0); PG8_BAR; PG8_MMA(0, 0, At, B0); PG8_MMA(0, 1, At, B1); PG8_BAR; PG8_SCHED;
            PG8_LDA(At, 0, 1); PG8_STAGE(PG8_SB(0, 0), b2, voffB); PG8_STAGE(PG8_SB(0, 1), b2 + hstepB, voffB); PG8_STAGE(PG8_SA(0, 0), a2, voffA);
            PG8_WAIT_V(8); PG8_WAIT_L(0); PG8_BAR; PG8_MMA(1, 0, At, B0); PG8_MMA(1, 1, At, B1); PG8_BAR; PG8_SCHED;
            PG8_LDB(B0, 1, 0); PG8_LDB(B1, 1, 1); PG8_SCHED; PG8_LDA(At, 1, 0); PG8_STAGE(PG8_SA(0, 1), a2 + hstepA, voffA);
            PG8_WAIT_V(8); PG8_WAIT_L(0); PG8_BAR; PG8_MMA(0, 0, At, B0); PG8_MMA(0, 1, At, B1); PG8_BAR; PG8_SCHED;
            PG8_LDA(At, 1, 1); PG8_STAGE(PG8_SB(1, 0), b3, voffB); PG8_STAGE(PG8_SB(1, 1), b3 + hstepB, voffB); PG8_STAGE(PG8_SA(1, 0), a3, voffA);
            PG8_WAIT_V(8); PG8_WAIT_L(0); PG8_BAR; PG8_MMA(1, 0, At, B0); PG8_MMA(1, 1, At, B1); PG8_BAR; PG8_SCHED;
        }
        if (wr == 0) PG8_BAR;
        p.epi(acc, cur, wr, wc, fr, fq);
        if (!has_next) break;
        if (!p.keep(cur)) {
#pragma unroll
            for (int a = 0; a < 2; ++a)
#pragma unroll
                for (int b = 0; b < 2; ++b)
#pragma unroll
                    for (int m = 0; m < 4; ++m)
#pragma unroll
                        for (int n = 0; n < 2; ++n) acc[a][b][m][n] = (f32x4){0.f, 0.f, 0.f, 0.f};
        }
        cur = nxt; cA = nA; cB = nB; ++ui;
        if (wr == 1) PG8_BAR;
    }
    PG8_WAIT_V(0);
    PG8_BAR;
#undef PG8_SA
#undef PG8_SB
#undef PG8_STAGE
#undef PG8_LDA
#undef PG8_LDB
#undef PG8_MMA
#undef PG8_WAIT_V
#undef PG8_WAIT_L
#undef PG8_BAR
#undef PG8_SCHED
}
}
using pg8::Unit;

struct TwoPart {
    int lat0, nNa, nMb, nNb, pn0b, G, c;
    __device__ __forceinline__ bool map(int L, Unit& u) const {
        const int nA = PAN_CH * nNa, nB = nMb * nNb; int pm, pn;
        if (L < nA) { pg8::tile_map(L, nA, PAN_CH, nNa, pm, pn); u.pm = lat0 + pm; u.pn = pn; return true; }
        if (L < nA + nB) { pg8::tile_map(L - nA, nB, nMb, nNb, pm, pn); u.pm = PAN_LAT + pm; u.pn = pn0b + pn; return true; }
        return false;
    }
};
__device__ __forceinline__ float sigmoid_c(float x) { x = fminf(fmaxf(x, -30.f), 30.f); return __builtin_amdgcn_rcpf(1.f + __builtin_amdgcn_exp2f(-1.4426950408889634f * x)); }

struct GInProj {
    static constexpr int NT = DM / 64; static constexpr bool PERM = true;
    const bf16_t* H; const bf16_t* W; bf16_t* Z; bf16_t* ZC; TwoPart tp; int lda, ldb, dry;
    __device__ __forceinline__ bool next(int i, Unit& u) const { u.seg = 0; return tp.map(i * tp.G + tp.c, u); }
    __device__ __forceinline__ const char* a_ptr(const Unit& u) const { return (const char*)(H + (size_t)u.pm * 256 * DM); }
    __device__ __forceinline__ const char* b_ptr(const Unit& u) const { return (const char*)(W + (size_t)u.pn * 256 * DM); }
    __device__ __forceinline__ bool keep(const Unit&) const { return false; }
    __device__ __forceinline__ void epi(const f32x4 (&acc)[2][2][4][2], const Unit& u, int wr, int wc, int fr, int fq) const {
        if (PROBE_DUP && dry) return;
        bf16_t* base = (u.pm < PAN_LAT) ? Z + (size_t)(u.pm - tp.lat0) * 256 * INW : ZC + (size_t)(u.pm - PAN_LAT) * 256 * INW;
        const int row0 = wr * 64 + fr, col0 = u.pn * 256 + wc * 32 + 8 * fq; const bool gate = u.pn >= G0 / 256;
#pragma unroll
        for (int ai = 0; ai < 2; ++ai)
#pragma unroll
            for (int m = 0; m < 4; ++m) { bf16_t* rowp = base + (size_t)(row0 + ai * 128 + m * 16) * INW + col0;
#pragma unroll
                for (int bj = 0; bj < 2; ++bj) { f32x4 v0 = acc[ai][bj][m][0], v1 = acc[ai][bj][m][1];
                    if (gate) { v0 = (f32x4){sigmoid_c(v0[0]), sigmoid_c(v0[1]), sigmoid_c(v0[2]), sigmoid_c(v0[3])}; v1 = (f32x4){sigmoid_c(v1[0]), sigmoid_c(v1[1]), sigmoid_c(v1[2]), sigmoid_c(v1[3])}; }
                    u32x4 w; w.x = cvt_pk_bf16(v0[0], v0[1]); w.y = cvt_pk_bf16(v0[2], v0[3]); w.z = cvt_pk_bf16(v1[0], v1[1]); w.w = cvt_pk_bf16(v1[2], v1[3]);
                    *(u32x4*)(rowp + bj * 128) = w; } }
    }
};

struct GBranch {
    static constexpr int NT = 1024 / 64; static constexpr bool PERM = true;
    const bf16_t* Z; const bf16_t* ZC; const bf16_t* W; bf16_t* Hout; TwoPart tp; int lda, ldb, dry;
    __device__ __forceinline__ bool next(int i, Unit& u) const { const int t = i / 3; u.seg = i - 3 * t; return tp.map(t * tp.G + tp.c, u); }
    __device__ __forceinline__ const bf16_t* zrow(const Unit& u) const { return (u.pm < PAN_LAT) ? Z + (size_t)(u.pm - tp.lat0) * 256 * INW : ZC + (size_t)(u.pm - PAN_LAT) * 256 * INW; }
    __device__ __forceinline__ const char* a_ptr(const Unit& u) const { return (const char*)(zrow(u) + (u.seg == 0 ? QA0 : (u.seg == 1 ? QB0 : CB0))); }
    __device__ __forceinline__ const char* b_ptr(const Unit& u) const { return (const char*)(W + (size_t)u.pn * 256 * 3072 + u.seg * 1024); }
    __device__ __forceinline__ bool keep(const Unit& u) const { return u.seg < 2; }
    __device__ __forceinline__ void epi(f32x4 (&acc)[2][2][4][2], const Unit& u, int wr, int wc, int fr, int fq) const {
        if (PROBE_DUP && dry) return;
        const bf16_t* zb = zrow(u) + G0; const int row0 = wr * 64 + fr, col0 = u.pn * 256 + wc * 32 + 8 * fq;
        const int seg = u.seg;
#pragma unroll
        for (int ai = 0; ai < 2; ++ai)
#pragma unroll
            for (int m = 0; m < 4; ++m) { const bf16_t* zr = zb + (size_t)(row0 + ai * 128 + m * 16) * INW + col0;
                if (seg < 2) {
#pragma unroll
                    for (int bj = 0; bj < 2; ++bj) { const u32x4 gp = *(const u32x4*)(zr + seg * 2048 + bj * 128), gn = *(const u32x4*)(zr + (seg + 1) * 2048 + bj * 128);
                        f32x4 r0, r1;
                        r0[0] = bflo(gp.x) * __builtin_amdgcn_rcpf(bflo(gn.x)); r0[1] = bfhi(gp.x) * __builtin_amdgcn_rcpf(bfhi(gn.x));
                        r0[2] = bflo(gp.y) * __builtin_amdgcn_rcpf(bflo(gn.y)); r0[3] = bfhi(gp.y) * __builtin_amdgcn_rcpf(bfhi(gn.y));
                        r1[0] = bflo(gp.z) * __builtin_amdgcn_rcpf(bflo(gn.z)); r1[1] = bfhi(gp.z) * __builtin_amdgcn_rcpf(bfhi(gn.z));
                        r1[2] = bflo(gp.w) * __builtin_amdgcn_rcpf(bflo(gn.w)); r1[3] = bfhi(gp.w) * __builtin_amdgcn_rcpf(bfhi(gn.w));
                        acc[ai][bj][m][0] *= r0; acc[ai][bj][m][1] *= r1; }
                } else {
                    bf16_t* orow = Hout + (size_t)(u.pm * 256 + row0 + ai * 128 + m * 16) * DM + col0;
#pragma unroll
                    for (int bj = 0; bj < 2; ++bj) { const u32x4 g = *(const u32x4*)(zr + 2 * 2048 + bj * 128);
                        const f32x4 v0 = acc[ai][bj][m][0] * (f32x4){bflo(g.x), bfhi(g.x), bflo(g.y), bfhi(g.y)}, v1 = acc[ai][bj][m][1] * (f32x4){bflo(g.z), bfhi(g.z), bflo(g.w), bfhi(g.w)};
                        u32x4 w; w.x = cvt_pk_bf16(v0[0], v0[1]); w.y = cvt_pk_bf16(v0[2], v0[3]); w.z = cvt_pk_bf16(v1[0], v1[1]); w.w = cvt_pk_bf16(v1[2], v1[3]);
                        *(u32x4*)(orow + bj * 128) = w; }
                }
                asm volatile("" ::: "memory"); }
    }
};

template <bool LNRES>
__device__ __forceinline__ void epi_residual(const f32x4 (&acc)[2][2][4][2], const float* res, float* out, const float* modv, const float* stats, const float* lg, const float* lb, int pn, int wr, int wc, int fr, int fq) {
    const int row0 = wr * 64 + fr, col0 = pn * 256 + wc * 32 + 4 * fq;
    f32x4 gv[2][2], gl[2][2], bl[2][2];
#pragma unroll
    for (int bj = 0; bj < 2; ++bj)
#pragma unroll
        for (int n = 0; n < 2; ++n) { gv[bj][n] = *(const f32x4*)(modv + col0 + bj * 128 + n * 16);
            if (LNRES) { gl[bj][n] = *(const f32x4*)(lg + col0 + bj * 128 + n * 16) * DN_ALPHA; bl[bj][n] = *(const f32x4*)(lb + col0 + bj * 128 + n * 16) * DN_ALPHA; } }
#pragma unroll
    for (int ai = 0; ai < 2; ++ai)
#pragma unroll
        for (int m = 0; m < 4; ++m) { const int rr = row0 + ai * 128 + m * 16; const size_t off = (size_t)rr * DM + col0;
            f32x2 st = (f32x2){0.f, 1.f}; if (LNRES) st = *(const f32x2*)(stats + 2 * rr);
#pragma unroll
            for (int bj = 0; bj < 2; ++bj)
#pragma unroll
                for (int n = 0; n < 2; ++n) { const f32x4 r = *(const f32x4*)(res + off + bj * 128 + n * 16);
                    f32x4 o;
                    if (LNRES) o = ((r - st.x) * st.y) * gl[bj][n] + bl[bj][n] + gv[bj][n] * acc[ai][bj][m][n];
                    else o = r * DN_ALPHA + gv[bj][n] * acc[ai][bj][m][n];
                    *(f32x4*)(out + off + bj * 128 + n * 16) = o; }
            asm volatile("" ::: "memory"); }
}
struct GRes {
    static constexpr bool PERM = false;
    const bf16_t* A_lat; const bf16_t* A_ctx;
    int a_lat0; const bf16_t* W; const float* res_lat; const float* res_ctx; float* out_lat; float* out_ctx; const float* mod; int modj; TwoPart tp; int lda, ldb, dry;
    const float* stats; const float* lg; const float* lb; int lnres;
    __device__ __forceinline__ bool nextu(int i, Unit& u) const { u.seg = 0; return tp.map(i * tp.G + tp.c, u); }
    __device__ __forceinline__ const char* a_ptr(const Unit& u) const { return (const char*)((u.pm < PAN_LAT) ? A_lat + (size_t)(u.pm - a_lat0) * 256 * lda : A_ctx + (size_t)(u.pm - PAN_LAT) * 256 * lda); }
    __device__ __forceinline__ const char* b_ptr(const Unit& u) const { return (const char*)(W + (size_t)u.pn * 256 * ldb); }
    __device__ __forceinline__ bool keep(const Unit&) const { return false; }
    __device__ __forceinline__ void epi(const f32x4 (&acc)[2][2][4][2], const Unit& u, int wr, int wc, int fr, int fq) const {
        if (PROBE_DUP && dry) return;
        const bool lat = u.pm < PAN_LAT; const size_t prow = (size_t)(lat ? u.pm : u.pm - PAN_LAT) * 256;
        const float* r = (lat ? res_lat : res_ctx) + prow * DM; float* o = (lat ? out_lat : out_ctx) + prow * DM;
        const float* mv = mod + (size_t)(lat ? (u.pm >> 3) : 16) * MODW + modj * DM; const float* st = stats + (size_t)u.pm * 256 * 2;
        if (lnres) epi_residual<true>(acc, r, o, mv, st, lg, lb, u.pn, wr, wc, fr, fq);
        else epi_residual<false>(acc, r, o, mv, st, lg, lb, u.pn, wr, wc, fr, fq);
    }
};
struct GWo : GRes { static constexpr int NT = DM / 64; __device__ __forceinline__ bool next(int i, Unit& u) const { return nextu(i, u); } };
struct GDown : GRes { static constexpr int NT = HID / 64; __device__ __forceinline__ bool next(int i, Unit& u) const { return nextu(i, u); } };

struct GUp {
    static constexpr int NT = DM / 64; static constexpr bool PERM = true;
    const bf16_t* H; const bf16_t* W; bf16_t* U; TwoPart tp; int lda, ldb, dry;
    __device__ __forceinline__ bool next(int i, Unit& u) const { u.seg = 0; return tp.map(i * tp.G + tp.c, u); }
    __device__ __forceinline__ const char* a_ptr(const Unit& u) const { return (const char*)(H + (size_t)u.pm * 256 * DM); }
    __device__ __forceinline__ const char* b_ptr(const Unit& u) const { return (const char*)(W + (size_t)u.pn * 256 * DM); }
    __device__ __forceinline__ bool keep(const Unit&) const { return false; }
    __device__ __forceinline__ void epi(const f32x4 (&acc)[2][2][4][2], const Unit& u, int wr, int wc, int fr, int fq) const {
        if (PROBE_DUP && dry) return;
        bf16_t* base = U + (size_t)((u.pm < PAN_LAT) ? (u.pm - tp.lat0) : (PAN_CH + u.pm - PAN_LAT)) * 256 * HID;
        const int row0 = wr * 64 + fr, col0 = u.pn * 256 + wc * 32 + 8 * fq;
#pragma unroll
        for (int ai = 0; ai < 2; ++ai)
#pragma unroll
            for (int m = 0; m < 4; ++m) { bf16_t* rowp = base + (size_t)(row0 + ai * 128 + m * 16) * HID + col0;
#pragma unroll
                for (int bj = 0; bj < 2; ++bj) { f32x4 v0 = acc[ai][bj][m][0], v1 = acc[ai][bj][m][1];
                    v0 = __builtin_elementwise_max(v0, (f32x4){0.f, 0.f, 0.f, 0.f}); v1 = __builtin_elementwise_max(v1, (f32x4){0.f, 0.f, 0.f, 0.f}); v0 = v0 * v0; v1 = v1 * v1;
                    u32x4 w; w.x = cvt_pk_bf16(v0[0], v0[1]); w.y = cvt_pk_bf16(v0[2], v0[3]); w.z = cvt_pk_bf16(v1[0], v1[1]); w.w = cvt_pk_bf16(v1[2], v1[3]);
                    *(u32x4*)(rowp + bj * 128) = w; } }
    }
};

namespace att {
constexpr int NW = 8, QBLK = 32, KVBLK = 64, LDZ = INW;
constexpr float SCALE = ATT_SCALE, THR = 8.f, NEG = -1e30f;
constexpr int SHM_V = 16384, SHM_K = 16384, OFF_WS = 65536, OFF_TAB = OFF_WS + 2048, LDS_ATTN = OFF_TAB + 15 * 512;
static_assert(LDS_ATTN <= SCR_BYTES, "attention LDS");
struct AUnit { const bf16_t* Q; const bf16_t* P0; const bf16_t* P1; int nfirst, NT, vofs; int r0, lo; const float* rpb; int dry; };
#define KSWZ(row, colB) ((row) * 256 + ((colB) ^ (((row) & 7) << 4)))
#define SBAR() __builtin_amdgcn_sched_barrier(0)
__device__ __forceinline__ int crow(int r, int hi) { return (r & 3) + 8 * (r >> 2) + 4 * hi; }
__device__ __forceinline__ void partialSM(f32x16& p0, f32x16& p1, float& m_reg, float& mn, float& alpha) {
  constexpr float C = SCALE * 1.4426950408889634f;
  float pmax = p0[0];
#pragma unroll
  for (int r = 1; r < 16; ++r) pmax = fmaxf(pmax, p0[r]);
#pragma unroll
  for (int r = 0; r < 16; ++r) pmax = fmaxf(pmax, p1[r]);
  { auto rr = __builtin_amdgcn_permlane32_swap(__float_as_uint(pmax), __float_as_uint(pmax), false, false);
    pmax = fmaxf(__uint_as_float(rr[0]), __uint_as_float(rr[1])); }
  if (__builtin_expect(__all(pmax - m_reg <= THR / SCALE), 1)) { mn = m_reg; alpha = 1.f; }
  else { mn = fmaxf(m_reg, pmax); alpha = __builtin_amdgcn_exp2f((m_reg - mn) * C); m_reg = mn; }
  float mnC = -mn * C;
#pragma unroll
  for (int r = 0; r < 16; ++r) p0[r] = fmaf(p0[r], C, mnC);
#pragma unroll
  for (int r = 0; r < 16; ++r) p1[r] = fmaf(p1[r], C, mnC);
#pragma unroll
  for (int r = 0; r < 16; ++r) p0[r] = __builtin_amdgcn_exp2f(p0[r]);
}
__device__ __forceinline__ void finishSM(f32x16& p0, f32x16& p1, float alpha, float& l_reg, bf16x8& pa0, bf16x8& pa1, bf16x8& pa2, bf16x8& pa3) {
#pragma unroll
  for (int r = 0; r < 16; ++r) p1[r] = __builtin_amdgcn_exp2f(p1[r]);
  float ps = 0;
#pragma unroll
  for (int r = 0; r < 16; ++r) ps += p0[r];
#pragma unroll
  for (int r = 0; r < 16; ++r) ps += p1[r];
  { auto rr = __builtin_amdgcn_permlane32_swap(__float_as_uint(ps), __float_as_uint(ps), false, false);
    ps = __uint_as_float(rr[0]) + __uint_as_float(rr[1]); }
  l_reg = l_reg * alpha + ps;
#define PK4(P, BASE, OUT) do { unsigned a0 = cvt_pk_bf16(P[BASE + 0], P[BASE + 1]), a1 = cvt_pk_bf16(P[BASE + 2], P[BASE + 3]);   \
    unsigned b0 = cvt_pk_bf16(P[BASE + 4], P[BASE + 5]), b1 = cvt_pk_bf16(P[BASE + 6], P[BASE + 7]);                              \
    auto r0 = __builtin_amdgcn_permlane32_swap(a0, b0, false, false); auto r1 = __builtin_amdgcn_permlane32_swap(a1, b1, false, false); \
    u32x4 w = {r0[0], r1[0], r0[1], r1[1]}; OUT = *reinterpret_cast<bf16x8*>(&w); } while (0)
  PK4(p0, 0, pa0); PK4(p0, 8, pa1); PK4(p1, 0, pa2); PK4(p1, 8, pa3);
#undef PK4
}
__device__ __forceinline__ void qkt(f32x16& p0, f32x16& p1, const char* Ks, const bf16x8* qr, int r32, int hi) {
  p0 = f32x16{}; p1 = f32x16{};
#pragma unroll
  for (int d0 = 0; d0 < 8; ++d0) { int cb = (d0 * 16 + hi * 8) * 2;
    bf16x8 b0 = *reinterpret_cast<const bf16x8*>(Ks + KSWZ(r32, cb));
    bf16x8 b1 = *reinterpret_cast<const bf16x8*>(Ks + KSWZ(32 + r32, cb));
    p0 = __builtin_amdgcn_mfma_f32_32x32x16_bf16(b0, qr[d0], p0, 0, 0, 0);
    p1 = __builtin_amdgcn_mfma_f32_32x32x16_bf16(b1, qr[d0], p1, 0, 0, 0); }
}
__device__ __forceinline__ int v_st(int k, int c) { const int kk = (k & ~0xC) | ((k & 4) << 1) | ((k & 8) >> 1); return ((kk >> 3) * 4 + (c >> 5)) * 512 + ((kk & 7) * 32 + (c & 31)) * 2; }
__device__ __forceinline__ int v_rd_base(int lane) { return ((lane & 3) << 3) | (((lane >> 2) & 3) << 6) | (((lane >> 4) & 1) << 5) | (((lane >> 5) & 1) << 8); }
constexpr int v_rd_off(int d0, int ks, int half) { return d0 * 512 + ks * 4096 + half * 2048; }
template <int OFF> __device__ __forceinline__ s16x4 tr_read(int vb) {
  s16x4 r; asm volatile("ds_read_b64_tr_b16 %0, %1 offset:%2" : "=&v"(r) : "v"(vb), "i"(OFF) : "memory"); return r;
}
template <int D0> __device__ __forceinline__ void pv_one(f32x16& od, int vb, bf16x8 pa0, bf16x8 pa1, bf16x8 pa2, bf16x8 pa3) {
  const s16x4 l0 = tr_read<v_rd_off(D0, 0, 0)>(vb), h0 = tr_read<v_rd_off(D0, 0, 1)>(vb), l1 = tr_read<v_rd_off(D0, 1, 0)>(vb), h1 = tr_read<v_rd_off(D0, 1, 1)>(vb);
  const s16x4 l2 = tr_read<v_rd_off(D0, 2, 0)>(vb), h2 = tr_read<v_rd_off(D0, 2, 1)>(vb), l3 = tr_read<v_rd_off(D0, 3, 0)>(vb), h3 = tr_read<v_rd_off(D0, 3, 1)>(vb);
  asm volatile("s_waitcnt lgkmcnt(0)" ::: "memory"); SBAR();
#define PK(L, H) (bf16x8){L[0], L[1], L[2], L[3], H[0], H[1], H[2], H[3]}
  od = __builtin_amdgcn_mfma_f32_32x32x16_bf16(pa0, PK(l0, h0), od, 0, 0, 0);
  od = __builtin_amdgcn_mfma_f32_32x32x16_bf16(pa1, PK(l1, h1), od, 0, 0, 0);
  od = __builtin_amdgcn_mfma_f32_32x32x16_bf16(pa2, PK(l2, h2), od, 0, 0, 0);
  od = __builtin_amdgcn_mfma_f32_32x32x16_bf16(pa3, PK(l3, h3), od, 0, 0, 0);
#undef PK
}
__device__ __forceinline__ void pv_d0(f32x16* o, int vb, bf16x8 pa0, bf16x8 pa1, bf16x8 pa2, bf16x8 pa3) {
  pv_one<0>(o[0], vb, pa0, pa1, pa2, pa3); pv_one<1>(o[1], vb, pa0, pa1, pa2, pa3); pv_one<2>(o[2], vb, pa0, pa1, pa2, pa3); pv_one<3>(o[3], vb, pa0, pa1, pa2, pa3);
}
__device__ __forceinline__ void na_fix(f32x16& p0, f32x16& p1, int j, int lo, int qrow, int rsq, const float* tabl  , int cs4  ) {
  if (j < 4) return;
  const int kr = lo + (j - 4);
  if (kr < rsq || kr >= rsq + 8) {
#pragma unroll
    for (int r = 0; r < 16; ++r) { p0[r] = NEG; p1[r] = NEG; }
    return;
  }
  const float* tb = tabl + (kr - qrow + 7) * 128;
#pragma unroll
  for (int r = 0; r < 16; ++r) { const int kcc = (r & 3) + 8 * (r >> 2);
    const float b0 = tb[kcc], b1 = tb[kcc + 32];
    p0[r] = ((unsigned)(kcc - cs4) < 16u) ? p0[r] + b0 : NEG; p1[r] = ((unsigned)(kcc + 32 - cs4) < 16u) ? p1[r] + b1 : NEG; }
}

template <bool NA>
__device__ __forceinline__ void attn_unit(const AUnit& U, char* lds, int tid) {
  asm volatile("" : "+v"(tid));
  const int wid = tid >> 6, lane = tid & 63, r32 = lane & 31, hi = lane >> 5;
  char* V_lds = lds; char* K_lds = lds + 2 * SHM_V;
  float* ws = (float*)(lds + OFF_WS) + wid * 64; float* li_l = ws; float* al_l = ws + 32;
  float* tab = (float*)(lds + OFF_TAB);
  float m_reg = NEG, l_reg = 0; f32x16 o[4] = {}; bf16x8 qr[8];
  const bf16_t* Qw = U.Q + (size_t)(wid * QBLK + r32) * LDZ + hi * 8;
#pragma unroll
  for (int d0 = 0; d0 < 8; ++d0) qr[d0] = *reinterpret_cast<const bf16x8*>(Qw + d0 * 16);
  int qrow = 0, rsq = 0, cs4 = 0; const float* tabl = tab;
  if constexpr (NA) {
    const int wu = __builtin_amdgcn_readfirstlane(wid);
    qrow = U.r0 + (wu >> 1); rsq = min(max(qrow - 4, 0), 24);
    const int qc = (wu & 1) * 32 + r32, cs = min(max(qc - 8, 0), 48);
    cs4 = cs - 4 * hi;
    tabl = tab + (4 * hi - qc + 64);
    for (int e = tid; e < 15 * 128; e += 512) { const int dri = e >> 7, dc = (e & 127) - 64; tab[e] = (dc >= -15 && dc <= 15) ? U.rpb[dri * 31 + dc + 15] * (1.0f / SCALE) : 0.f; }
  }
  const int sr = tid >> 4, sc = (tid & 15) * 8, vst0 = v_st(sr, sc), vst1 = v_st(32 + sr, sc);
  const int vb0 = (int)(uintptr_t)V_lds + v_rd_base(lane);
  struct { bf16x8 vs0, vs1, ks0, ks1; } sr_[1];
  const int nfirst = U.nfirst, vofs = U.vofs; const bf16_t* P0 = U.P0; const bf16_t* P1 = U.P1;
#define TILEP(j) (((j) < nfirst ? P0 + (size_t)(j) * 64 * LDZ : P1 + (size_t)((j) - nfirst) * 64 * LDZ) + (size_t)sr * LDZ + sc)
#define SLOAD(i, j) do { const bf16_t* kp_ = TILEP(j); sr_[i].vs0 = *reinterpret_cast<const bf16x8*>(kp_ + vofs); sr_[i].vs1 = *reinterpret_cast<const bf16x8*>(kp_ + 32 * LDZ + vofs); \
    sr_[i].ks0 = *reinterpret_cast<const bf16x8*>(kp_); sr_[i].ks1 = *reinterpret_cast<const bf16x8*>(kp_ + 32 * LDZ); } while (0)
#define SWRITE(b, i) do { *(bf16x8*)(V_lds + (b) * SHM_V + vst0) = sr_[i].vs0; *(bf16x8*)(V_lds + (b) * SHM_V + vst1) = sr_[i].vs1; int kc_ = sc * 2; \
    *(bf16x8*)(K_lds + (b) * SHM_K + KSWZ(sr, kc_)) = sr_[i].ks0; *(bf16x8*)(K_lds + (b) * SHM_K + KSWZ(32 + sr, kc_)) = sr_[i].ks1; } while (0)
#define SWAIT() asm volatile("s_waitcnt vmcnt(0)" ::: "memory")
#define RESC(a) do { if (__any((a) < 1.f)) { if (hi == 0) al_l[r32] = (a); asm volatile("s_waitcnt lgkmcnt(0)" ::: "memory"); \
    _Pragma("unroll") for (int d = 0; d < 4; ++d) _Pragma("unroll") for (int r = 0; r < 16; ++r) o[d][r] *= al_l[crow(r, hi)]; } } while (0)
#define NAFIX(PA, PB, j) do { if constexpr (NA) na_fix(PA, PB, (j), U.lo, qrow, rsq, tabl, cs4); } while (0)
  f32x16 pA0, pA1, pB0, pB1; float mnA, mnB, alA, alB; bf16x8 pa0, pa1, pa2, pa3; const int NT = U.NT;
  constexpr int SE = 0, SO = 0;
  SLOAD(SE, 0); asm volatile("s_waitcnt vmcnt(0)" ::: "memory"); SWRITE(0, SE); __syncthreads();
  qkt(pA0, pA1, K_lds, qr, r32, hi); NAFIX(pA0, pA1, 0); partialSM(pA0, pA1, m_reg, mnA, alA);
  SLOAD(SO, 1);
  SWAIT(); SWRITE(1, SO); __syncthreads();
  for (int j = 1; j + 1 < NT; j += 2) {
    SBAR(); qkt(pB0, pB1, K_lds + SHM_K, qr, r32, hi);
    finishSM(pA0, pA1, alA, l_reg, pa0, pa1, pa2, pa3); SBAR();
    SLOAD(SE, j + 1); SBAR();
    pv_d0(o, vb0, pa0, pa1, pa2, pa3); NAFIX(pB0, pB1, j); partialSM(pB0, pB1, m_reg, mnB, alB);
    __syncthreads(); SWAIT(); SWRITE(0, SE);
    RESC(alB); __syncthreads();
    SBAR(); qkt(pA0, pA1, K_lds, qr, r32, hi);
    finishSM(pB0, pB1, alB, l_reg, pa0, pa1, pa2, pa3); SBAR();
    SLOAD(SO, j + 2); SBAR();
    pv_d0(o, vb0 + SHM_V, pa0, pa1, pa2, pa3); NAFIX(pA0, pA1, j + 1); partialSM(pA0, pA1, m_reg, mnA, alA);
    __syncthreads(); SWAIT(); SWRITE(1, SO);
    RESC(alA); __syncthreads();
  }
  SBAR(); qkt(pB0, pB1, K_lds + SHM_K, qr, r32, hi);
  finishSM(pA0, pA1, alA, l_reg, pa0, pa1, pa2, pa3); SBAR();
  pv_d0(o, vb0, pa0, pa1, pa2, pa3); NAFIX(pB0, pB1, NT - 1); partialSM(pB0, pB1, m_reg, mnB, alB);
  __syncthreads(); RESC(alB);
  finishSM(pB0, pB1, alB, l_reg, pa0, pa1, pa2, pa3); SBAR();
  pv_d0(o, vb0 + SHM_V, pa0, pa1, pa2, pa3);
  if (hi == 0) li_l[r32] = l_reg; asm volatile("s_waitcnt lgkmcnt(0)" ::: "memory");
  float rli[16];
#pragma unroll
  for (int r = 0; r < 16; ++r) rli[r] = __builtin_amdgcn_rcpf(li_l[crow(r, hi)]);
  __syncthreads();
  bf16_t* ost = (bf16_t*)(lds + wid * 8192);
#pragma unroll
  for (int r = 0; r < 16; ++r) { const int orow = crow(r, hi);
#pragma unroll
    for (int d0 = 0; d0 < 4; ++d0) { const unsigned w = cvt_pk_bf16(o[d0][r] * rli[r], 0.f); ost[orow * 128 + d0 * 32 + r32] = (bf16_t)(w & 0xffffu); } }
  asm volatile("s_waitcnt lgkmcnt(0)" ::: "memory");
  bf16_t* Ow = (bf16_t*)U.Q + (size_t)(wid * QBLK) * LDZ;
  if (!(PROBE_DUP && U.dry)) {
#pragma unroll
  for (int i = 0; i < 8; ++i) { const int id = i * 64 + lane, row = id >> 4, c16 = id & 15;
    *(u32x4*)(Ow + (size_t)row * LDZ + c16 * 8) = *(const u32x4*)(ost + row * 128 + c16 * 8); } }
  __syncthreads();
#undef TILEP
#undef SLOAD
#undef SWRITE
#undef SWAIT
#undef RESC
#undef NAFIX
}
}

struct Args { const float* in[17]; float* out; unsigned char* ws; int ph_lo, ph_hi; };
static_assert(sizeof(Args) == 17 * 8 + 8 + 8 + 8, "Args has no padding");


__device__ __forceinline__ void transpose_item(const float* W, int N, bf16_t* WT, int ldt, LAS float* scr, int kb, int nb, int lane) {
    const int k0 = 64 * kb, n0 = 32 * nb;
#pragma unroll 8
    for (int i = 0; i < 32; ++i) { const int kk = 2 * i + (lane >> 5); scr[kk * 33 + (lane & 31)] = W[(size_t)(k0 + kk) * N + n0 + (lane & 31)]; }
    LDS_WAIT(); asm volatile("" ::: "memory");
    const int c = lane & 7;
#pragma unroll
    for (int j = 0; j < 4; ++j) { const int n = (lane >> 3) + 8 * j; const LAS float* s = scr + (8 * c) * 33 + n;
        u32x4 o; o.x = cvt_pk_bf16(s[0 * 33], s[1 * 33]); o.y = cvt_pk_bf16(s[2 * 33], s[3 * 33]); o.z = cvt_pk_bf16(s[4 * 33], s[5 * 33]); o.w = cvt_pk_bf16(s[6 * 33], s[7 * 33]);
        *(u32x4*)(WT + (size_t)(n0 + n) * ldt + k0 + 8 * c) = o; }
    LDS_WAIT(); asm volatile("" ::: "memory");
}

__device__ __forceinline__ void row_stats(const f32x4 (&v)[8], float& mean, float& rstd, int lane) {
    float s = 0.f;
#pragma unroll
    for (int j = 0; j < 8; ++j) s += (v[j].x + v[j].y) + (v[j].z + v[j].w);
    mean = wave_sum(s, lane) * (1.f / DM); float s2 = 0.f;
#pragma unroll
    for (int j = 0; j < 8; ++j) { const f32x4 d = v[j] - mean; s2 += (d.x * d.x + d.y * d.y) + (d.z * d.z + d.w * d.w); }
    rstd = 1.0f / sqrtf(wave_sum(s2, lane) * (1.f / DM) + LN_EPS);
}
struct LnArgs { int nrows; const float* src_lat; const float* src_ctx; float* dst_lat; float* dst_ctx; bf16_t* H; float* stats; const float* g; const float* b; const float* modl; int shift_j, scale_j; };
__device__ __forceinline__ void ln_load(const LnArgs& a, int m, f32x4 (&v)[8], int lane) {
    const f32x4* sp = (const f32x4*)(m < NLAT ? a.src_lat + (size_t)m * DM : a.src_ctx + (size_t)(m - NLAT) * DM) + 2 * lane;
#pragma unroll
    for (int j = 0; j < 4; ++j) { v[2 * j] = sp[128 * j]; v[2 * j + 1] = sp[128 * j + 1]; }
}
struct LnVecs { f32x4 gg[8], bb[8], sc[8], sh[8]; };
template <int MODE>
__device__ __forceinline__ void ln_process(const LnArgs& a, int m, f32x4 (&v)[8], const LnVecs& V, int lane) {
    const bool lat = m < NLAT;
    float mean, rstd; row_stats(v, mean, rstd, lane);
    if (MODE >= 1) {
        if (MODE == 1 && lane == 0) *(f32x2*)(a.stats + 2 * (size_t)m) = (f32x2){mean, rstd};
        f32x4* dp = (f32x4*)(lat ? a.dst_lat + (size_t)m * DM : a.dst_ctx + (size_t)(m - NLAT) * DM) + 2 * lane;
#pragma unroll
        for (int j = 0; j < 4; ++j)
#pragma unroll
            for (int e = 0; e < 2; ++e) { v[2 * j + e] = (v[2 * j + e] - mean) * rstd * V.gg[2 * j + e] + V.bb[2 * j + e]; if (MODE == 2) dp[128 * j + e] = v[2 * j + e]; }
        if (MODE == 1) row_stats(v, mean, rstd, lane);
    }
    if (MODE <= 1) {
        u32x4* hp = (u32x4*)(a.H + (size_t)m * DM) + lane;
#pragma unroll
        for (int j = 0; j < 4; ++j) { const f32x4 h0 = (v[2 * j] - mean) * rstd * V.sc[2 * j] + V.sh[2 * j], h1 = (v[2 * j + 1] - mean) * rstd * V.sc[2 * j + 1] + V.sh[2 * j + 1];
            u32x4 o; o.x = cvt_pk_bf16(h0.x, h0.y); o.y = cvt_pk_bf16(h0.z, h0.w); o.z = cvt_pk_bf16(h1.x, h1.y); o.w = cvt_pk_bf16(h1.z, h1.w); hp[64 * j] = o; }
    }
}
__device__ __forceinline__ void ln_modvecs(const LnArgs& a, int bi, LnVecs& V, int lane) {
    const float* md = a.modl + (size_t)bi * MODW; const f32x4* scp = (const f32x4*)(md + a.scale_j * DM) + 2 * lane; const f32x4* shp = (const f32x4*)(md + a.shift_j * DM) + 2 * lane;
#pragma unroll
    for (int j = 0; j < 4; ++j)
#pragma unroll
        for (int e = 0; e < 2; ++e) { V.sc[2 * j + e] = scp[128 * j + e] + 1.0f; V.sh[2 * j + e] = shp[128 * j + e]; }
}
template <int MODE>
__device__ __forceinline__ void ln_phase(const LnArgs& a, int gw, int NGW, int lane) {
    const int R = (a.nrows + NGW - 1) / NGW, mbeg = gw * R, mend = min(mbeg + R, a.nrows);
    if (mbeg >= mend) return;
    LnVecs V; int cur_bi = (mbeg < NLAT) ? (mbeg >> 11) : 16;
    if (MODE >= 1) { const f32x4* gp = (const f32x4*)a.g + 2 * lane; const f32x4* bp = (const f32x4*)a.b + 2 * lane;
#pragma unroll
        for (int j = 0; j < 4; ++j)
#pragma unroll
            for (int e = 0; e < 2; ++e) { V.gg[2 * j + e] = gp[128 * j + e]; V.bb[2 * j + e] = bp[128 * j + e]; } }
    if (MODE <= 1) ln_modvecs(a, cur_bi, V, lane);
    f32x4 va[8], vb[8];
    int m = mbeg;
    ln_load(a, m, va, lane);
#define LN_STEP(X, mm) do { if (MODE <= 1) { const int bi_ = ((mm) < NLAT) ? ((mm) >> 11) : 16; if (bi_ != cur_bi) { cur_bi = bi_; ln_modvecs(a, bi_, V, lane); } } ln_process<MODE>(a, (mm), X, V, lane); } while (0)
    while (m < mend) {
        if (m + 1 < mend) ln_load(a, m + 1, vb, lane);
        asm volatile("" ::: "memory");
        LN_STEP(va, m);
        if (m + 1 >= mend) break;
        if (m + 2 < mend) ln_load(a, m + 2, va, lane);
        asm volatile("" ::: "memory");
        LN_STEP(vb, m + 1);
        m += 2;
    }
#undef LN_STEP
}

struct Raw16 { u32x4 a, b; };
__device__ __forceinline__ Raw16 ldraw(const bf16_t* p) { Raw16 r; r.a = *(const u32x4*)p; r.b = *(const u32x4*)(p + 8); return r; }
__device__ __forceinline__ void dec16(const Raw16& r, float (&v)[16]) {
    v[0] = bflo(r.a.x); v[1] = bfhi(r.a.x); v[2] = bflo(r.a.y); v[3] = bfhi(r.a.y); v[4] = bflo(r.a.z); v[5] = bfhi(r.a.z); v[6] = bflo(r.a.w); v[7] = bfhi(r.a.w);
    v[8] = bflo(r.b.x); v[9] = bfhi(r.b.x); v[10] = bflo(r.b.y); v[11] = bfhi(r.b.y); v[12] = bflo(r.b.z); v[13] = bfhi(r.b.z); v[14] = bflo(r.b.w); v[15] = bfhi(r.b.w);
}
__device__ __forceinline__ void store16(bf16_t* p, const float (&v)[16]) {
    u32x4 a, b; a.x = cvt_pk_bf16(v[0], v[1]); a.y = cvt_pk_bf16(v[2], v[3]); a.z = cvt_pk_bf16(v[4], v[5]); a.w = cvt_pk_bf16(v[6], v[7]);
    b.x = cvt_pk_bf16(v[8], v[9]); b.y = cvt_pk_bf16(v[10], v[11]); b.z = cvt_pk_bf16(v[12], v[13]); b.w = cvt_pk_bf16(v[14], v[15]);
    *(u32x4*)p = a; *(u32x4*)(p + 8) = b;
}
__device__ __forceinline__ void qk_norm_rope(const Raw16& raw, bf16_t* p, const float* gain, const float* ropec, const float* ropes, int pos, int lane, bool dry) {
    float v[16]; dec16(raw, v);
    float ss = 0.f;
#pragma unroll
    for (int j = 0; j < 16; ++j) ss += v[j] * v[j];
    ss += shfl_xor_l(ss, 1, lane); ss += shfl_xor_l(ss, 2, lane); ss += shfl_xor_l(ss, 4, lane);
    const float rinv = 1.0f / sqrtf(ss * (1.f / 128.f) + LN_EPS);
    const int l8 = lane & 7;
#pragma unroll
    for (int j = 0; j < 16; ++j) v[j] = v[j] * rinv * gain[l8 * 16 + j];
    if (pos >= 0) {
        const int ti = ((l8 & 4) ? 32 + (pos & 63) : (pos >> 6)) * 32 + 16 * (l8 & 1);
#pragma unroll
        for (int j = 0; j < 16; ++j) { const float pr = shfl_xor_l(v[j], 2, lane); const float c = ropec[ti + j], sn = ropes[ti + j]; v[j] = v[j] * c + ((l8 & 2) ? pr : -pr) * sn; }
    }
    if (!(PROBE_DUP && dry)) store16(p, v);
}
__device__ __forceinline__ void prep_row(bf16_t* zr, int pos, int seqlen, bool rope, bool do_q, bool do_conv, const float* qg, const float* kg, const float* cw, const float* ropec, const float* ropes, int lane, bool dry = false) {
    const int ch = lane * 16; const bool hp = pos > 0, hn = pos < seqlen - 1;
    Raw16 rq, rk, rb, rc, ru, rcp, rup, rcn, run;
    rq = rk = rb = rc = ru = rcp = rup = rcn = run = Raw16{(u32x4){0u, 0u, 0u, 0u}, (u32x4){0u, 0u, 0u, 0u}};
    if (do_q) rq = ldraw(zr + QB0 + ch);
    if (lane < 16) rk = ldraw(zr + KB0 + ch);
    if (do_conv) { rb = ldraw(zr + CB0 + ch); rc = ldraw(zr + CC0 + ch); ru = ldraw(zr + CX0 + ch);
        if (hp) { rcp = ldraw(zr - INW + CC0 + ch); rup = ldraw(zr - INW + CX0 + ch); }
        if (hn) { rcn = ldraw(zr + INW + CC0 + ch); run = ldraw(zr + INW + CX0 + ch); } }
    asm volatile("" ::: "memory");
    if (do_q) qk_norm_rope(rq, zr + QB0 + ch, qg, ropec, ropes, rope ? pos : -1, lane, dry);
    if (lane < 16) qk_norm_rope(rk, zr + KB0 + ch, kg, ropec, ropes, rope ? pos : -1, lane, dry);
    if (do_conv) {
        float bg[16], c1[16], u1[16], accv[16];
        dec16(rb, bg); dec16(rc, c1); dec16(ru, u1);
#pragma unroll
        for (int j = 0; j < 16; ++j) accv[j] = cw[1024 + ch + j] * (c1[j] * u1[j]);
        dec16(rcp, c1); dec16(rup, u1);
#pragma unroll
        for (int j = 0; j < 16; ++j) accv[j] += cw[ch + j] * (c1[j] * u1[j]);
        dec16(rcn, c1); dec16(run, u1);
#pragma unroll
        for (int j = 0; j < 16; ++j) accv[j] += cw[2048 + ch + j] * (c1[j] * u1[j]);
#pragma unroll
        for (int j = 0; j < 16; ++j) accv[j] *= bg[j];
        if (!(PROBE_DUP && dry)) store16(zr + CB0 + ch, accv);
    }
}

typedef const __attribute__((address_space(4))) Args* KArgs;
#define PHASE_CTX \
    KArgs ap = (KArgs)__builtin_amdgcn_kernarg_segment_ptr(); asm volatile("" : "+s"(ap)); \
    const int lane = lane_id_opaque(); const int wave = wave_s; int tid = wave_s * 64 + lane; asm volatile("" : "+v"(tid)); \
    const int G = gridDim.x, bx = blockIdx.x, vcu = (G % 8 == 0) ? (bx % 8) * (G / 8) + bx / 8 : bx; \
    const int gw = vcu * 8 + wave, NGW = G * 8; \
    unsigned char* ws = ap->ws; (void)lane; (void)gw; (void)NGW;
#define WSP(T, off) ((T*)(ws + (off)))

__global__ void __launch_bounds__(512, 2) mk_fwd(Args args) {
    extern __shared__ __attribute__((aligned(16))) unsigned char lds[];
    LAS unsigned char* const ldsl = (LAS unsigned char*)lds;
    {
        const int t0 = threadIdx.x;
        for (int u = t0; u < (LDS_BYTES - LDSCTL_OFF) / 4; u += 512) ((LAS unsigned*)(ldsl + LDSCTL_OFF))[u] = 0u;
    }
    __syncthreads();
    const int wave_s = __builtin_amdgcn_readfirstlane((int)threadIdx.x >> 6);
    const int lo = args.ph_lo, hi = args.ph_hi;
    XcdBarrier bar; bar.bar = (unsigned*)(args.ws + WS_CTL) + CW_BAR; bar.x = 0; bar.st = (volatile LAS unsigned*)(ldsl + MISC_OFF + 32);
    if (hi - lo > 1) bar = xcd_barrier_post((unsigned*)(args.ws + WS_CTL) + CW_BAR, (volatile LAS unsigned*)(ldsl + MISC_OFF + 32));
    int pid = 0;
#define PHASE_BEGIN if (lo <= pid && pid < hi) { PHASE_CTX
#define PHASE_END   if (pid + 1 < hi) { xcd_barrier(bar, tid == 0); if (PROBE_DUP & 16) xcd_barrier(bar, tid == 0); } } ++pid;

    PHASE_BEGIN
    _Pragma("unroll 1") for (int rep = (PROBE_DUP & 4) ? 0 : 1; rep < 2; ++rep)
    {
        const float* c_in = ap->in[1]; const float* cctx_in = ap->in[3]; const float* w_mod = ap->in[4]; const float* b_mod = ap->in[5];
        float* MOD = WSP(float, WS_MOD); float* ROPEC = WSP(float, WS_ROPE); float* ROPES = ROPEC + 96 * 32;
        if (bx < 192) {
            const int l = bx / 96, n0 = (bx % 96) * 128;
            LAS float* cact = (LAS float*)ldsl;
            for (int i = tid; i < 17 * DM; i += 512) { const int b = i >> 11, k = i & 2047; const float v = (b < 16) ? c_in[b * DM + k] : cctx_in[k]; cact[i] = v / (1.0f + __expf(-v)); }
            __syncthreads();
            const int c4 = tid & 31, kg = tid >> 5;
            f32x4 acc[17];
#pragma unroll
            for (int b = 0; b < 17; ++b) acc[b] = (f32x4){0.f, 0.f, 0.f, 0.f};
            const float* wp = w_mod + ((size_t)l * DM + kg * 128) * MODW + n0 + 4 * c4;
            for (int kk = 0; kk < 128; kk += 4) {
                const f32x4 w0 = *(const f32x4*)(wp + (size_t)(kk + 0) * MODW), w1 = *(const f32x4*)(wp + (size_t)(kk + 1) * MODW), w2 = *(const f32x4*)(wp + (size_t)(kk + 2) * MODW), w3 = *(const f32x4*)(wp + (size_t)(kk + 3) * MODW);
#pragma unroll
                for (int b = 0; b < 17; ++b) { const f32x4 a = *(const LAS f32x4*)(cact + b * DM + kg * 128 + kk); acc[b] += w0 * a.x + w1 * a.y + w2 * a.z + w3 * a.w; }
            }
            __syncthreads();
            LAS float* part = (LAS float*)ldsl;
            const int tid2 = wave_s * 64 + lane_id_opaque(), c4b = tid2 & 31, kgb = tid2 >> 5;
#pragma unroll
            for (int b = 0; b < 17; ++b) *(LAS f32x4*)(part + (kgb * 17 + b) * 128 + 4 * c4b) = acc[b];
            __syncthreads();
            for (int o = tid2; o < 17 * 128; o += 512) { const int b = o >> 7, n = o & 127; float sacc = b_mod[l * MODW + n0 + n];
#pragma unroll
                for (int g = 0; g < 16; ++g) sacc += part[(g * 17 + b) * 128 + n];
                MOD[((size_t)l * 17 + b) * MODW + n0 + n] = sacc; }
            __syncthreads();
        } else if (bx == 192) {
            for (int i = tid; i < 96 * 32; i += 512) { const int pos = i >> 5, fi = i & 31; const float p = (float)(pos < 32 ? pos : pos - 32);
                const float freq = powf(10000.0f, -(float)(2 * fi) / 64.0f); const float ang = p * freq; ROPEC[i] = cosf(ang); ROPES[i] = sinf(ang); }
        }
        const float* w_in = ap->in[6]; const float* w_branch = ap->in[11]; const float* w_o = ap->in[12]; const float* w_up = ap->in[13]; const float* w_down = ap->in[14];
        LAS float* scr = (LAS float*)(ldsl + wave * 16384);
        constexpr int I_IN = (DM / 64) * (INW / 32), I_BR = (1024 / 64) * (DM / 32), I_O = (DM / 64) * (DM / 32), I_UP = (DM / 64) * (HID / 32), I_DN = (HID / 64) * (DM / 32);
        constexpr int I_LAYER = I_IN + 3 * I_BR + I_O + I_UP + I_DN;
        for (int it = gw; it < 2 * I_LAYER; it += NGW) {
            const int l = it / I_LAYER; int r = it - l * I_LAYER; unsigned char* wl = ws + WS_W + (size_t)l * W_LAYER;
            if (r < I_IN) { transpose_item(w_in + (size_t)l * DM * INW, INW, (bf16_t*)(wl + W_IN), DM, scr, r / (INW / 32), r % (INW / 32), lane); continue; } r -= I_IN;
            if (r < 3 * I_BR) { const int i = r / I_BR, rr = r % I_BR; transpose_item(w_branch + ((size_t)l * 3 + i) * 1024 * DM, DM, (bf16_t*)(wl + W_BR) + i * 1024, 3072, scr, rr / (DM / 32), rr % (DM / 32), lane); continue; } r -= 3 * I_BR;
            if (r < I_O) { transpose_item(w_o + (size_t)l * DM * DM, DM, (bf16_t*)(wl + W_O), DM, scr, r / (DM / 32), r % (DM / 32), lane); continue; } r -= I_O;
            if (r < I_UP) { transpose_item(w_up + (size_t)l * DM * HID, HID, (bf16_t*)(wl + W_UP), DM, scr, r / (HID / 32), r % (HID / 32), lane); continue; } r -= I_UP;
            transpose_item(w_down + (size_t)l * HID * DM, DM, (bf16_t*)(wl + W_DN), HID, scr, r / (DM / 32), r % (DM / 32), lane);
        }
        if (PROBE_DUP & 4) __syncthreads();
    }
    PHASE_END

    PHASE_BEGIN
    {
        const float* x_in = ap->in[0]; const float* ctx_in = ap->in[2]; const float* MOD = WSP(float, WS_MOD); bf16_t* H = WSP(bf16_t, WS_H);
        const LnArgs la{MALL, x_in, ctx_in, nullptr, nullptr, H, nullptr, nullptr, nullptr, MOD, 0, 1};
        _Pragma("unroll 1") for (int rep = (PROBE_DUP & 8) ? 0 : 1; rep < 2; ++rep)
        ln_phase<0>(la, gw, NGW, lane);
    }
    PHASE_END

    for (int l = 0; l < DEPTH; ++l) {
        const bool with_ctx = (l == 0);
        for (int ch = 0; ch < 2; ++ch) {
            const bool ctx_here = (ch == 0);
            PHASE_BEGIN
            {
                GInProj P; P.H = WSP(bf16_t, WS_H); P.W = (const bf16_t*)(ws + WS_W + (size_t)l * W_LAYER + W_IN); P.Z = WSP(bf16_t, WS_Z); P.ZC = WSP(bf16_t, WS_ZC); P.lda = DM; P.ldb = DM;
                P.tp = TwoPart{ch * PAN_CH, INW / 256, ctx_here ? PAN_CTX : 0, with_ctx ? INW / 256 : (CB0 - KA0) / 256, with_ctx ? 0 : KA0 / 256, G, bx};
                _Pragma("unroll 1") for (int rep = (PROBE_DUP & 1) ? 0 : 1; rep < 2; ++rep) { P.dry = (rep == 0); pg8::gemm_phase<GInProj>(ldsl, P, tid); }
            }
            PHASE_END
            PHASE_BEGIN
            {
                const float* qg = ap->in[8] + l * 128; const float* kg = ap->in[9] + l * 128; const float* cw = ap->in[10] + (size_t)l * 3 * 1024;
                const float* ROPEC = WSP(float, WS_ROPE); const float* ROPES = ROPEC + 96 * 32; bf16_t* Z = WSP(bf16_t, WS_Z); bf16_t* ZC = WSP(bf16_t, WS_ZC);
                const int nrows = CHROWS + (ctx_here ? NCTX : 0);
                _Pragma("unroll 1") for (int rep = (PROBE_DUP & 32) ? 0 : 1; rep < 2; ++rep)
                for (int m = gw; m < nrows; m += NGW) {
                    if (m < CHROWS) prep_row(Z + (size_t)m * INW, m & 2047, SEQ, true, true, true, qg, kg, cw, ROPEC, ROPES, lane, rep == 0);
                    else { const int mc = m - CHROWS; prep_row(ZC + (size_t)mc * INW, mc & 255, CTXL, false, with_ctx, with_ctx, qg, kg, cw, ROPEC, ROPES, lane, rep == 0); }
                }
            }
            PHASE_END
            PHASE_BEGIN
            {
                bf16_t* Z = WSP(bf16_t, WS_Z); bf16_t* ZC = WSP(bf16_t, WS_ZC); const float* rpb = ap->in[7];
                const int n_dense = 512 + ((with_ctx && ctx_here) ? 256 : 0);
                _Pragma("unroll 1") for (int rep = (PROBE_DUP & 2) ? 0 : 1; rep < 2; ++rep) {
                for (int id = bx; id < n_dense; id += G) {
                    att::AUnit A; A.r0 = 0; A.lo = 0; A.rpb = nullptr; A.dry = (rep == 0);
                    if (id < 512) {
                        const int bl = id >> 6, qh = (id >> 3) & 7, qb = id & 7, b = ch * 8 + bl;
                        A.Q = Z + ((size_t)(bl * SEQ + qb * 256) * INW + QB0 + qh * 128);
                        A.P0 = Z + ((size_t)(bl * SEQ) * INW + KB0 + (qh >> 2) * 128); A.P1 = ZC + ((size_t)(b * CTXL) * INW + KB0 + (qh >> 2) * 128);
                        A.nfirst = 32; A.NT = 36; A.vofs = VB0 - KB0;
                    } else {
                        const int i2 = id - 512, b = i2 >> 4, hh = i2 & 15; const bf16_t* zb = ZC + (size_t)(b * CTXL) * INW;
                        if (hh < 8) { A.Q = zb + QA0 + hh * 128; A.P0 = zb + KA0 + hh * 128; A.vofs = VA0 - KA0; }
                        else { const int qh = hh - 8; A.Q = zb + QB0 + qh * 128; A.P0 = zb + KB0 + (qh >> 2) * 128; A.vofs = VB0 - KB0; }
                        A.P1 = A.P0; A.nfirst = 4; A.NT = 4;
                    }
                    att::attn_unit<false>(A, (char*)lds, tid);
                }
                for (int id = bx; id < 512; id += G) {
                    int bl, h, r0;
                    if (id < 384) { bl = id / 48; const int rem = id % 48; h = rem / 6; r0 = 4 + 4 * (rem % 6); }
                    else { const int i2 = id - 384; bl = i2 >> 4; h = (i2 >> 1) & 7; r0 = (i2 & 1) ? 28 : 0; }
                    const int b = ch * 8 + bl; const bool edge = (r0 == 0 || r0 == 28); const int lo_ = (r0 == 0) ? 0 : (r0 == 28 ? 24 : r0 - 4);
                    att::AUnit A; A.Q = Z + ((size_t)(bl * SEQ + r0 * 64) * INW + QA0 + h * 128);
                    A.P0 = ZC + ((size_t)(b * CTXL) * INW + KA0 + h * 128); A.P1 = Z + ((size_t)(bl * SEQ + lo_ * 64) * INW + KA0 + h * 128);
                    A.nfirst = 4; A.NT = 4 + (edge ? 8 : 12); A.vofs = VA0 - KA0; A.r0 = r0; A.lo = lo_; A.rpb = rpb + ((size_t)l * 8 + h) * 15 * 31; A.dry = (rep == 0);
                    att::attn_unit<true>(A, (char*)lds, tid);
                }
                }
            }
            PHASE_END
            PHASE_BEGIN
            {
                GBranch P; P.Z = WSP(bf16_t, WS_Z); P.ZC = WSP(bf16_t, WS_ZC); P.W = (const bf16_t*)(ws + WS_W + (size_t)l * W_LAYER + W_BR); P.Hout = WSP(bf16_t, WS_H); P.lda = INW; P.ldb = 3072;
                P.tp = TwoPart{ch * PAN_CH, DM / 256, (with_ctx && ctx_here) ? PAN_CTX : 0, DM / 256, 0, G, bx};
                _Pragma("unroll 1") for (int rep = (PROBE_DUP & 1) ? 0 : 1; rep < 2; ++rep) { P.dry = (rep == 0); pg8::gemm_phase<GBranch>(ldsl, P, tid); }
            }
            PHASE_END
            PHASE_BEGIN
            {
                GWo P; P.A_lat = WSP(bf16_t, WS_H); P.A_ctx = P.A_lat + (size_t)NLAT * DM; P.a_lat0 = 0; P.W = (const bf16_t*)(ws + WS_W + (size_t)l * W_LAYER + W_O); P.lda = DM; P.ldb = DM;
                P.res_lat = (l == 0) ? ap->in[0] : (const float*)ap->out; P.res_ctx = ap->in[2]; P.out_lat = ap->out; P.out_ctx = WSP(float, WS_CTXS); P.mod = WSP(float, WS_MOD) + (size_t)l * 17 * MODW; P.modj = 2;
                P.lnres = (l > 0); P.stats = WSP(float, WS_STATS); P.lg = ap->in[15] + (size_t)((l > 0 ? l - 1 : 0) * 2 + 1) * DM; P.lb = ap->in[16] + (size_t)((l > 0 ? l - 1 : 0) * 2 + 1) * DM;
                P.tp = TwoPart{ch * PAN_CH, DM / 256, (with_ctx && ctx_here) ? PAN_CTX : 0, DM / 256, 0, G, bx};
                _Pragma("unroll 1") for (int rep = (PROBE_DUP & 1) ? 0 : 1; rep < 2; ++rep) { P.dry = (rep == 0); pg8::gemm_phase<GWo>(ldsl, P, tid); }
            }
            PHASE_END
        }
        PHASE_BEGIN
        {
            const int nrows = with_ctx ? MALL : NLAT; const float* g = ap->in[15] + (size_t)(l * 2 + 0) * DM; const float* bb = ap->in[16] + (size_t)(l * 2 + 0) * DM;
            float* OUT = ap->out; float* CTXS = WSP(float, WS_CTXS); bf16_t* H = WSP(bf16_t, WS_H); const float* MODL = WSP(float, WS_MOD) + (size_t)l * 17 * MODW;
            const LnArgs la{nrows, OUT, CTXS, OUT, CTXS, H, WSP(float, WS_STATS), g, bb, MODL, 3, 4};
            ln_phase<1>(la, gw, NGW, lane);
        }
        PHASE_END
        for (int ch = 0; ch < 2; ++ch) {
            const bool ctx_here = (ch == 0) && with_ctx;
            PHASE_BEGIN
            {
                GUp P; P.H = WSP(bf16_t, WS_H); P.W = (const bf16_t*)(ws + WS_W + (size_t)l * W_LAYER + W_UP); P.U = WSP(bf16_t, WS_Z); P.lda = DM; P.ldb = DM;
                P.tp = TwoPart{ch * PAN_CH, HID / 256, ctx_here ? PAN_CTX : 0, HID / 256, 0, G, bx};
                _Pragma("unroll 1") for (int rep = (PROBE_DUP & 1) ? 0 : 1; rep < 2; ++rep) { P.dry = (rep == 0); pg8::gemm_phase<GUp>(ldsl, P, tid); }
            }
            PHASE_END
            PHASE_BEGIN
            {
                GDown P; P.A_lat = WSP(bf16_t, WS_Z); P.A_ctx = P.A_lat + (size_t)CHROWS * HID; P.a_lat0 = ch * PAN_CH; P.W = (const bf16_t*)(ws + WS_W + (size_t)l * W_LAYER + W_DN); P.lda = HID; P.ldb = HID;
                P.res_lat = ap->out; P.res_ctx = WSP(float, WS_CTXS); P.out_lat = ap->out; P.out_ctx = WSP(float, WS_CTXS); P.mod = WSP(float, WS_MOD) + (size_t)l * 17 * MODW; P.modj = 5;
                P.lnres = 1; P.stats = WSP(float, WS_STATS); P.lg = ap->in[15] + (size_t)(l * 2 + 0) * DM; P.lb = ap->in[16] + (size_t)(l * 2 + 0) * DM;
                P.tp = TwoPart{ch * PAN_CH, DM / 256, ctx_here ? PAN_CTX : 0, DM / 256, 0, G, bx};
                _Pragma("unroll 1") for (int rep = (PROBE_DUP & 1) ? 0 : 1; rep < 2; ++rep) { P.dry = (rep == 0); pg8::gemm_phase<GDown>(ldsl, P, tid); }
            }
            PHASE_END
        }
        PHASE_BEGIN
        {
            const int nrows = with_ctx ? MALL : NLAT; const float* g = ap->in[15] + (size_t)(l * 2 + 1) * DM; const float* bb = ap->in[16] + (size_t)(l * 2 + 1) * DM;
            float* OUT = ap->out; float* CTXS = WSP(float, WS_CTXS); bf16_t* H = WSP(bf16_t, WS_H); const float* MODN = WSP(float, WS_MOD) + (size_t)(l + 1) * 17 * MODW;
            const LnArgs la{nrows, OUT, CTXS, OUT, CTXS, H, WSP(float, WS_STATS), g, bb, MODN, 0, 1};
            if (l + 1 < DEPTH) ln_phase<1>(la, gw, NGW, lane);
            else ln_phase<2>(la, gw, NGW, lane);
        }
        PHASE_END
    }
#undef PHASE_BEGIN
#undef PHASE_END
}
constexpr int N_PHASES = 2 + DEPTH * (2 * 5 + 1 + 2 * 2 + 1);

extern "C" void kernel_launch(void* const* d_in, const int* in_sizes, int n_in, void* d_out, int out_size, void* d_ws, size_t ws_size, hipStream_t stream) {
    static int grid = 0;
    if (grid == 0) {
        if (n_in != 17 || in_sizes[0] != NLAT * DM || out_size != NLAT * DM || ws_size < WS_END) { fprintf(stderr, "kernel_launch: shape / workspace mismatch (ws %zu, need %zu)\n", ws_size, (size_t)WS_END); grid = -1; return; }
        int dev = 0, cus = 0, per_cu = 0;
        if (hipGetDevice(&dev) != hipSuccess || hipDeviceGetAttribute(&cus, hipDeviceAttributeMultiprocessorCount, dev) != hipSuccess) { grid = -1; return; }
        if (hipFuncSetAttribute((const void*)mk_fwd, hipFuncAttributeMaxDynamicSharedMemorySize, LDS_BYTES) != hipSuccess) { fprintf(stderr, "kernel_launch: hipFuncSetAttribute failed\n"); grid = -1; return; }
        if (hipOccupancyMaxActiveBlocksPerMultiprocessor(&per_cu, (const void*)mk_fwd, 512, LDS_BYTES) != hipSuccess || per_cu < 1) fprintf(stderr, "kernel_launch: occupancy query says %d\n", per_cu);
        (void)hipGetLastError();
        grid = cus;
    }
    if (grid < 0) return;
    if (hipMemsetAsync((char*)d_ws + WS_CTL, 0, CTL_ZERO_BYTES, stream) != hipSuccess) return;
    Args a{};
    for (int i = 0; i < 17; ++i) a.in[i] = (const float*)d_in[i];
    a.out = (float*)d_out; a.ws = (unsigned char*)d_ws;
#if MK_PER_PHASE
    for (int p = 0; p < N_PHASES; ++p) { a.ph_lo = p; a.ph_hi = p + 1; hipLaunchKernelGGL(mk_fwd, dim3(grid), dim3(512), LDS_BYTES, stream, a); }
#else
    a.ph_lo = 0; a.ph_hi = N_PHASES;
    hipLaunchKernelGGL(mk_fwd, dim3(grid), dim3(512), LDS_BYTES, stream, a);
#endif
    const hipError_t le = hipPeekAtLastError();
    if (le != hipSuccess) fprintf(stderr, "kernel_launch: launch failed: %s\n", hipGetErrorName(le));
}
```

```cpp
#include <hip/hip_runtime.h>
#include <cstdio>
#include <cstdint>
#include <cmath>

#define LAS __attribute__((address_space(3)))
#define GAS __attribute__((address_space(1)))
typedef unsigned short bf16_t;
typedef short bf16x8 __attribute__((ext_vector_type(8)));
typedef short bf16x16_t __attribute__((ext_vector_type(16)));
typedef short s16x4 __attribute__((ext_vector_type(4)));
typedef float f32x4 __attribute__((ext_vector_type(4)));
typedef float f32x2 __attribute__((ext_vector_type(2)));
typedef float f32x16 __attribute__((ext_vector_type(16)));
typedef unsigned u32x4 __attribute__((ext_vector_type(4)));
typedef unsigned u32x2 __attribute__((ext_vector_type(2)));
typedef int i32x8 __attribute__((ext_vector_type(8)));

#ifndef PROBE_DUP
#define PROBE_DUP 0
#endif
#ifndef STAGGER_TICKS
#define STAGGER_TICKS 0
#endif
#ifndef PROBE_REAL
#define PROBE_REAL 0
#endif
#ifndef PROBE_GEMM_MASK
#define PROBE_GEMM_MASK 31
#endif
#ifndef MK_PER_PHASE
#define MK_PER_PHASE 0
#endif

constexpr int DM = 2048, NB = 16, SEQ = 2048, CTXL = 256, HD = 128, HID = 8192, DEPTH = 2;
constexpr int QA0 = 0, QB0 = 1024, KA0 = 2048, VA0 = 3072, KB0 = 4096, VB0 = 4352, CB0 = 4608, CC0 = 5632, CX0 = 6656, G0 = 7680, INW = 13824;
constexpr int NLAT = NB * SEQ, NCTX = NB * CTXL, MALL = NLAT + NCTX;
constexpr int CHROWS = 16384, PAN_CH = 64, PAN_LAT = 128, PAN_CTX = 16;
constexpr float LN_EPS = 1e-6f, DN_ALPHA = 1.4142135623730951f, ATT_SCALE = 0.08838834764831845f;
constexpr int MODW = 6 * DM;

constexpr size_t MiB = 1u << 20;
constexpr size_t WS_CTL = 0, CTL_ZERO_BYTES = 1 * MiB;
constexpr size_t WS_MOD = 1 * MiB;
constexpr size_t WS_ROPE = 3 * MiB;
constexpr size_t WS_STATS = 3 * MiB + 512 * 1024;
constexpr int NQKV = CB0 / 256, NCV = (G0 - CB0) / 256, NGT = (INW - G0) / 256, N8 = NQKV + NGT;
constexpr size_t WS_W = 4 * MiB;
constexpr size_t W_IN = 0, W_G8 = 12 * MiB, W_BR = 34 * MiB, W_O = 46 * MiB, W_UP = 54 * MiB, W_DN = 86 * MiB, W_LAYER = 126 * MiB;
constexpr size_t WS_CTXS = 256 * MiB;
constexpr size_t WS_H = 272 * MiB;
constexpr size_t WS_H8 = 416 * MiB;
constexpr size_t WS_ZC = 488 * MiB;
constexpr size_t WS_Z = 596 * MiB;
constexpr size_t WS_END = 1028 * MiB;
constexpr size_t WS_U0 = WS_END - (size_t)(CHROWS + NCTX) * HID * 2, WS_U1 = WS_H8;
static_assert(WS_U1 + (size_t)CHROWS * HID * 2 <= WS_U0 && WS_U0 >= WS_Z, "U buffers");
static_assert(WS_W + 2 * W_LAYER <= WS_CTXS && WS_CTXS + (size_t)NCTX * DM * 2 <= WS_H && WS_H + (size_t)MALL * DM * 2 <= WS_H8 && WS_H8 + (size_t)MALL * DM <= WS_ZC && WS_ZC + (size_t)NCTX * INW * 2 <= WS_Z && WS_Z + (size_t)CHROWS * INW * 2 <= WS_END, "ws map");
static_assert((size_t)(G0 - CB0) * DM * 2 <= W_G8 && W_G8 + (size_t)N8 * 256 * DM <= W_BR, "weight map");
static_assert((size_t)(CHROWS + NCTX) * HID * 2 <= WS_END - WS_Z, "U overlay");
constexpr int CW_TMO = 0, CW_BAR = 4096;

constexpr int RING_BYTES = 131072;
constexpr int SCR_BYTES = 139264;
constexpr int LDSCTL_OFF = SCR_BYTES, MISC_OFF = LDSCTL_OFF + 64;
constexpr int LDS_BYTES = 147456;

#define RLX_AGENT __ATOMIC_RELAXED, __HIP_MEMORY_SCOPE_AGENT
#define LDS_WAIT() asm volatile("s_waitcnt lgkmcnt(0)" ::: "memory")
#define VM_WAIT() asm volatile("s_waitcnt vmcnt(0)" ::: "memory")
typedef float f32x2_cv __attribute__((ext_vector_type(2))); typedef __bf16 bf16x2_cv __attribute__((ext_vector_type(2)));
__device__ __forceinline__ unsigned cvt_pk_bf16(float lo, float hi) { const f32x2_cv v = {lo, hi}; const bf16x2_cv b = __builtin_convertvector(v, bf16x2_cv); return __builtin_bit_cast(unsigned, b); }
__device__ __forceinline__ float bflo(unsigned w) { return __uint_as_float(w << 16); }
__device__ __forceinline__ float bfhi(unsigned w) { return __uint_as_float(w & 0xffff0000u); }
typedef _Float16 h16x2 __attribute__((ext_vector_type(2)));
__device__ __forceinline__ unsigned pk_h2(float a, float b) { a = __builtin_amdgcn_fmed3f(a, -60000.f, 60000.f); b = __builtin_amdgcn_fmed3f(b, -60000.f, 60000.f); h16x2 h = {(_Float16)a, (_Float16)b}; return __builtin_bit_cast(unsigned, h); }
__device__ __forceinline__ f32x2 un_h2(unsigned w) { const h16x2 h = __builtin_bit_cast(h16x2, w); return (f32x2){(float)h.x, (float)h.y}; }
__device__ __forceinline__ void un_h8(const u32x4 w, f32x4& lo, f32x4& hi) { const f32x2 a = un_h2(w.x), b = un_h2(w.y), c = un_h2(w.z), d = un_h2(w.w); lo = (f32x4){a.x, a.y, b.x, b.y}; hi = (f32x4){c.x, c.y, d.x, d.y}; }
constexpr float G8_WSCALE = 32.0f;
__device__ __forceinline__ unsigned pk_fp8x4(float a, float b, float c, float d) { int v = __builtin_amdgcn_cvt_pk_fp8_f32(a, b, 0, false); v = __builtin_amdgcn_cvt_pk_fp8_f32(c, d, v, true); return (unsigned)v; }
__device__ __forceinline__ int lane_id_opaque() { int l; asm volatile("v_mbcnt_lo_u32_b32 %0, -1, 0\n\tv_mbcnt_hi_u32_b32 %0, -1, %0" : "=v"(l)); return l; }
__device__ __forceinline__ float shfl_xor_l(float v, int mask, int lane) { return __uint_as_float((unsigned)__builtin_amdgcn_ds_bpermute((lane ^ mask) << 2, (int)__float_as_uint(v))); }
__device__ __forceinline__ float wave_sum(float v, int lane) {
#pragma unroll
    for (int o = 1; o < 64; o <<= 1) v += shfl_xor_l(v, o, lane);
    return v;
}

#define XB_TMO      128
#define XB_XCNT(j)  (256  + 64 * (j))
#define XB_XSUB(j)  (1280 + 64 * (j))
#define XB_XGEN(j)  (2304 + 64 * (j))
#define XB_TOP      3328
#define XB_TOPGEN   3392
#define XCD_BAR_WORDS 3456
#define XB_SPIN_CAP (1u << 20)
__device__ __forceinline__ unsigned xb_ld(unsigned* p)              { return __hip_atomic_load(p, __ATOMIC_RELAXED, __HIP_MEMORY_SCOPE_AGENT); }
__device__ __forceinline__ unsigned xb_add(unsigned* p, unsigned v) { return __hip_atomic_fetch_add(p, v, __ATOMIC_RELAXED, __HIP_MEMORY_SCOPE_AGENT); }
__device__ __forceinline__ unsigned xb_xcc_id() { return (unsigned)__builtin_amdgcn_s_getreg((3 << 11) | 20) & 0xFu; }
#define XB_SPIN(cond, bar) do { unsigned _sp = 0; while (cond) { __builtin_amdgcn_s_sleep(1); \
    if ((++_sp & 255u) == 0u) { if (xb_ld(&(bar)[XB_TMO])) break; if (_sp > XB_SPIN_CAP) { atomicAdd(&(bar)[XB_TMO], 1u); break; } } } } while (0)
struct XcdBarrier { unsigned* bar; unsigned x; volatile LAS unsigned* st; };
__device__ __forceinline__ XcdBarrier xcd_barrier_post(unsigned* bar, volatile LAS unsigned* st) {
    XcdBarrier b; b.bar = bar; b.x = xb_xcc_id(); b.st = st;
    if (threadIdx.x == 0) (void)xb_add(&bar[XB_XCNT(b.x)], 1u);
    return b;
}
__device__ __forceinline__ void xcd_barrier_complete(unsigned* bar, unsigned x, unsigned& nloc, unsigned& nx) {
    const unsigned G = gridDim.x * gridDim.y * gridDim.z;
    unsigned sum, cnt, mine, sp = 0u;
    for (;;) {
        sum = 0u; cnt = 0u; mine = 0u;
#pragma unroll
        for (unsigned j = 0; j < 16; ++j) { const unsigned c = xb_ld(&bar[XB_XCNT(j)]); sum += c; cnt += (c > 0u) ? 1u : 0u; mine = (j == x) ? c : mine; }
        if (sum == G) break;
        __builtin_amdgcn_s_sleep(1);
        if ((++sp & 255u) == 0u) { if (xb_ld(&bar[XB_TMO])) break; if (sp > XB_SPIN_CAP) { atomicAdd(&bar[XB_TMO], 1u); break; } }
    }
    nloc = mine > 0u ? mine : 1u; nx = cnt > 0u ? cnt : 1u;
}
__device__ __forceinline__ void xcd_barrier(const XcdBarrier& b, const bool leader) {
    asm volatile("s_waitcnt vmcnt(0)" ::: "memory");
    __syncthreads();
    if (leader) {
        unsigned* bar = b.bar;
        __builtin_amdgcn_s_waitcnt(0);
        unsigned nloc = b.st[0], nx = b.st[1];
        if (nloc == 0u) { xcd_barrier_complete(bar, b.x, nloc, nx); b.st[0] = nloc; b.st[1] = nx; }
        const unsigned old = xb_add(&bar[XB_XSUB(b.x)], 1u);
        const unsigned gen = old / nloc;
        if (old + 1u == (gen + 1u) * nloc) {
            __builtin_amdgcn_fence(__ATOMIC_RELEASE, "agent");
            asm volatile("s_waitcnt vmcnt(0)" ::: "memory");
            const unsigned og = xb_add(&bar[XB_TOP], 1u);
            const unsigned tg = og / nx;
            if (og + 1u == (tg + 1u) * nx) xb_add(&bar[XB_TOPGEN], 1u);
            else XB_SPIN(xb_ld(&bar[XB_TOPGEN]) == tg, bar);
            __builtin_amdgcn_fence(__ATOMIC_ACQUIRE, "agent");
            xb_add(&bar[XB_XGEN(b.x)], 1u);
            asm volatile("s_waitcnt vmcnt(0)" ::: "memory");
        } else {
            XB_SPIN(xb_ld(&bar[XB_XGEN(b.x)]) == gen, bar);
            __builtin_amdgcn_fence(__ATOMIC_ACQUIRE, "agent");
            asm volatile("s_waitcnt vmcnt(0)" ::: "memory");
        }
    }
    __syncthreads();
}

namespace pg8 {
constexpr int BM = 256, BK = 64, HALF = 128, HTB = HALF * BK * 2, STAGE_BYTES = 8 * HTB;
__host__ __device__ __forceinline__ int lds_byte(int r, int c) { const int st = (r >> 4) * 2 + (c >> 5), rr = r & 15, cc = c & 31, ob = rr * 64 + cc * 2; return st * 1024 + (ob ^ (((ob >> 9) & 1) << 5)); }
__host__ __device__ __forceinline__ void stage_rc(int b, int& R, int& C) { const int st = b / 1024, sb = b % 1024, swz = sb ^ (((sb >> 9) & 1) << 5); R = (st >> 1) * 16 + swz / 64; C = (st & 1) * 32 + (swz % 64) / 2; }
__host__ __device__ __forceinline__ int perm32(int rho) { const int n = rho >> 4, i = rho & 15; return 8 * (i >> 2) + 4 * n + (i & 3); }
struct Unit { int pm, pn, seg; };
__device__ __forceinline__ void tile_map(int L, int nwg, int nM, int nN, int& pm, int& pn) {
    const int q = nwg / 8, r = nwg % 8, xcd = L % 8, off = L / 8;
    const int wgid = (xcd < r ? xcd * (q + 1) : r * (q + 1) + (xcd - r) * q) + off;
    const int sh = (nN <= 8) ? 2 : 3, WG = 1 << sh;
    const int nig = WG * nN, gid = wgid / nig, rem = wgid - gid * nig; (void)nM;
    pm = gid * WG + (rem & (WG - 1)); pn = rem >> sh;
}

template <class P>
__device__ __forceinline__ void gemm_phase(LAS unsigned char* lds, const P& p, const int tid) {
    const int wid = __builtin_amdgcn_readfirstlane(tid >> 6), lane = tid & 63, wr = wid >> 2, wc = wid & 3, fr = lane & 15, fq = lane >> 4;
    constexpr int nt = P::NT;
    unsigned voffA[2], voffB[2];
#pragma unroll
    for (int i = 0; i < 2; ++i) { int R, C; stage_rc(tid * 16 + i * 8192, R, C); const int Rb = P::PERM ? ((R & ~31) + perm32(R & 31)) : R;
        voffA[i] = (unsigned)(R * p.lda + C) * 2u; voffB[i] = (unsigned)(Rb * p.ldb + C) * 2u; }
    const size_t kstepA = (size_t)p.kstepA, kstepB = (size_t)p.kstepB;
    const size_t hstepA = (size_t)HALF * p.lda * 2, hstepB = (size_t)HALF * p.ldb * 2;
    const unsigned ldsw = (unsigned)wid * 1024u;
    const int aoff = P::FP8 ? lds_byte(wr * 64 + fr, fq * 16) : lds_byte(wr * 64 + fr, fq * 8), boff = P::FP8 ? lds_byte(wc * 32 + fr, fq * 16) : lds_byte(wc * 32 + fr, fq * 8);
#define PG8_SA(b, h) (((b) * 2 + (h)) * HTB)
#define PG8_SB(b, h) ((4 + (b) * 2 + (h)) * HTB)
#define PG8_STAGE(bufoff, gbase, voff) do { _Pragma("unroll") for (int _i = 0; _i < 2; ++_i) \
        __builtin_amdgcn_global_load_lds((const unsigned*)((const char*)(gbase) + (voff)[_i]), (LAS unsigned*)(lds + (bufoff) + ldsw + _i * 8192), 16, 0, 0); } while (0)
typedef int i32x4_t __attribute__((ext_vector_type(4)));
#define PG8_LD32(p) __builtin_shufflevector(*(const LAS i32x4_t*)(p), *(const LAS i32x4_t*)((p) + 16), 0, 1, 2, 3, 4, 5, 6, 7)
#define PG8_LDA(dst, b, h) do { if constexpr (P::FP8) { _Pragma("unroll") for (int m = 0; m < 4; ++m) dst##8[m] = PG8_LD32(lds + PG8_SA(b, h) + aoff + m * 2048); } \
        else { _Pragma("unroll") for (int m = 0; m < 4; ++m) _Pragma("unroll") for (int k = 0; k < 2; ++k) dst[m][k] = *(const LAS bf16x8*)(lds + PG8_SA(b, h) + aoff + m * 2048 + k * 1024); } } while (0)
#define PG8_LDB(dst, b, h) do { if constexpr (P::FP8) { _Pragma("unroll") for (int n = 0; n < 2; ++n) dst##8[n] = PG8_LD32(lds + PG8_SB(b, h) + boff + n * 2048); } \
        else { _Pragma("unroll") for (int n = 0; n < 2; ++n) _Pragma("unroll") for (int k = 0; k < 2; ++k) dst[n][k] = *(const LAS bf16x8*)(lds + PG8_SB(b, h) + boff + n * 2048 + k * 1024); } } while (0)
#define PG8_MMA(ai, bj, At, Bt) do { __builtin_amdgcn_s_setprio(1); _Pragma("unroll") for (int m = 0; m < 4; ++m) _Pragma("unroll") for (int n = 0; n < 2; ++n) { \
        if constexpr (P::FP8) asm volatile("v_mfma_f32_16x16x128_f8f6f4 %0, %1, %2, %0" : "+v"(acc[ai][bj][m][n]) : "v"(Bt##8[n]), "v"(At##8[m])); \
        else { _Pragma("unroll") for (int k = 0; k < 2; ++k) acc[ai][bj][m][n] = __builtin_amdgcn_mfma_f32_16x16x32_bf16(Bt[n][k], At[m][k], acc[ai][bj][m][n], 0, 0, 0); } } __builtin_amdgcn_s_setprio(0); } while (0)
#define PG8_WAIT_V(n) asm volatile("s_waitcnt vmcnt(" #n ")" ::: "memory")
#define PG8_WAIT_L(n) asm volatile("s_waitcnt lgkmcnt(" #n ")" ::: "memory")
#define PG8_BAR __builtin_amdgcn_s_barrier()
#define PG8_SCHED __builtin_amdgcn_sched_barrier(0)
    Unit cur, nxt; int ui = 0;
    if (!p.next(0, cur)) return;
    if (STAGGER_TICKS > 0) {
        const unsigned long long t0 = __builtin_amdgcn_s_memrealtime(), dl = (unsigned long long)(((unsigned)blockIdx.x >> 3) & 7u) * STAGGER_TICKS;
        while (__builtin_amdgcn_s_memrealtime() - t0 < dl) __builtin_amdgcn_s_sleep(4);
    }
    f32x4 acc[2][2][4][2];
#pragma unroll
    for (int a = 0; a < 2; ++a)
#pragma unroll
        for (int b = 0; b < 2; ++b)
#pragma unroll
            for (int m = 0; m < 4; ++m)
#pragma unroll
                for (int n = 0; n < 2; ++n) acc[a][b][m][n] = (f32x4){0.f, 0.f, 0.f, 0.f};
    bf16x8 At[4][2], B0[2][2], B1[2][2]; i32x8 At8[4], B08[2], B18[2]; (void)At; (void)B0; (void)B1; (void)At8; (void)B08; (void)B18;
    const char* cA = p.a_ptr(cur); const char* cB = p.b_ptr(cur);
    PG8_STAGE(PG8_SB(0, 0), cB, voffB); PG8_STAGE(PG8_SB(0, 1), cB + hstepB, voffB); PG8_STAGE(PG8_SA(0, 0), cA, voffA); PG8_STAGE(PG8_SA(0, 1), cA + hstepA, voffA);
    if (wr == 1) PG8_BAR;
    PG8_WAIT_V(2); PG8_BAR;
    PG8_STAGE(PG8_SB(1, 0), cB + kstepB, voffB); PG8_STAGE(PG8_SA(1, 0), cA + kstepA, voffA); PG8_STAGE(PG8_SB(1, 1), cB + hstepB + kstepB, voffB);
    PG8_WAIT_V(6); PG8_BAR;
    for (;;) {
        const bool has_next = p.next(ui + 1, nxt);
        const char* nA = has_next ? p.a_ptr(nxt) : cA; const char* nB = has_next ? p.b_ptr(nxt) : cB;
        _Pragma("nounroll") for (int t = 0; t < nt; t += 2) {
            const bool last = (t == nt - 2);
            const char* a1 = cA + (size_t)(t + 1) * kstepA;
            const char* a2 = last ? nA : cA + (size_t)(t + 2) * kstepA; const char* b2 = last ? nB : cB + (size_t)(t + 2) * kstepB;
            const char* a3 = a2 + kstepA; const char* b3 = b2 + kstepB;
            PG8_LDB(B0, 0, 0); PG8_LDB(B1, 0, 1); PG8_SCHED; PG8_LDA(At, 0, 0); PG8_STAGE(PG8_SA(1, 1), a1 + hstepA, voffA);
            PG8_WAIT_V(8); PG8_WAIT_L(0); PG8_BAR; PG8_MMA(0, 0, At, B0); PG8_MMA(0, 1, At, B1); PG8_BAR; PG8_SCHED;
            PG8_LDA(At, 0, 1); PG8_STAGE(PG8_SB(0, 0), b2, voffB); PG8_STAGE(PG8_SB(0, 1), b2 + hstepB, voffB); PG8_STAGE(PG8_SA(0, 0), a2, voffA);
            PG8_WAIT_V(8); PG8_WAIT_L(0); PG8_BAR; PG8_MMA(1, 0, At, B0); PG8_MMA(1, 1, At, B1); PG8_BAR; PG8_SCHED;
            PG8_LDB(B0, 1, 0); PG8_LDB(B1, 1, 1); PG8_SCHED; PG8_LDA(At, 1, 0); PG8_STAGE(PG8_SA(0, 1), a2 + hstepA, voffA);
            PG8_WAIT_V(8); PG8_WAIT_L(0); PG8_BAR; PG8_MMA(0, 0, At, B0); PG8_MMA(0, 1, At, B1); PG8_BAR; PG8_SCHED;
            PG8_LDA(At, 1, 1); PG8_STAGE(PG8_SB(1, 0), b3, voffB); PG8_STAGE(PG8_SB(1, 1), b3 + hstepB, voffB); PG8_STAGE(PG8_SA(1, 0), a3, voffA);
            PG8_WAIT_V(8); PG8_WAIT_L(0); PG8_BAR; PG8_MMA(1, 0, At, B0); PG8_MMA(1, 1, At, B1); PG8_BAR; PG8_SCHED;
        }
        if (wr == 0) PG8_BAR;
        if constexpr (P::FP8) asm volatile("s_nop 15\n\ts_nop 15" ::: "memory");
        p.epi(acc, cur, wr, wc, fr, fq);
        if (!has_next) break;
        if (!p.keep(cur)) {
#pragma unroll
            for (int a = 0; a < 2; ++a)
#pragma unroll
                for (int b = 0; b < 2; ++b)
#pragma unroll
                    for (int m = 0; m < 4; ++m)
#pragma unroll
                        for (int n = 0; n < 2; ++n) acc[a][b][m][n] = (f32x4){0.f, 0.f, 0.f, 0.f};
        }
        cur = nxt; cA = nA; cB = nB; ++ui;
        if (wr == 1) PG8_BAR;
    }
    PG8_WAIT_V(0);
    PG8_BAR;
#undef PG8_SA
#undef PG8_SB
#undef PG8_STAGE
#undef PG8_LDA
#undef PG8_LDB
#undef PG8_MMA
#undef PG8_WAIT_V
#undef PG8_WAIT_L
#undef PG8_BAR
#undef PG8_SCHED
}
}
using pg8::Unit;

struct TwoPart {
    int lat0, nNa, nMb, nNb, pn0b, G, c, pmb0;
    __device__ __forceinline__ bool map(int L, Unit& u) const {
        const int nA = PAN_CH * nNa, nB = nMb * nNb; int pm, pn;
        if (L < nA) { pg8::tile_map(L, nA, PAN_CH, nNa, pm, pn); u.pm = lat0 + pm; u.pn = pn; return true; }
        if (L < nA + nB) { pg8::tile_map(L - nA, nB, nMb, nNb, pm, pn); u.pm = pmb0 + pm; u.pn = pn0b + pn; return true; }
        return false;
    }
};
__device__ __forceinline__ int skew_deal(int i, int G, int c, int nlo, int cbase, int span) {
    if (i < nlo) return i * G + c;
    return ((unsigned)(c - cbase) < (unsigned)span) ? nlo * G + (i - nlo) * span + (c - cbase) : 0x3fffffff;
}
__device__ __forceinline__ float sigmoid_c(float x) { x = fminf(fmaxf(x, -30.f), 30.f); return __builtin_amdgcn_rcpf(1.f + __builtin_amdgcn_exp2f(-1.4426950408889634f * x)); }

__device__ __forceinline__ unsigned gate_u8(float x) { const unsigned q = (unsigned)(sigmoid_c(x) * 255.f + 0.5f); return q < 1u ? 1u : q; }
__device__ __forceinline__ void epi_z(const f32x4 (&acc)[2][2][4][2], bf16_t* base, int pn, bool gate, float scale, int wr, int wc, int fr, int fq) {
    int row0 = wr * 64 + fr, col0 = pn * 256 + wc * 32 + 8 * fq;
    asm volatile("" : "+v"(row0), "+v"(col0));
#pragma unroll
    for (int ai = 0; ai < 2; ++ai)
#pragma unroll
        for (int m = 0; m < 4; ++m) { bf16_t* rowp = base + (size_t)(row0 + ai * 128 + m * 16) * INW + col0;
#pragma unroll
            for (int bj = 0; bj < 2; ++bj) { f32x4 v0 = acc[ai][bj][m][0], v1 = acc[ai][bj][m][1];
                v0 = v0 * scale; v1 = v1 * scale;
                if (gate) {
                    u32x2 w; w.x = gate_u8(v0[0]) | (gate_u8(v0[1]) << 8) | (gate_u8(v0[2]) << 16) | (gate_u8(v0[3]) << 24);
                    w.y = gate_u8(v1[0]) | (gate_u8(v1[1]) << 8) | (gate_u8(v1[2]) << 16) | (gate_u8(v1[3]) << 24);
                    *(u32x2*)((unsigned char*)(rowp - col0 + G0) + (col0 - G0) + bj * 128) = w;
                } else {
                u32x4 w; w.x = cvt_pk_bf16(v0[0], v0[1]); w.y = cvt_pk_bf16(v0[2], v0[3]); w.z = cvt_pk_bf16(v1[0], v1[1]); w.w = cvt_pk_bf16(v1[2], v1[3]);
                *(u32x4*)(rowp + bj * 128) = w; } } }
}
struct GInProj {
    static constexpr int NT = DM / 64; static constexpr bool PERM = true, FP8 = false;
    const bf16_t* H; const bf16_t* W; bf16_t* Z; bf16_t* ZC; TwoPart tp; int lda, ldb, dry, kstepA, kstepB;
    __device__ __forceinline__ bool next(int i, Unit& u) const { u.seg = 0; return tp.map(i * tp.G + tp.c, u); }
    __device__ __forceinline__ const char* a_ptr(const Unit& u) const { return (const char*)(H + (size_t)u.pm * 256 * DM); }
    __device__ __forceinline__ const char* b_ptr(const Unit& u) const { return (const char*)(W + (size_t)u.pn * 256 * DM); }
    __device__ __forceinline__ bool keep(const Unit&) const { return false; }
    __device__ __forceinline__ void epi(const f32x4 (&acc)[2][2][4][2], const Unit& u, int wr, int wc, int fr, int fq) const {
        if (PROBE_DUP && dry) return;
        bf16_t* base = (u.pm < PAN_LAT) ? Z + (size_t)(u.pm - tp.lat0) * 256 * INW : ZC + (size_t)(u.pm - PAN_LAT) * 256 * INW;
        epi_z(acc, base, NQKV + u.pn, false, 1.f, wr, wc, fr, fq);
    }
};
struct GGate8 {
    static constexpr int NT = DM / 128; static constexpr bool PERM = true, FP8 = true;
    const unsigned char* H8; const unsigned char* W8; bf16_t* Z; bf16_t* ZC; TwoPart tp; int lda, ldb, dry, kstepA, kstepB;
    int nlo, cbase, span;
    __device__ __forceinline__ bool next(int i, Unit& u) const { u.seg = 0; return tp.map(skew_deal(i, tp.G, tp.c, nlo, cbase, span), u); }
    __device__ __forceinline__ const char* a_ptr(const Unit& u) const { return (const char*)(H8 + (size_t)u.pm * 256 * DM); }
    __device__ __forceinline__ const char* b_ptr(const Unit& u) const { return (const char*)(W8 + (size_t)u.pn * 256 * DM); }
    __device__ __forceinline__ bool keep(const Unit&) const { return false; }
    __device__ __forceinline__ void epi(const f32x4 (&acc)[2][2][4][2], const Unit& u, int wr, int wc, int fr, int fq) const {
        bf16_t* base = (u.pm < PAN_LAT) ? Z + (size_t)(u.pm - tp.lat0) * 256 * INW : ZC + (size_t)(u.pm - PAN_LAT) * 256 * INW;
        if (u.pn < NQKV) epi_z(acc, base, u.pn, false, 1.0f / G8_WSCALE, wr, wc, fr, fq);
        else epi_z(acc, base, u.pn + NCV, true, 1.0f / G8_WSCALE, wr, wc, fr, fq);
    }
};

#define UB0(x) ((float)(((x) >> 0) & 0xffu))
#define UB1(x) ((float)(((x) >> 8) & 0xffu))
#define UB2(x) ((float)(((x) >> 16) & 0xffu))
#define UB3(x) ((float)(((x) >> 24) & 0xffu))
struct GBranch {
    static constexpr int NT = 1024 / 64; static constexpr bool PERM = true, FP8 = false;
    const bf16_t* Z; const bf16_t* ZC; const bf16_t* W; bf16_t* Hout; TwoPart tp; int lda, ldb, dry, kstepA, kstepB;
    __device__ __forceinline__ bool next(int i, Unit& u) const { const int t = i / 3; u.seg = i - 3 * t; return tp.map(t * tp.G + tp.c, u); }
    __device__ __forceinline__ const bf16_t* zrow(const Unit& u) const { return (u.pm < PAN_LAT) ? Z + (size_t)(u.pm - tp.lat0) * 256 * INW : ZC + (size_t)(u.pm - PAN_LAT) * 256 * INW; }
    __device__ __forceinline__ const char* a_ptr(const Unit& u) const { return (const char*)(zrow(u) + (u.seg == 0 ? QA0 : (u.seg == 1 ? QB0 : CB0))); }
    __device__ __forceinline__ const char* b_ptr(const Unit& u) const { return (const char*)(W + (size_t)u.pn * 256 * 3072 + u.seg * 1024); }
    __device__ __forceinline__ bool keep(const Unit& u) const { return u.seg < 2; }
    __device__ __forceinline__ void epi(f32x4 (&acc)[2][2][4][2], const Unit& u, int wr, int wc, int fr, int fq) const {
        if (PROBE_DUP && dry) return;
        const unsigned char* zb = (const unsigned char*)(zrow(u) + G0); const int row0 = wr * 64 + fr, col0 = u.pn * 256 + wc * 32 + 8 * fq;
        const int seg = u.seg;
#pragma unroll
        for (int ai = 0; ai < 2; ++ai)
#pragma unroll
            for (int m = 0; m < 4; ++m) { const unsigned char* zr = zb + (size_t)(row0 + ai * 128 + m * 16) * (INW * 2) + col0;
                if (seg < 2) {
#pragma unroll
                    for (int bj = 0; bj < 2; ++bj) { const u32x2 gp = *(const u32x2*)(zr + seg * 2048 + bj * 128), gn = *(const u32x2*)(zr + (seg + 1) * 2048 + bj * 128);
                        f32x4 r0, r1;
                        r0[0] = UB0(gp.x) * __builtin_amdgcn_rcpf(UB0(gn.x)); r0[1] = UB1(gp.x) * __builtin_amdgcn_rcpf(UB1(gn.x));
                        r0[2] = UB2(gp.x) * __builtin_amdgcn_rcpf(UB2(gn.x)); r0[3] = UB3(gp.x) * __builtin_amdgcn_rcpf(UB3(gn.x));
                        r1[0] = UB0(gp.y) * __builtin_amdgcn_rcpf(UB0(gn.y)); r1[1] = UB1(gp.y) * __builtin_amdgcn_rcpf(UB1(gn.y));
                        r1[2] = UB2(gp.y) * __builtin_amdgcn_rcpf(UB2(gn.y)); r1[3] = UB3(gp.y) * __builtin_amdgcn_rcpf(UB3(gn.y));
                        acc[ai][bj][m][0] *= r0; acc[ai][bj][m][1] *= r1; }
                } else {
                    bf16_t* orow = Hout + (size_t)(u.pm * 256 + row0 + ai * 128 + m * 16) * DM + col0;
#pragma unroll
                    for (int bj = 0; bj < 2; ++bj) { const u32x2 g = *(const u32x2*)(zr + 2 * 2048 + bj * 128);
                        const f32x4 v0 = acc[ai][bj][m][0] * ((f32x4){UB0(g.x), UB1(g.x), UB2(g.x), UB3(g.x)} * (1.0f / 255.f)), v1 = acc[ai][bj][m][1] * ((f32x4){UB0(g.y), UB1(g.y), UB2(g.y), UB3(g.y)} * (1.0f / 255.f));
                        u32x4 w; w.x = cvt_pk_bf16(v0[0], v0[1]); w.y = cvt_pk_bf16(v0[2], v0[3]); w.z = cvt_pk_bf16(v1[0], v1[1]); w.w = cvt_pk_bf16(v1[2], v1[3]);
                        *(u32x4*)(orow + bj * 128) = w; }
                }
                asm volatile("" ::: "memory"); }
    }
};

typedef unsigned short half_t;
template <bool LNRES>
__device__ __forceinline__ void epi_residual(const f32x4 (&acc)[2][2][4][2], const void* res, half_t* out, const float* modv, const float* stats, const float* lg, const float* lb, int pn, int wr, int wc, int fr, int fq) {
    int row0 = wr * 64 + fr, col0 = pn * 256 + wc * 32 + 8 * fq;
    asm volatile("" : "+v"(row0), "+v"(col0));
    f32x4 gv[2][2], gl[2][2], bl[2][2];
#pragma unroll
    for (int bj = 0; bj < 2; ++bj)
#pragma unroll
        for (int n = 0; n < 2; ++n) { gv[bj][n] = *(const f32x4*)(modv + col0 + bj * 128 + n * 4);
            if (LNRES) { gl[bj][n] = *(const f32x4*)(lg + col0 + bj * 128 + n * 4) * DN_ALPHA; bl[bj][n] = *(const f32x4*)(lb + col0 + bj * 128 + n * 4) * DN_ALPHA; } }
#pragma unroll
    for (int ai = 0; ai < 2; ++ai)
#pragma unroll
        for (int m = 0; m < 4; ++m) { const int rr = row0 + ai * 128 + m * 16; const size_t off = (size_t)rr * DM + col0;
            f32x2 st = (f32x2){0.f, 1.f}; if (LNRES) st = *(const f32x2*)(stats + 2 * rr);
#pragma unroll
            for (int bj = 0; bj < 2; ++bj) { f32x4 r0, r1, o0, o1;
                if (LNRES) { un_h8(*(const u32x4*)((const half_t*)res + off + bj * 128), r0, r1);
                    o0 = ((r0 - st.x) * st.y) * gl[bj][0] + bl[bj][0] + gv[bj][0] * acc[ai][bj][m][0]; o1 = ((r1 - st.x) * st.y) * gl[bj][1] + bl[bj][1] + gv[bj][1] * acc[ai][bj][m][1]; }
                else { r0 = *(const f32x4*)((const float*)res + off + bj * 128); r1 = *(const f32x4*)((const float*)res + off + bj * 128 + 4);
                    o0 = r0 * DN_ALPHA + gv[bj][0] * acc[ai][bj][m][0]; o1 = r1 * DN_ALPHA + gv[bj][1] * acc[ai][bj][m][1]; }
                u32x4 w; w.x = pk_h2(o0[0], o0[1]); w.y = pk_h2(o0[2], o0[3]); w.z = pk_h2(o1[0], o1[1]); w.w = pk_h2(o1[2], o1[3]);
                *(u32x4*)(out + off + bj * 128) = w; }
            asm volatile("" ::: "memory"); }
}
struct GRes {
    static constexpr bool PERM = true, FP8 = false;
    const bf16_t* A_lat; const bf16_t* A_ctx;
    int a_lat0; const bf16_t* W; const void* res_lat; const void* res_ctx; half_t* out_lat; half_t* out_ctx; const float* mod; int modj; TwoPart tp; int lda, ldb, dry, kstepA, kstepB;
    int apan;
    const float* stats; const float* lg; const float* lb; int lnres;
    __device__ __forceinline__ bool nextu(int i, Unit& u) const { u.seg = 0; return tp.map(i * tp.G + tp.c, u); }
    __device__ __forceinline__ const char* a_ptr(const Unit& u) const { return (const char*)((u.pm < PAN_LAT) ? A_lat + (size_t)(u.pm - a_lat0) * apan : A_ctx + (size_t)(u.pm - PAN_LAT) * apan); }
    __device__ __forceinline__ const char* b_ptr(const Unit& u) const { return (const char*)(W + (size_t)u.pn * 256 * ldb); }
    __device__ __forceinline__ bool keep(const Unit&) const { return false; }
    __device__ __forceinline__ void epi(const f32x4 (&acc)[2][2][4][2], const Unit& u, int wr, int wc, int fr, int fq) const {
        if (PROBE_DUP && dry) return;
        const bool lat = u.pm < PAN_LAT; const size_t prow = (size_t)(lat ? u.pm : u.pm - PAN_LAT) * 256;
        half_t* o = (lat ? out_lat : out_ctx) + prow * DM;
        const float* mv = mod + (size_t)(lat ? (u.pm >> 3) : 16) * MODW + modj * DM; const float* st = stats + (size_t)u.pm * 256 * 2;
        if (lnres) epi_residual<true>(acc, (const half_t*)(lat ? res_lat : res_ctx) + prow * DM, o, mv, st, lg, lb, u.pn, wr, wc, fr, fq);
        else epi_residual<false>(acc, (const float*)(lat ? res_lat : res_ctx) + prow * DM, o, mv, st, lg, lb, u.pn, wr, wc, fr, fq);
    }
};
struct GWo : GRes { static constexpr int NT = DM / 64; __device__ __forceinline__ bool next(int i, Unit& u) const { return nextu(i, u); } };
struct GDown : GRes { static constexpr int NT = HID / 64; __device__ __forceinline__ bool next(int i, Unit& u) const { return nextu(i, u); } };

struct GUp {
    static constexpr int NT = DM / 64; static constexpr bool PERM = true, FP8 = false;
    const bf16_t* H; const bf16_t* W; bf16_t* U; TwoPart tp; int lda, ldb, dry, kstepA, kstepB; int nlo, cbase, span;
    __device__ __forceinline__ bool next(int i, Unit& u) const { u.seg = 0; return tp.map(skew_deal(i, tp.G, tp.c, nlo, cbase, span), u); }
    __device__ __forceinline__ const char* a_ptr(const Unit& u) const { return (const char*)(H + (size_t)u.pm * 256 * DM); }
    __device__ __forceinline__ const char* b_ptr(const Unit& u) const { return (const char*)(W + (size_t)u.pn * 256 * DM); }
    __device__ __forceinline__ bool keep(const Unit&) const { return false; }
    __device__ __forceinline__ void epi(const f32x4 (&acc)[2][2][4][2], const Unit& u, int wr, int wc, int fr, int fq) const {
        if (PROBE_DUP && dry) return;
        bf16_t* base = U + (size_t)((u.pm < PAN_LAT) ? (u.pm - tp.lat0) : (PAN_CH + u.pm - PAN_LAT)) * 256 * HID;
        const int row0 = wr * 64 + fr, col0 = u.pn * 256 + wc * 32 + 8 * fq;
#pragma unroll
        for (int ai = 0; ai < 2; ++ai)
#pragma unroll
            for (int m = 0; m < 4; ++m) { bf16_t* rowp = base + (size_t)(col0 >> 6) * (256 * 64) + (size_t)(row0 + ai * 128 + m * 16) * 64 + (col0 & 63);
#pragma unroll
                for (int bj = 0; bj < 2; ++bj) { f32x4 v0 = acc[ai][bj][m][0], v1 = acc[ai][bj][m][1];
                    v0 = __builtin_elementwise_max(v0, (f32x4){0.f, 0.f, 0.f, 0.f}); v1 = __builtin_elementwise_max(v1, (f32x4){0.f, 0.f, 0.f, 0.f}); v0 = v0 * v0; v1 = v1 * v1;
                    u32x4 w; w.x = cvt_pk_bf16(v0[0], v0[1]); w.y = cvt_pk_bf16(v0[2], v0[3]); w.z = cvt_pk_bf16(v1[0], v1[1]); w.w = cvt_pk_bf16(v1[2], v1[3]);
                    *(u32x4*)(rowp + bj * 2 * (256 * 64)) = w; } }
    }
};

namespace att {
constexpr int NW = 8, QBLK = 32, KVBLK = 64, LDZ = INW;
constexpr float SCALE = ATT_SCALE, THR = 8.f, NEG = -1e30f;
constexpr int SHM_V = 16384, SHM_K = 16384, NRING = 3, OFF_WS = NRING * (SHM_V + SHM_K), OFF_TAB = OFF_WS + 2048, LDS_ATTN = OFF_TAB + 15 * 512;
static_assert(LDS_ATTN <= SCR_BYTES, "attention LDS");
struct AUnit { const bf16_t* Q; const bf16_t* P0; const bf16_t* P1; int nfirst, NT, vofs; int r0, lo; const float* rpb; int dry; const float* qgain; const float* ropec; int pos0; };
#define KSWZ(row, colB) ((row) * 256 + ((colB) ^ (((row) & 7) << 4)))
#define SBAR() __builtin_amdgcn_sched_barrier(0)
__device__ __forceinline__ int crow(int r, int hi) { return (r & 3) + 8 * (r >> 2) + 4 * hi; }
__device__ __forceinline__ void partialSM(f32x16& p0, f32x16& p1, float& m_reg, float& mn, float& alpha) {
  constexpr float C = SCALE * 1.4426950408889634f;
  float pmax = p0[0];
#pragma unroll
  for (int r = 1; r < 16; ++r) pmax = fmaxf(pmax, p0[r]);
#pragma unroll
  for (int r = 0; r < 16; ++r) pmax = fmaxf(pmax, p1[r]);
  { auto rr = __builtin_amdgcn_permlane32_swap(__float_as_uint(pmax), __float_as_uint(pmax), false, false);
    pmax = fmaxf(__uint_as_float(rr[0]), __uint_as_float(rr[1])); }
  if (__builtin_expect(__all(pmax - m_reg <= THR / SCALE), 1)) { mn = m_reg; alpha = 1.f; }
  else { mn = fmaxf(m_reg, pmax); alpha = __builtin_amdgcn_exp2f((m_reg - mn) * C); m_reg = mn; }
  float mnC = -mn * C;
#pragma unroll
  for (int r = 0; r < 16; ++r) p0[r] = fmaf(p0[r], C, mnC);
#pragma unroll
  for (int r = 0; r < 16; ++r) p1[r] = fmaf(p1[r], C, mnC);
#pragma unroll
  for (int r = 0; r < 16; ++r) p0[r] = __builtin_amdgcn_exp2f(p0[r]);
}
__device__ __forceinline__ void finishSM(f32x16& p0, f32x16& p1, float alpha, float& l_reg, bf16x8& pa0, bf16x8& pa1, bf16x8& pa2, bf16x8& pa3) {
#pragma unroll
  for (int r = 0; r < 16; ++r) p1[r] = __builtin_amdgcn_exp2f(p1[r]);
  float ps = 0;
#pragma unroll
  for (int r = 0; r < 16; ++r) ps += p0[r];
#pragma unroll
  for (int r = 0; r < 16; ++r) ps += p1[r];
  { auto rr = __builtin_amdgcn_permlane32_swap(__float_as_uint(ps), __float_as_uint(ps), false, false);
    ps = __uint_as_float(rr[0]) + __uint_as_float(rr[1]); }
  l_reg = l_reg * alpha + ps;
#define PK4(P, BASE, OUT) do { unsigned a0 = cvt_pk_bf16(P[BASE + 0], P[BASE + 1]), a1 = cvt_pk_bf16(P[BASE + 2], P[BASE + 3]);   \
    unsigned b0 = cvt_pk_bf16(P[BASE + 4], P[BASE + 5]), b1 = cvt_pk_bf16(P[BASE + 6], P[BASE + 7]);                              \
    auto r0 = __builtin_amdgcn_permlane32_swap(a0, b0, false, false); auto r1 = __builtin_amdgcn_permlane32_swap(a1, b1, false, false); \
    u32x4 w = {r0[0], r1[0], r0[1], r1[1]}; OUT = *reinterpret_cast<bf16x8*>(&w); } while (0)
  PK4(p0, 0, pa0); PK4(p0, 8, pa1); PK4(p1, 0, pa2); PK4(p1, 8, pa3);
#undef PK4
}
__device__ __forceinline__ void qkt(f32x16& p0, f32x16& p1, const char* Ks, const bf16x8* qr, int r32, int hi) {
  p0 = f32x16{}; p1 = f32x16{};
#pragma unroll
  for (int d0 = 0; d0 < 8; ++d0) { int cb = (d0 * 16 + hi * 8) * 2;
    bf16x8 b0 = *reinterpret_cast<const bf16x8*>(Ks + KSWZ(r32, cb));
    bf16x8 b1 = *reinterpret_cast<const bf16x8*>(Ks + KSWZ(32 + r32, cb));
    p0 = __builtin_amdgcn_mfma_f32_32x32x16_bf16(b0, qr[d0], p0, 0, 0, 0);
    p1 = __builtin_amdgcn_mfma_f32_32x32x16_bf16(b1, qr[d0], p1, 0, 0, 0); }
}
__device__ __forceinline__ int v_st(int k, int c) { const int kk = (k & ~0xC) | ((k & 4) << 1) | ((k & 8) >> 1); return ((kk >> 3) * 4 + (c >> 5)) * 512 + ((kk & 7) * 32 + (c & 31)) * 2; }
__device__ __forceinline__ int v_rd_base(int lane) { return ((lane & 3) << 3) | (((lane >> 2) & 3) << 6) | (((lane >> 4) & 1) << 5) | (((lane >> 5) & 1) << 8); }
constexpr int v_rd_off(int d0, int ks, int half) { return d0 * 512 + ks * 4096 + half * 2048; }
template <int OFF> __device__ __forceinline__ s16x4 tr_read(int vb) {
  s16x4 r; asm volatile("ds_read_b64_tr_b16 %0, %1 offset:%2" : "=&v"(r) : "v"(vb), "i"(OFF) : "memory"); return r;
}
template <int D0> __device__ __forceinline__ void pv_one(f32x16& od, int vb, bf16x8 pa0, bf16x8 pa1, bf16x8 pa2, bf16x8 pa3) {
  const s16x4 l0 = tr_read<v_rd_off(D0, 0, 0)>(vb), h0 = tr_read<v_rd_off(D0, 0, 1)>(vb), l1 = tr_read<v_rd_off(D0, 1, 0)>(vb), h1 = tr_read<v_rd_off(D0, 1, 1)>(vb);
  const s16x4 l2 = tr_read<v_rd_off(D0, 2, 0)>(vb), h2 = tr_read<v_rd_off(D0, 2, 1)>(vb), l3 = tr_read<v_rd_off(D0, 3, 0)>(vb), h3 = tr_read<v_rd_off(D0, 3, 1)>(vb);
  asm volatile("s_waitcnt lgkmcnt(0)" ::: "memory"); SBAR();
#define PK(L, H) (bf16x8){L[0], L[1], L[2], L[3], H[0], H[1], H[2], H[3]}
  od = __builtin_amdgcn_mfma_f32_32x32x16_bf16(pa0, PK(l0, h0), od, 0, 0, 0);
  od = __builtin_amdgcn_mfma_f32_32x32x16_bf16(pa1, PK(l1, h1), od, 0, 0, 0);
  od = __builtin_amdgcn_mfma_f32_32x32x16_bf16(pa2, PK(l2, h2), od, 0, 0, 0);
  od = __builtin_amdgcn_mfma_f32_32x32x16_bf16(pa3, PK(l3, h3), od, 0, 0, 0);
#undef PK
}
__device__ __forceinline__ void pv_d0(f32x16* o, int vb, bf16x8 pa0, bf16x8 pa1, bf16x8 pa2, bf16x8 pa3) {
  pv_one<0>(o[0], vb, pa0, pa1, pa2, pa3); pv_one<1>(o[1], vb, pa0, pa1, pa2, pa3); pv_one<2>(o[2], vb, pa0, pa1, pa2, pa3); pv_one<3>(o[3], vb, pa0, pa1, pa2, pa3);
}
__device__ __forceinline__ void na_fix(f32x16& p0, f32x16& p1, int j, int lo, int qrow, int rsq, const float* tabl  , int cs4  ) {
  if (j < 4) return;
  const int kr = lo + (j - 4);
  if (kr < rsq || kr >= rsq + 8) {
#pragma unroll
    for (int r = 0; r < 16; ++r) { p0[r] = NEG; p1[r] = NEG; }
    return;
  }
  const float* tb = tabl + (kr - qrow + 7) * 128;
#pragma unroll
  for (int r = 0; r < 16; ++r) { const int kcc = (r & 3) + 8 * (r >> 2);
    const float b0 = tb[kcc], b1 = tb[kcc + 32];
    p0[r] = ((unsigned)(kcc - cs4) < 16u) ? p0[r] + b0 : NEG; p1[r] = ((unsigned)(kcc + 32 - cs4) < 16u) ? p1[r] + b1 : NEG; }
}

__device__ __forceinline__ void q_norm_rope(bf16x8 (&qr)[8], const float* gain, const float* ropec, int pos, int hi) {
  float ss = 0.f;
#pragma unroll
  for (int d0 = 0; d0 < 8; ++d0) { const u32x4 w = __builtin_bit_cast(u32x4, qr[d0]);
    ss += bflo(w.x) * bflo(w.x) + bfhi(w.x) * bfhi(w.x) + bflo(w.y) * bflo(w.y) + bfhi(w.y) * bfhi(w.y) + bflo(w.z) * bflo(w.z) + bfhi(w.z) * bfhi(w.z) + bflo(w.w) * bflo(w.w) + bfhi(w.w) * bfhi(w.w); }
  { auto rr = __builtin_amdgcn_permlane32_swap(__float_as_uint(ss), __float_as_uint(ss), false, false); ss = __uint_as_float(rr[0]) + __uint_as_float(rr[1]); }
  const float rinv = 1.0f / sqrtf(ss * (1.f / 128.f) + LN_EPS);
#pragma unroll
  for (int p = 0; p < 4; ++p) { const int a = (p & 1) + 4 * (p >> 1), b = a + 2, da = a * 16 + hi * 8;
    const f32x4 ga0 = *(const f32x4*)(gain + da), ga1 = *(const f32x4*)(gain + da + 4), gb0 = *(const f32x4*)(gain + da + 32), gb1 = *(const f32x4*)(gain + da + 36);
    f32x4 c0 = {1.f, 1.f, 1.f, 1.f}, c1 = c0, s0 = {0.f, 0.f, 0.f, 0.f}, s1 = s0;
    if (ropec) { const float* tc = ropec + ((a >= 4) ? 32 + (pos & 63) : (pos >> 6)) * 32 + (da & 31); c0 = *(const f32x4*)tc; c1 = *(const f32x4*)(tc + 4); s0 = *(const f32x4*)(tc + 96 * 32); s1 = *(const f32x4*)(tc + 96 * 32 + 4); }
    const u32x4 wa = __builtin_bit_cast(u32x4, qr[a]), wb = __builtin_bit_cast(u32x4, qr[b]);
    f32x4 xa0 = (f32x4){bflo(wa.x), bfhi(wa.x), bflo(wa.y), bfhi(wa.y)} * rinv * ga0, xa1 = (f32x4){bflo(wa.z), bfhi(wa.z), bflo(wa.w), bfhi(wa.w)} * rinv * ga1;
    f32x4 xb0 = (f32x4){bflo(wb.x), bfhi(wb.x), bflo(wb.y), bfhi(wb.y)} * rinv * gb0, xb1 = (f32x4){bflo(wb.z), bfhi(wb.z), bflo(wb.w), bfhi(wb.w)} * rinv * gb1;
    const f32x4 ya0 = xa0 * c0 - xb0 * s0, ya1 = xa1 * c1 - xb1 * s1, yb0 = xb0 * c0 + xa0 * s0, yb1 = xb1 * c1 + xa1 * s1;
    u32x4 oa, ob; oa.x = cvt_pk_bf16(ya0[0], ya0[1]); oa.y = cvt_pk_bf16(ya0[2], ya0[3]); oa.z = cvt_pk_bf16(ya1[0], ya1[1]); oa.w = cvt_pk_bf16(ya1[2], ya1[3]);
    ob.x = cvt_pk_bf16(yb0[0], yb0[1]); ob.y = cvt_pk_bf16(yb0[2], yb0[3]); ob.z = cvt_pk_bf16(yb1[0], yb1[1]); ob.w = cvt_pk_bf16(yb1[2], yb1[3]);
    qr[a] = __builtin_bit_cast(bf16x8, oa); qr[b] = __builtin_bit_cast(bf16x8, ob); }
}
template <bool NA>
__device__ __forceinline__ void attn_unit(const AUnit& U, char* lds, LAS unsigned char* ldl, int tid) {
  asm volatile("" : "+v"(tid));
  const int wid = tid >> 6, lane = tid & 63, r32 = lane & 31, hi = lane >> 5;
  char* V_lds = lds; char* K_lds = lds + NRING * SHM_V;
  float* ws = (float*)(lds + OFF_WS) + wid * 64; float* li_l = ws; float* al_l = ws + 32;
  float* tab = (float*)(lds + OFF_TAB);
  float m_reg = NEG, l_reg = 0; f32x16 o[4] = {}; bf16x8 qr[8];
  const bf16_t* Qw = U.Q + (size_t)(wid * QBLK + r32) * LDZ + hi * 8;
#pragma unroll
  for (int d0 = 0; d0 < 8; ++d0) qr[d0] = *reinterpret_cast<const bf16x8*>(Qw + d0 * 16);
  if constexpr (!NA) { if (U.qgain) q_norm_rope(qr, U.qgain, U.ropec, U.pos0 + wid * QBLK + r32, hi); }
  int qrow = 0, rsq = 0, cs4 = 0; const float* tabl = tab;
  if constexpr (NA) {
    const int wu = __builtin_amdgcn_readfirstlane(wid);
    qrow = U.r0 + (wu >> 1); rsq = min(max(qrow - 4, 0), 24);
    const int qc = (wu & 1) * 32 + r32, cs = min(max(qc - 8, 0), 48);
    cs4 = cs - 4 * hi;
    tabl = tab + (4 * hi - qc + 64);
    for (int e = tid; e < 15 * 128; e += 512) { const int dri = e >> 7, dc = (e & 127) - 64; tab[e] = (dc >= -15 && dc <= 15) ? U.rpb[dri * 31 + dc + 15] * (1.0f / SCALE) : 0.f; }
  }
  const int vb0 = (int)(uintptr_t)V_lds + v_rd_base(lane);
  const int wq = __builtin_amdgcn_readfirstlane(wid);
  int kof[2], vof[2];
#pragma unroll
  for (int i = 0; i < 2; ++i) { const int row = wq * 8 + i * 4 + (lane >> 4); kof[i] = row * LDZ + (((lane & 15) ^ (row & 7)) << 3);
    const int sl = (wq * 2 + i) * 64 + lane, blk = sl >> 5, kk = ((blk >> 2) << 3) | ((sl >> 2) & 7), k = (kk & ~0xC) | ((kk & 4) << 1) | ((kk & 8) >> 1), c = ((blk & 3) << 5) | ((sl & 3) << 3);
    vof[i] = k * LDZ + c + U.vofs; }
  const int nfirst = U.nfirst; const bf16_t* P0 = U.P0; const bf16_t* P1 = U.P1;
  LAS unsigned char* const lV = ldl + wq * 2048; LAS unsigned char* const lK = ldl + NRING * SHM_V + wq * 2048;
#define TILEB(j) ((j) < nfirst ? P0 + (size_t)(j) * 64 * LDZ : P1 + (size_t)((j) - nfirst) * 64 * LDZ)
#define DMA_K(b, j) do { const bf16_t* tp_ = TILEB(j); _Pragma("unroll") for (int i_ = 0; i_ < 2; ++i_) \
    __builtin_amdgcn_global_load_lds((const unsigned*)(tp_ + kof[i_]), (LAS unsigned*)(lK + (b) * SHM_K + i_ * 1024), 16, 0, 0); } while (0)
#define DMA_V(b, j) do { const bf16_t* tp_ = TILEB(j); _Pragma("unroll") for (int i_ = 0; i_ < 2; ++i_) \
    __builtin_amdgcn_global_load_lds((const unsigned*)(tp_ + vof[i_]), (LAS unsigned*)(lV + (b) * SHM_V + i_ * 1024), 16, 0, 0); } while (0)
#define STEP_END() do { asm volatile("s_waitcnt vmcnt(0)" ::: "memory"); __syncthreads(); } while (0)
#define RESC(a) do { if (__any((a) < 1.f)) { if (hi == 0) al_l[r32] = (a); asm volatile("s_waitcnt lgkmcnt(0)" ::: "memory"); \
    _Pragma("unroll") for (int d = 0; d < 4; ++d) _Pragma("unroll") for (int r = 0; r < 16; ++r) o[d][r] *= al_l[crow(r, hi)]; } } while (0)
#define NAFIX(PA, PB, j) do { if constexpr (NA) na_fix(PA, PB, (j), U.lo, qrow, rsq, tabl, cs4); } while (0)
  f32x16 pA0, pA1, pB0, pB1; float mnA, mnB, alA, alB; bf16x8 pa0, pa1, pa2, pa3; const int NT = U.NT;
#define STEP_WAIT(n) do { asm volatile("s_waitcnt vmcnt(" #n ")" ::: "memory"); __syncthreads(); } while (0)
  DMA_K(0, 0); STEP_WAIT(0);
  DMA_K(1, 1); DMA_V(0, 0); DMA_K(2, 2); DMA_V(1, 1); SBAR();
  qkt(pA0, pA1, K_lds, qr, r32, hi); NAFIX(pA0, pA1, 0); partialSM(pA0, pA1, m_reg, mnA, alA);
  STEP_WAIT(4);
  int r = 1;
  for (int j = 1; j + 1 < NT; j += 2) {
    { const int r2 = (r == 0) ? 2 : r - 1, r1 = (r == 2) ? 0 : r + 1;
    const bool more = j + 2 < NT;
    if (more) { DMA_K(r2, j + 2); } DMA_V(r1, j + 1);
    SBAR(); qkt(pB0, pB1, K_lds + r * SHM_K, qr, r32, hi);
    finishSM(pA0, pA1, alA, l_reg, pa0, pa1, pa2, pa3); SBAR();
    pv_d0(o, vb0 + r2 * SHM_V, pa0, pa1, pa2, pa3); NAFIX(pB0, pB1, j); partialSM(pB0, pB1, m_reg, mnB, alB);
    RESC(alB); if (more) STEP_WAIT(4); else STEP_WAIT(0);
    r = r1; }
    { const int r2 = (r == 0) ? 2 : r - 1, r1 = (r == 2) ? 0 : r + 1; const int jj = j + 1;
    const bool more = jj + 2 < NT, more1 = jj + 1 < NT;
    if (more) { DMA_K(r2, jj + 2); } if (more1) { DMA_V(r1, jj + 1); }
    SBAR(); qkt(pA0, pA1, K_lds + r * SHM_K, qr, r32, hi);
    finishSM(pB0, pB1, alB, l_reg, pa0, pa1, pa2, pa3); SBAR();
    pv_d0(o, vb0 + r2 * SHM_V, pa0, pa1, pa2, pa3); NAFIX(pA0, pA1, jj); partialSM(pA0, pA1, m_reg, mnA, alA);
    RESC(alA); if (more) STEP_WAIT(4); else STEP_WAIT(0);
    r = r1; }
  }
  { const int r2 = (r == 0) ? 2 : r - 1;
  SBAR(); qkt(pB0, pB1, K_lds + r * SHM_K, qr, r32, hi);
  finishSM(pA0, pA1, alA, l_reg, pa0, pa1, pa2, pa3); SBAR();
  pv_d0(o, vb0 + r2 * SHM_V, pa0, pa1, pa2, pa3); NAFIX(pB0, pB1, NT - 1); partialSM(pB0, pB1, m_reg, mnB, alB);
  RESC(alB);
  finishSM(pB0, pB1, alB, l_reg, pa0, pa1, pa2, pa3); SBAR();
  pv_d0(o, vb0 + r * SHM_V, pa0, pa1, pa2, pa3); }
#undef STEP_WAIT
  if (hi == 0) li_l[r32] = l_reg; asm volatile("s_waitcnt lgkmcnt(0)" ::: "memory");
  float rli[16];
#pragma unroll
  for (int r = 0; r < 16; ++r) rli[r] = __builtin_amdgcn_rcpf(li_l[crow(r, hi)]);
  __syncthreads();
  bf16_t* ost = (bf16_t*)(lds + wid * 8192);
#pragma unroll
  for (int r = 0; r < 16; ++r) { const int orow = crow(r, hi);
#pragma unroll
    for (int d0 = 0; d0 < 4; ++d0) { const unsigned w = cvt_pk_bf16(o[d0][r] * rli[r], 0.f); ost[orow * 128 + d0 * 32 + r32] = (bf16_t)(w & 0xffffu); } }
  asm volatile("s_waitcnt lgkmcnt(0)" ::: "memory");
  bf16_t* Ow = (bf16_t*)U.Q + (size_t)(wid * QBLK) * LDZ;
  if (!(PROBE_DUP && U.dry)) {
#pragma unroll
  for (int i = 0; i < 8; ++i) { const int id = i * 64 + lane, row = id >> 4, c16 = id & 15;
    *(u32x4*)(Ow + (size_t)row * LDZ + c16 * 8) = *(const u32x4*)(ost + row * 128 + c16 * 8); } }
  __syncthreads();
#undef TILEB
#undef DMA_K
#undef DMA_V
#undef STEP_END
#undef RESC
#undef NAFIX
}
}

struct Args { const float* in[17]; float* out; unsigned char* ws; int ph_lo, ph_hi; };
static_assert(sizeof(Args) == 17 * 8 + 8 + 8 + 8, "Args has no padding");


__device__ __forceinline__ void transpose_item(const float* W, int N, bf16_t* WT, int ldt, LAS float* scr, int kb, int nb, int lane) {
    const int k0 = 64 * kb, n0 = 32 * nb;
#pragma unroll 8
    for (int i = 0; i < 32; ++i) { const int kk = 2 * i + (lane >> 5); scr[kk * 33 + (lane & 31)] = W[(size_t)(k0 + kk) * N + n0 + (lane & 31)]; }
    LDS_WAIT(); asm volatile("" ::: "memory");
    const int c = lane & 7;
#pragma unroll
    for (int j = 0; j < 4; ++j) { const int n = (lane >> 3) + 8 * j; const LAS float* s = scr + (8 * c) * 33 + n;
        u32x4 o; o.x = cvt_pk_bf16(s[0 * 33], s[1 * 33]); o.y = cvt_pk_bf16(s[2 * 33], s[3 * 33]); o.z = cvt_pk_bf16(s[4 * 33], s[5 * 33]); o.w = cvt_pk_bf16(s[6 * 33], s[7 * 33]);
        *(u32x4*)(WT + (size_t)(n0 + n) * ldt + k0 + 8 * c) = o; }
    LDS_WAIT(); asm volatile("" ::: "memory");
}
__device__ __forceinline__ void transpose_item8(const float* W, int N, unsigned char* WT8, int ldt, LAS float* scr, int kb, int nb, int nrow0, int lane) {
    const int k0 = 64 * kb, n0 = 32 * nb;
#pragma unroll 8
    for (int i = 0; i < 32; ++i) { const int kk = 2 * i + (lane >> 5); scr[kk * 33 + (lane & 31)] = W[(size_t)(k0 + kk) * N + n0 + (lane & 31)]; }
    LDS_WAIT(); asm volatile("" ::: "memory");
    const int c = lane & 7;
#pragma unroll
    for (int j = 0; j < 4; ++j) { const int n = (lane >> 3) + 8 * j; const LAS float* s = scr + (8 * c) * 33 + n;
        u32x2 o; o.x = pk_fp8x4(s[0 * 33] * G8_WSCALE, s[1 * 33] * G8_WSCALE, s[2 * 33] * G8_WSCALE, s[3 * 33] * G8_WSCALE); o.y = pk_fp8x4(s[4 * 33] * G8_WSCALE, s[5 * 33] * G8_WSCALE, s[6 * 33] * G8_WSCALE, s[7 * 33] * G8_WSCALE);
        *(u32x2*)(WT8 + (size_t)(n0 - nrow0 + n) * ldt + k0 + 8 * c) = o; }
    LDS_WAIT(); asm volatile("" ::: "memory");
}

__device__ __forceinline__ void row_stats(const f32x4 (&v)[8], float& mean, float& rstd, int lane) {
    float s = 0.f;
#pragma unroll
    for (int j = 0; j < 8; ++j) s += (v[j].x + v[j].y) + (v[j].z + v[j].w);
    mean = wave_sum(s, lane) * (1.f / DM); float s2 = 0.f;
#pragma unroll
    for (int j = 0; j < 8; ++j) { const f32x4 d = v[j] - mean; s2 += (d.x * d.x + d.y * d.y) + (d.z * d.z + d.w * d.w); }
    rstd = 1.0f / sqrtf(wave_sum(s2, lane) * (1.f / DM) + LN_EPS);
}
struct LnArgs { int nrows; const void* src_lat; const void* src_ctx; float* dst_lat; float* dst_ctx; bf16_t* H; unsigned char* H8; float* stats; const float* g; const float* b; const float* modl; int shift_j, scale_j; };
template <int MODE>
__device__ __forceinline__ void ln_load(const LnArgs& a, int m, f32x4 (&v)[8], int lane) {
    if (MODE == 0) {
        const f32x4* sp = (const f32x4*)(m < NLAT ? (const float*)a.src_lat + (size_t)m * DM : (const float*)a.src_ctx + (size_t)(m - NLAT) * DM) + 2 * lane;
#pragma unroll
        for (int j = 0; j < 4; ++j) { v[2 * j] = sp[128 * j]; v[2 * j + 1] = sp[128 * j + 1]; }
    } else {
        const u32x4* sp = (const u32x4*)(m < NLAT ? (const half_t*)a.src_lat + (size_t)m * DM : (const half_t*)a.src_ctx + (size_t)(m - NLAT) * DM) + lane;
#pragma unroll
        for (int j = 0; j < 4; ++j) v[2 * j] = __builtin_bit_cast(f32x4, sp[64 * j]);
    }
}
template <int MODE>
__device__ __forceinline__ void ln_unpack(f32x4 (&v)[8]) {
    if (MODE != 0) {
#pragma unroll
        for (int j = 0; j < 4; ++j) { const u32x4 w = __builtin_bit_cast(u32x4, v[2 * j]); un_h8(w, v[2 * j], v[2 * j + 1]); }
    }
}
struct LnVecs { f32x4 gg[8], bb[8], sc[8], sh[8]; };
template <int MODE>
__device__ __forceinline__ void ln_process(const LnArgs& a, int m, f32x4 (&v)[8], const LnVecs& V, int lane) {
    const bool lat = m < NLAT;
    ln_unpack<MODE>(v);
    float mean, rstd; row_stats(v, mean, rstd, lane);
    if (MODE >= 1) {
        if (MODE == 1 && lane == 0) *(f32x2*)(a.stats + 2 * (size_t)m) = (f32x2){mean, rstd};
        f32x4* dp = (f32x4*)(lat ? a.dst_lat + (size_t)m * DM : a.dst_ctx + (size_t)(m - NLAT) * DM) + 2 * lane;
#pragma unroll
        for (int j = 0; j < 4; ++j)
#pragma unroll
            for (int e = 0; e < 2; ++e) { v[2 * j + e] = (v[2 * j + e] - mean) * rstd * V.gg[2 * j + e] + V.bb[2 * j + e]; if (MODE == 2) dp[128 * j + e] = v[2 * j + e]; }
        if (MODE == 1) row_stats(v, mean, rstd, lane);
    }
    if (MODE <= 1) {
        u32x4* hp = (u32x4*)(a.H + (size_t)m * DM) + lane;
#pragma unroll
        for (int j = 0; j < 4; ++j) { const f32x4 h0 = (v[2 * j] - mean) * rstd * V.sc[2 * j] + V.sh[2 * j], h1 = (v[2 * j + 1] - mean) * rstd * V.sc[2 * j + 1] + V.sh[2 * j + 1];
            u32x4 o; o.x = cvt_pk_bf16(h0.x, h0.y); o.y = cvt_pk_bf16(h0.z, h0.w); o.z = cvt_pk_bf16(h1.x, h1.y); o.w = cvt_pk_bf16(h1.z, h1.w); hp[64 * j] = o;
            if (a.H8) { u32x2 o8; o8.x = pk_fp8x4(h0.x, h0.y, h0.z, h0.w); o8.y = pk_fp8x4(h1.x, h1.y, h1.z, h1.w); ((u32x2*)(a.H8 + (size_t)m * DM))[lane + 64 * j] = o8; } }
    }
}
__device__ __forceinline__ void ln_modvecs(const LnArgs& a, int bi, LnVecs& V, int lane) {
    const float* md = a.modl + (size_t)bi * MODW; const f32x4* scp = (const f32x4*)(md + a.scale_j * DM) + 2 * lane; const f32x4* shp = (const f32x4*)(md + a.shift_j * DM) + 2 * lane;
#pragma unroll
    for (int j = 0; j < 4; ++j)
#pragma unroll
        for (int e = 0; e < 2; ++e) { V.sc[2 * j + e] = scp[128 * j + e] + 1.0f; V.sh[2 * j + e] = shp[128 * j + e]; }
}
template <int MODE>
__device__ __forceinline__ void ln_block(const LnArgs& a, int m0, int R, int bi, int lane) {
    LnVecs V;
    if (MODE >= 1) { const f32x4* gp = (const f32x4*)a.g + 2 * lane; const f32x4* bp = (const f32x4*)a.b + 2 * lane;
#pragma unroll
        for (int j = 0; j < 4; ++j)
#pragma unroll
            for (int e = 0; e < 2; ++e) { V.gg[2 * j + e] = gp[128 * j + e]; V.bb[2 * j + e] = bp[128 * j + e]; } }
    if (MODE <= 1) ln_modvecs(a, bi, V, lane);
    if constexpr (MODE != 2) {
    f32x4 va[8], vb[8];
    ln_load<MODE>(a, m0, va, lane);
    for (int k = 0; k + 2 < R; k += 2) {
        ln_load<MODE>(a, m0 + k + 1, vb, lane);
        asm volatile("" ::: "memory");
        ln_process<MODE>(a, m0 + k, va, V, lane);
        ln_load<MODE>(a, m0 + k + 2, va, lane);
        asm volatile("" ::: "memory");
        ln_process<MODE>(a, m0 + k + 1, vb, V, lane);
    }
    ln_load<MODE>(a, m0 + R - 1, vb, lane);
    asm volatile("" ::: "memory");
    ln_process<MODE>(a, m0 + R - 2, va, V, lane);
    ln_process<MODE>(a, m0 + R - 1, vb, V, lane);
    } else {
    f32x4 va[8], vb[8], vc[8];
    ln_load<MODE>(a, m0, va, lane); ln_load<MODE>(a, m0 + 1, vb, lane);
    int k = 0;
    for (; k + 5 <= R; k += 3) {
        ln_load<MODE>(a, m0 + k + 2, vc, lane);
        asm volatile("" ::: "memory");
        ln_process<MODE>(a, m0 + k, va, V, lane);
        ln_load<MODE>(a, m0 + k + 3, va, lane);
        asm volatile("" ::: "memory");
        ln_process<MODE>(a, m0 + k + 1, vb, V, lane);
        ln_load<MODE>(a, m0 + k + 4, vb, lane);
        asm volatile("" ::: "memory");
        ln_process<MODE>(a, m0 + k + 2, vc, V, lane);
    }
    const int rem = R - k;
    if (rem >= 3) ln_load<MODE>(a, m0 + k + 2, vc, lane);
    asm volatile("" ::: "memory");
    ln_process<MODE>(a, m0 + k, va, V, lane);
    if (rem >= 4) ln_load<MODE>(a, m0 + k + 3, va, lane);
    asm volatile("" ::: "memory");
    ln_process<MODE>(a, m0 + k + 1, vb, V, lane);
    if (rem >= 3) ln_process<MODE>(a, m0 + k + 2, vc, V, lane);
    if (rem >= 4) ln_process<MODE>(a, m0 + k + 3, va, V, lane);
    }
}
template <int MODE>
__device__ __forceinline__ void ln_phase(const LnArgs& a, int gw, int NGW, int lane) {
    const int Rl = NLAT / NGW, Rc = NCTX / NGW;
    if (Rl * NGW == NLAT && (Rl & 1) == 0 && Rl >= 2 && SEQ % Rl == 0 && Rc * NGW == NCTX && (Rc & 1) == 0 && Rc >= 2) {
        ln_block<MODE>(a, gw * Rl, Rl, (gw * Rl) >> 11, lane);
        if (a.nrows > NLAT) ln_block<MODE>(a, NLAT + gw * Rc, Rc, 16, lane);
    } else {
        for (int m = gw; m < a.nrows; m += NGW) { LnVecs V; const int bi = (m < NLAT) ? (m >> 11) : 16;
            if (MODE >= 1) { const f32x4* gp = (const f32x4*)a.g + 2 * lane; const f32x4* bp = (const f32x4*)a.b + 2 * lane;
#pragma unroll
                for (int j = 0; j < 8; ++j) { V.gg[j] = gp[128 * (j >> 1) + (j & 1)]; V.bb[j] = bp[128 * (j >> 1) + (j & 1)]; } }
            if (MODE <= 1) ln_modvecs(a, bi, V, lane);
            f32x4 v[8]; ln_load<MODE>(a, m, v, lane); ln_process<MODE>(a, m, v, V, lane); }
    }
}

struct Raw16 { u32x4 a, b; };
__device__ __forceinline__ Raw16 ldraw(const bf16_t* p) { Raw16 r; r.a = *(const u32x4*)p; r.b = *(const u32x4*)(p + 8); return r; }
__device__ __forceinline__ void dec16(const Raw16& r, float (&v)[16]) {
    v[0] = bflo(r.a.x); v[1] = bfhi(r.a.x); v[2] = bflo(r.a.y); v[3] = bfhi(r.a.y); v[4] = bflo(r.a.z); v[5] = bfhi(r.a.z); v[6] = bflo(r.a.w); v[7] = bfhi(r.a.w);
    v[8] = bflo(r.b.x); v[9] = bfhi(r.b.x); v[10] = bflo(r.b.y); v[11] = bfhi(r.b.y); v[12] = bflo(r.b.z); v[13] = bfhi(r.b.z); v[14] = bflo(r.b.w); v[15] = bfhi(r.b.w);
}
__device__ __forceinline__ void store16(bf16_t* p, const float (&v)[16]) {
    u32x4 a, b; a.x = cvt_pk_bf16(v[0], v[1]); a.y = cvt_pk_bf16(v[2], v[3]); a.z = cvt_pk_bf16(v[4], v[5]); a.w = cvt_pk_bf16(v[6], v[7]);
    b.x = cvt_pk_bf16(v[8], v[9]); b.y = cvt_pk_bf16(v[10], v[11]); b.z = cvt_pk_bf16(v[12], v[13]); b.w = cvt_pk_bf16(v[14], v[15]);
    *(u32x4*)p = a; *(u32x4*)(p + 8) = b;
}
__device__ __forceinline__ void qk_norm_rope(const Raw16& raw, bf16_t* p, const float* gain, const float* ropec, const float* ropes, int pos, int lane, bool dry) {
    float v[16]; dec16(raw, v);
    float ss = 0.f;
#pragma unroll
    for (int j = 0; j < 16; ++j) ss += v[j] * v[j];
    ss += shfl_xor_l(ss, 1, lane); ss += shfl_xor_l(ss, 2, lane); ss += shfl_xor_l(ss, 4, lane);
    const float rinv = 1.0f / sqrtf(ss * (1.f / 128.f) + LN_EPS);
    const int l8 = lane & 7;
#pragma unroll
    for (int j = 0; j < 16; ++j) v[j] = v[j] * rinv * gain[l8 * 16 + j];
    if (pos >= 0) {
        const int ti = ((l8 & 4) ? 32 + (pos & 63) : (pos >> 6)) * 32 + 16 * (l8 & 1);
#pragma unroll
        for (int j = 0; j < 16; ++j) { const float pr = shfl_xor_l(v[j], 2, lane); const float c = ropec[ti + j], sn = ropes[ti + j]; v[j] = v[j] * c + ((l8 & 2) ? pr : -pr) * sn; }
    }
    if (!(PROBE_DUP && dry)) store16(p, v);
}
__device__ __forceinline__ void prep_row(bf16_t* zr, int pos, int seqlen, bool rope, bool do_q, bool do_conv, const float* qg, const float* kg, const float* cw, const float* ropec, const float* ropes, int lane, bool dry = false) {
    const int ch = lane * 16; const bool hp = pos > 0, hn = pos < seqlen - 1;
    Raw16 rq, rk, rb, rc, ru, rcp, rup, rcn, run;
    rq = rk = rb = rc = ru = rcp = rup = rcn = run = Raw16{(u32x4){0u, 0u, 0u, 0u}, (u32x4){0u, 0u, 0u, 0u}};
    if (do_q) rq = ldraw(zr + QB0 + ch);
    if (lane < 16) rk = ldraw(zr + KB0 + ch);
    if (do_conv) { rb = ldraw(zr + CB0 + ch); rc = ldraw(zr + CC0 + ch); ru = ldraw(zr + CX0 + ch);
        if (hp) { rcp = ldraw(zr - INW + CC0 + ch); rup = ldraw(zr - INW + CX0 + ch); }
        if (hn) { rcn = ldraw(zr + INW + CC0 + ch); run = ldraw(zr + INW + CX0 + ch); } }
    asm volatile("" ::: "memory");
    if (do_q) qk_norm_rope(rq, zr + QB0 + ch, qg, ropec, ropes, rope ? pos : -1, lane, dry);
    if (lane < 16) qk_norm_rope(rk, zr + KB0 + ch, kg, ropec, ropes, rope ? pos : -1, lane, dry);
    if (do_conv) {
        float bg[16], c1[16], u1[16], accv[16];
        dec16(rb, bg); dec16(rc, c1); dec16(ru, u1);
#pragma unroll
        for (int j = 0; j < 16; ++j) accv[j] = cw[1024 + ch + j] * (c1[j] * u1[j]);
        dec16(rcp, c1); dec16(rup, u1);
#pragma unroll
        for (int j = 0; j < 16; ++j) accv[j] += cw[ch + j] * (c1[j] * u1[j]);
        dec16(rcn, c1); dec16(run, u1);
#pragma unroll
        for (int j = 0; j < 16; ++j) accv[j] += cw[2048 + ch + j] * (c1[j] * u1[j]);
#pragma unroll
        for (int j = 0; j < 16; ++j) accv[j] *= bg[j];
        if (!(PROBE_DUP && dry)) store16(zr + CB0 + ch, accv);
    }
}

typedef const __attribute__((address_space(4))) Args* KArgs;
#define PHASE_CTX \
    KArgs ap = (KArgs)__builtin_amdgcn_kernarg_segment_ptr(); asm volatile("" : "+s"(ap)); \
    const int lane = lane_id_opaque(); const int wave = wave_s; int tid = wave_s * 64 + lane; asm volatile("" : "+v"(tid)); \
    const int G = gridDim.x, bx = blockIdx.x, vcu = (G % 8 == 0) ? (bx % 8) * (G / 8) + bx / 8 : bx; \
    const int gw = vcu * 8 + wave, NGW = G * 8; \
    unsigned char* ws = ap->ws; (void)lane; (void)gw; (void)NGW;
#define WSP(T, off) ((T*)(ws + (off)))

__global__ void __launch_bounds__(512, 2) mk_fwd(Args args) {
    extern __shared__ __attribute__((aligned(16))) unsigned char lds[];
    LAS unsigned char* const ldsl = (LAS unsigned char*)lds;
    {
        const int t0 = threadIdx.x;
        for (int u = t0; u < (LDS_BYTES - LDSCTL_OFF) / 4; u += 512) ((LAS unsigned*)(ldsl + LDSCTL_OFF))[u] = 0u;
    }
    __syncthreads();
    const int wave_s = __builtin_amdgcn_readfirstlane((int)threadIdx.x >> 6);
    const int lo = args.ph_lo, hi = args.ph_hi;
    XcdBarrier bar; bar.bar = (unsigned*)(args.ws + WS_CTL) + CW_BAR; bar.x = 0; bar.st = (volatile LAS unsigned*)(ldsl + MISC_OFF + 32);
    if (hi - lo > 1) bar = xcd_barrier_post((unsigned*)(args.ws + WS_CTL) + CW_BAR, (volatile LAS unsigned*)(ldsl + MISC_OFF + 32));
    int pid = 0;
#define PHASE_BEGIN if (lo <= pid && pid < hi) { PHASE_CTX
#define PHASE_END   if (pid + 1 < hi) { xcd_barrier(bar, tid == 0); if (PROBE_DUP & 16) xcd_barrier(bar, tid == 0); } } ++pid;

    PHASE_BEGIN
    _Pragma("unroll 1") for (int rep = (PROBE_DUP & 4) ? 0 : 1; rep < 2; ++rep)
    {
        const float* c_in = ap->in[1]; const float* cctx_in = ap->in[3]; const float* w_mod = ap->in[4]; const float* b_mod = ap->in[5];
        float* MOD = WSP(float, WS_MOD); float* ROPEC = WSP(float, WS_ROPE); float* ROPES = ROPEC + 96 * 32;
        if (bx < 192) {
            const int l = bx / 96, n0 = (bx % 96) * 128;
            LAS float* cact = (LAS float*)ldsl;
            for (int i = tid; i < 17 * DM; i += 512) { const int b = i >> 11, k = i & 2047; const float v = (b < 16) ? c_in[b * DM + k] : cctx_in[k]; cact[i] = v / (1.0f + __expf(-v)); }
            __syncthreads();
            const int c4 = tid & 31, kg = tid >> 5;
            f32x4 acc[17];
#pragma unroll
            for (int b = 0; b < 17; ++b) acc[b] = (f32x4){0.f, 0.f, 0.f, 0.f};
            const float* wp = w_mod + ((size_t)l * DM + kg * 128) * MODW + n0 + 4 * c4;
            for (int kk = 0; kk < 128; kk += 4) {
                const f32x4 w0 = *(const f32x4*)(wp + (size_t)(kk + 0) * MODW), w1 = *(const f32x4*)(wp + (size_t)(kk + 1) * MODW), w2 = *(const f32x4*)(wp + (size_t)(kk + 2) * MODW), w3 = *(const f32x4*)(wp + (size_t)(kk + 3) * MODW);
#pragma unroll
                for (int b = 0; b < 17; ++b) { const f32x4 a = *(const LAS f32x4*)(cact + b * DM + kg * 128 + kk); acc[b] += w0 * a.x + w1 * a.y + w2 * a.z + w3 * a.w; }
            }
            __syncthreads();
            LAS float* part = (LAS float*)ldsl;
            const int tid2 = wave_s * 64 + lane_id_opaque(), c4b = tid2 & 31, kgb = tid2 >> 5;
#pragma unroll
            for (int b = 0; b < 17; ++b) *(LAS f32x4*)(part + (kgb * 17 + b) * 128 + 4 * c4b) = acc[b];
            __syncthreads();
            for (int o = tid2; o < 17 * 128; o += 512) { const int b = o >> 7, n = o & 127; float sacc = b_mod[l * MODW + n0 + n];
#pragma unroll
                for (int g = 0; g < 16; ++g) sacc += part[(g * 17 + b) * 128 + n];
                MOD[((size_t)l * 17 + b) * MODW + n0 + n] = sacc; }
            __syncthreads();
        } else if (bx == 192) {
            for (int i = tid; i < 96 * 32; i += 512) { const int pos = i >> 5, fi = i & 31; const float p = (float)(pos < 32 ? pos : pos - 32);
                const float freq = powf(10000.0f, -(float)(2 * fi) / 64.0f); const float ang = p * freq; ROPEC[i] = cosf(ang); ROPES[i] = sinf(ang); }
        }
        const float* w_in = ap->in[6]; const float* w_branch = ap->in[11]; const float* w_o = ap->in[12]; const float* w_up = ap->in[13]; const float* w_down = ap->in[14];
        LAS float* scr = (LAS float*)(ldsl + wave * 16384);
        constexpr int I_IN = (DM / 64) * (INW / 32), I_BR = (1024 / 64) * (DM / 32), I_O = (DM / 64) * (DM / 32), I_UP = (DM / 64) * (HID / 32), I_DN = (HID / 64) * (DM / 32);
        constexpr int I_LAYER = I_IN + 3 * I_BR + I_O + I_UP + I_DN;
        for (int it = gw; it < 2 * I_LAYER; it += NGW) {
            const int l = it / I_LAYER; int r = it - l * I_LAYER; unsigned char* wl = ws + WS_W + (size_t)l * W_LAYER;
            if (r < I_IN) { const int kb_ = r / (INW / 32), nb_ = r % (INW / 32), n0_ = 32 * nb_;
                if (n0_ >= CB0 && n0_ < G0) transpose_item(w_in + (size_t)l * DM * INW + CB0, INW, (bf16_t*)(wl + W_IN), DM, scr, kb_, nb_ - CB0 / 32, lane);
                else if ((kb_ & 1) == 0) {
                    const int row0_ = (n0_ < CB0) ? 0 : (G0 - CB0);
                    transpose_item8(w_in + (size_t)l * DM * INW, INW, wl + W_G8, DM, scr, kb_, nb_, row0_, lane); transpose_item8(w_in + (size_t)l * DM * INW, INW, wl + W_G8, DM, scr, kb_ + 1, nb_, row0_, lane); }
                continue; } r -= I_IN;
            if (r < 3 * I_BR) { const int i = r / I_BR, rr = r % I_BR; transpose_item(w_branch + ((size_t)l * 3 + i) * 1024 * DM, DM, (bf16_t*)(wl + W_BR) + i * 1024, 3072, scr, rr / (DM / 32), rr % (DM / 32), lane); continue; } r -= 3 * I_BR;
            if (r < I_O) { transpose_item(w_o + (size_t)l * DM * DM, DM, (bf16_t*)(wl + W_O), DM, scr, r / (DM / 32), r % (DM / 32), lane); continue; } r -= I_O;
            if (r < I_UP) { transpose_item(w_up + (size_t)l * DM * HID, HID, (bf16_t*)(wl + W_UP), DM, scr, r / (HID / 32), r % (HID / 32), lane); continue; } r -= I_UP;
            transpose_item(w_down + (size_t)l * HID * DM, DM, (bf16_t*)(wl + W_DN), HID, scr, r / (DM / 32), r % (DM / 32), lane);
        }
        if (PROBE_DUP & 4) __syncthreads();
    }
    PHASE_END

    PHASE_BEGIN
    {
        const float* x_in = ap->in[0]; const float* ctx_in = ap->in[2]; const float* MOD = WSP(float, WS_MOD); bf16_t* H = WSP(bf16_t, WS_H);
        const LnArgs la{MALL, x_in, ctx_in, nullptr, nullptr, H, WSP(unsigned char, WS_H8), nullptr, nullptr, nullptr, MOD, 0, 1};
        _Pragma("unroll 1") for (int rep = (PROBE_DUP & 8) ? 0 : 1; rep < 2; ++rep)
        ln_phase<0>(la, gw, NGW, lane);
    }
    PHASE_END

    for (int l = 0; l < DEPTH; ++l) {
        const bool with_ctx = (l == 0);
        for (int k = -1; k < 2; ++k) {
            PHASE_BEGIN
            {
                if (k >= 0) {
                    const int ch = k; const bool ctx_here = (ch == 0);
                GWo P; P.A_lat = WSP(bf16_t, WS_H); P.A_ctx = P.A_lat + (size_t)NLAT * DM; P.a_lat0 = 0; P.W = (const bf16_t*)(ws + WS_W + (size_t)l * W_LAYER + W_O); P.lda = DM; P.ldb = DM; P.kstepA = 128; P.kstepB = 128; P.apan = 256 * DM;
                P.res_lat = (l == 0) ? (const void*)ap->in[0] : (const void*)ap->out; P.res_ctx = ap->in[2]; P.out_lat = (half_t*)ap->out; P.out_ctx = WSP(half_t, WS_CTXS);   P.mod = WSP(float, WS_MOD) + (size_t)l * 17 * MODW; P.modj = 2;
                P.lnres = (l > 0); P.stats = WSP(float, WS_STATS); P.lg = ap->in[15] + (size_t)((l > 0 ? l - 1 : 0) * 2 + 1) * DM; P.lb = ap->in[16] + (size_t)((l > 0 ? l - 1 : 0) * 2 + 1) * DM;
                P.tp = TwoPart{ch * PAN_CH, DM / 256, (with_ctx && ctx_here) ? PAN_CTX : 0, DM / 256, 0, G, bx, PAN_LAT};
                P.dry = 0; pg8::gemm_phase<GWo>(ldsl, P, tid);
                }
                if (k + 1 < 2) {
                    const int ch = k + 1; const bool ctx_here = (ch == 0);
                    const int skn = with_ctx ? (ch == 0 ? 13 : 10) : (1 << 20), skc = with_ctx ? (ch == 0 ? 192 : 128) : 0, sks = with_ctx ? (ch == 0 ? 64 : 128) : 1;
                {
                GInProj P; P.H = WSP(bf16_t, WS_H); P.W = (const bf16_t*)(ws + WS_W + (size_t)l * W_LAYER + W_IN); P.Z = WSP(bf16_t, WS_Z); P.ZC = WSP(bf16_t, WS_ZC); P.lda = DM; P.ldb = DM; P.kstepA = 128; P.kstepB = 128; P.dry = 0;
                P.tp = TwoPart{ch * PAN_CH, NCV, (with_ctx && ctx_here) ? PAN_CTX : 0, NCV, 0, G, bx, PAN_LAT};
                int tid_c = wave_s * 64 + lane_id_opaque(); asm volatile("" : "+v"(tid_c));
                pg8::gemm_phase<GInProj>(ldsl, P, tid_c);
                }
                {
                GGate8 P; P.H8 = WSP(unsigned char, WS_H8); P.W8 = ws + WS_W + (size_t)l * W_LAYER + W_G8; P.Z = WSP(bf16_t, WS_Z); P.ZC = WSP(bf16_t, WS_ZC); P.lda = DM / 2; P.ldb = DM / 2; P.kstepA = 128; P.kstepB = 128; P.dry = 0;
                P.tp = with_ctx ? TwoPart{ch * PAN_CH, N8, ctx_here ? PAN_CTX : 0, N8, 0, G, bx, PAN_LAT}
                                : TwoPart{ch * PAN_CH, N8, PAN_CTX / 2, (CB0 - KA0) / 256, KA0 / 256, G, bx, PAN_LAT + ch * (PAN_CTX / 2)};
                P.nlo = skn; P.cbase = skc; P.span = sks;
                int tid_g = wave_s * 64 + lane_id_opaque(); asm volatile("" : "+v"(tid_g));
                pg8::gemm_phase<GGate8>(ldsl, P, tid_g);
                }
                }
            }
            PHASE_END
            if (k + 1 >= 2) break;
            const int ch = k + 1; const bool ctx_here = (ch == 0);
            PHASE_BEGIN
            {
                const float* qg = ap->in[8] + l * 128; const float* kg = ap->in[9] + l * 128; const float* cw = ap->in[10] + (size_t)l * 3 * 1024;
                const float* ROPEC = WSP(float, WS_ROPE); const float* ROPES = ROPEC + 96 * 32; bf16_t* Z = WSP(bf16_t, WS_Z); bf16_t* ZC = WSP(bf16_t, WS_ZC);
                const int nctx = with_ctx ? (ctx_here ? NCTX : 0) : NCTX / 2, ctx0 = with_ctx ? 0 : ch * (NCTX / 2);
                const int nrows = CHROWS + nctx;
                _Pragma("unroll 1") for (int rep = (PROBE_DUP & 32) ? 0 : 1; rep < 2; ++rep)
                for (int m = gw; m < nrows; m += NGW) {
                    if (m < CHROWS) prep_row(Z + (size_t)m * INW, m & 2047, SEQ, true, false, true, qg, kg, cw, ROPEC, ROPES, lane, rep == 0);
                    else { const int mc = ctx0 + m - CHROWS; prep_row(ZC + (size_t)mc * INW, mc & 255, CTXL, false, with_ctx, with_ctx, qg, kg, cw, ROPEC, ROPES, lane, rep == 0); }
                }
            }
            PHASE_END
            PHASE_BEGIN
            {
                bf16_t* Z = WSP(bf16_t, WS_Z); bf16_t* ZC = WSP(bf16_t, WS_ZC); const float* rpb = ap->in[7];
                const int n_dense = 512 + ((with_ctx && ctx_here) ? 256 : 0);
                _Pragma("unroll 1") for (int rep = (PROBE_DUP & 2) ? 0 : 1; rep < 2; ++rep) {
                for (int id = bx; id < n_dense; id += G) {
                    att::AUnit A; A.r0 = 0; A.lo = 0; A.rpb = nullptr; A.dry = (rep == 0); A.qgain = nullptr; A.ropec = nullptr; A.pos0 = 0;
                    if (id < 512) {
                        const int it = id >> 8, cc = id & 255, pair = (cc & 7) + 8 * it, j = cc >> 3;
                        const int bl = pair >> 1, qh = (pair & 1) * 4 + (j >> 3), qb = j & 7, b = ch * 8 + bl;
                        A.Q = Z + ((size_t)(bl * SEQ + qb * 256) * INW + QB0 + qh * 128);
                        A.P0 = Z + ((size_t)(bl * SEQ) * INW + KB0 + (qh >> 2) * 128); A.P1 = ZC + ((size_t)(b * CTXL) * INW + KB0 + (qh >> 2) * 128);
                        A.nfirst = 32; A.NT = 36; A.vofs = VB0 - KB0; A.qgain = ap->in[8] + l * 128; A.ropec = WSP(float, WS_ROPE); A.pos0 = qb * 256;
                    } else {
                        const int i2 = id - 512, b = i2 >> 4, hh = i2 & 15; const bf16_t* zb = ZC + (size_t)(b * CTXL) * INW;
                        if (hh < 8) { A.Q = zb + QA0 + hh * 128; A.P0 = zb + KA0 + hh * 128; A.vofs = VA0 - KA0; }
                        else { const int qh = hh - 8; A.Q = zb + QB0 + qh * 128; A.P0 = zb + KB0 + (qh >> 2) * 128; A.vofs = VB0 - KB0; }
                        A.P1 = A.P0; A.nfirst = 4; A.NT = 4;
                    }
                    att::attn_unit<false>(A, (char*)lds, ldsl, tid);
                }
                for (int id = bx; id < 512; id += G) {
                    const int it = id >> 8, cc = id & 255, pairn = (cc & 7) * 8 + 4 * it + (cc >> 6), r0 = 4 * ((cc >> 3) & 7);
                    const int bl = pairn >> 3, h = pairn & 7;
                    const int b = ch * 8 + bl; const bool edge = (r0 == 0 || r0 == 28); const int lo_ = (r0 == 0) ? 0 : (r0 == 28 ? 24 : r0 - 4);
                    att::AUnit A; A.Q = Z + ((size_t)(bl * SEQ + r0 * 64) * INW + QA0 + h * 128);
                    A.P0 = ZC + ((size_t)(b * CTXL) * INW + KA0 + h * 128); A.P1 = Z + ((size_t)(bl * SEQ + lo_ * 64) * INW + KA0 + h * 128);
                    A.nfirst = 4; A.NT = 4 + (edge ? 8 : 12); A.vofs = VA0 - KA0; A.r0 = r0; A.lo = lo_; A.rpb = rpb + ((size_t)l * 8 + h) * 15 * 31; A.dry = (rep == 0); A.qgain = nullptr; A.ropec = nullptr; A.pos0 = 0;
                    att::attn_unit<true>(A, (char*)lds, ldsl, tid);
                }
                }
            }
            PHASE_END
            PHASE_BEGIN
            {
                GBranch P; P.Z = WSP(bf16_t, WS_Z); P.ZC = WSP(bf16_t, WS_ZC); P.W = (const bf16_t*)(ws + WS_W + (size_t)l * W_LAYER + W_BR); P.Hout = WSP(bf16_t, WS_H); P.lda = INW; P.ldb = 3072; P.kstepA = 128; P.kstepB = 128;
                P.tp = TwoPart{ch * PAN_CH, DM / 256, (with_ctx && ctx_here) ? PAN_CTX : 0, DM / 256, 0, G, bx, PAN_LAT};
                _Pragma("unroll 1") for (int rep = (((PROBE_DUP & 1) != 0) && ((PROBE_GEMM_MASK & 2) != 0)) ? 0 : 1; rep < 2; ++rep) { P.dry = (rep == 0) && !PROBE_REAL; pg8::gemm_phase<GBranch>(ldsl, P, tid); }
            }
            PHASE_END
        }
        PHASE_BEGIN
        {
            const int nrows = with_ctx ? MALL : NLAT; const float* g = ap->in[15] + (size_t)(l * 2 + 0) * DM; const float* bb = ap->in[16] + (size_t)(l * 2 + 0) * DM;
            float* OUT = ap->out; float* CTXS = WSP(float, WS_CTXS); bf16_t* H = WSP(bf16_t, WS_H); const float* MODL = WSP(float, WS_MOD) + (size_t)l * 17 * MODW;
            const LnArgs la{nrows, (const void*)OUT, (const void*)CTXS, OUT, CTXS, H, nullptr, WSP(float, WS_STATS), g, bb, MODL, 3, 4};
            _Pragma("unroll 1") for (int rep = (PROBE_DUP & 64) ? 0 : 1; rep < 2; ++rep)
            ln_phase<1>(la, gw, NGW, lane);
        }
        PHASE_END
        for (int st = 0; st < 3; ++st) {
            PHASE_BEGIN
            {
                if (st >= 1) {
                    const int ch = st - 1; const bool ctx_here = (ch == 0) && with_ctx;
                GDown P; P.A_lat = WSP(bf16_t, ch == 0 ? WS_U0 : WS_U1); P.A_ctx = P.A_lat + (size_t)CHROWS * HID; P.a_lat0 = ch * PAN_CH; P.W = (const bf16_t*)(ws + WS_W + (size_t)l * W_LAYER + W_DN); P.lda = 64; P.ldb = HID; P.kstepA = 256 * 64 * 2; P.kstepB = 128; P.apan = 256 * HID;
                P.res_lat = ap->out; P.res_ctx = WSP(half_t, WS_CTXS); P.out_lat = (l + 1 < DEPTH) ? (half_t*)ap->out : WSP(half_t, WS_H); P.out_ctx = WSP(half_t, WS_CTXS);   P.mod = WSP(float, WS_MOD) + (size_t)l * 17 * MODW; P.modj = 5;
                P.lnres = 1; P.stats = WSP(float, WS_STATS); P.lg = ap->in[15] + (size_t)(l * 2 + 0) * DM; P.lb = ap->in[16] + (size_t)(l * 2 + 0) * DM;
                P.tp = TwoPart{ch * PAN_CH, DM / 256, ctx_here ? PAN_CTX : 0, DM / 256, 0, G, bx, PAN_LAT};
                P.dry = 0; pg8::gemm_phase<GDown>(ldsl, P, tid);
                }
                if (st < 2) {
                    const int ch = st; const bool ctx_here = (ch == 0) && with_ctx;
                GUp P; P.H = WSP(bf16_t, WS_H); P.W = (const bf16_t*)(ws + WS_W + (size_t)l * W_LAYER + W_UP); P.U = WSP(bf16_t, ch == 0 ? WS_U0 : WS_U1); P.lda = DM; P.ldb = DM; P.kstepA = 128; P.kstepB = 128;
                P.tp = TwoPart{ch * PAN_CH, HID / 256, ctx_here ? PAN_CTX : 0, HID / 256, 0, G, bx, PAN_LAT};
                P.dry = 0; P.nlo = (with_ctx && ch == 1) ? 6 : (1 << 20); P.cbase = 128; P.span = 128;
                int tid_u = wave_s * 64 + lane_id_opaque(); asm volatile("" : "+v"(tid_u));
                pg8::gemm_phase<GUp>(ldsl, P, tid_u);
                }
            }
            PHASE_END
        }
        PHASE_BEGIN
        {
            const int nrows = with_ctx ? MALL : NLAT; const float* g = ap->in[15] + (size_t)(l * 2 + 1) * DM; const float* bb = ap->in[16] + (size_t)(l * 2 + 1) * DM;
            float* OUT = ap->out; float* CTXS = WSP(float, WS_CTXS); bf16_t* H = WSP(bf16_t, WS_H); const float* MODN = WSP(float, WS_MOD) + (size_t)(l + 1) * 17 * MODW;
            const LnArgs la{nrows, (l + 1 < DEPTH) ? (const void*)OUT : (const void*)H, (const void*)CTXS, OUT, CTXS, H, WSP(unsigned char, WS_H8), WSP(float, WS_STATS), g, bb, MODN, 0, 1};
            if (l + 1 < DEPTH) { _Pragma("unroll 1") for (int rep = (PROBE_DUP & 64) ? 0 : 1; rep < 2; ++rep) ln_phase<1>(la, gw, NGW, lane); }
            else ln_phase<2>(la, gw, NGW, lane);
        }
        PHASE_END
    }
#undef PHASE_BEGIN
#undef PHASE_END
}
constexpr int N_PHASES = 2 + DEPTH * (3 + 2 * 3 + 1 + 3 + 1);

extern "C" void kernel_launch(void* const* d_in, const int* in_sizes, int n_in, void* d_out, int out_size, void* d_ws, size_t ws_size, hipStream_t stream) {
    static int grid = 0;
    if (grid == 0) {
        if (n_in != 17 || in_sizes[0] != NLAT * DM || out_size != NLAT * DM || ws_size < WS_END) { fprintf(stderr, "kernel_launch: shape / workspace mismatch (ws %zu, need %zu)\n", ws_size, (size_t)WS_END); grid = -1; return; }
        int dev = 0, cus = 0, per_cu = 0;
        if (hipGetDevice(&dev) != hipSuccess || hipDeviceGetAttribute(&cus, hipDeviceAttributeMultiprocessorCount, dev) != hipSuccess) { grid = -1; return; }
        if (hipFuncSetAttribute((const void*)mk_fwd, hipFuncAttributeMaxDynamicSharedMemorySize, LDS_BYTES) != hipSuccess) { fprintf(stderr, "kernel_launch: hipFuncSetAttribute failed\n"); grid = -1; return; }
        if (hipOccupancyMaxActiveBlocksPerMultiprocessor(&per_cu, (const void*)mk_fwd, 512, LDS_BYTES) != hipSuccess || per_cu < 1) fprintf(stderr, "kernel_launch: occupancy query says %d\n", per_cu);
        (void)hipGetLastError();
        if (cus != 256) { fprintf(stderr, "kernel_launch: the skewed unit deals are laid out for 256 CUs (have %d)\n", cus); grid = -1; return; }
        grid = cus;
    }
    if (grid < 0) return;
    if (hipMemsetAsync((char*)d_ws + WS_CTL, 0, CTL_ZERO_BYTES, stream) != hipSuccess) return;
    Args a{};
    for (int i = 0; i < 17; ++i) a.in[i] = (const float*)d_in[i];
    a.out = (float*)d_out; a.ws = (unsigned char*)d_ws;
#if MK_PER_PHASE
    for (int p = 0; p < N_PHASES; ++p) { a.ph_lo = p; a.ph_hi = p + 1; hipLaunchKernelGGL(mk_fwd, dim3(grid), dim3(512), LDS_BYTES, stream, a); }
#else
    a.ph_lo = 0; a.ph_hi = N_PHASES;
    hipLaunchKernelGGL(mk_fwd, dim3(grid), dim3(512), LDS_BYTES, stream, a);
#endif
    const hipError_t le = hipPeekAtLastError();
    if (le != hipSuccess) fprintf(stderr, "kernel_launch: launch failed: %s\n", hipGetErrorName(le));
}
```

```cpp
#include <hip/hip_runtime.h>
#include <cstdio>
#include <cstdint>
#include <cmath>

#define LAS __attribute__((address_space(3)))
#define GAS __attribute__((address_space(1)))
typedef unsigned short bf16_t;
typedef short bf16x8 __attribute__((ext_vector_type(8)));
typedef short bf16x16_t __attribute__((ext_vector_type(16)));
typedef short s16x4 __attribute__((ext_vector_type(4)));
typedef float f32x4 __attribute__((ext_vector_type(4)));
typedef float f32x2 __attribute__((ext_vector_type(2)));
typedef float f32x16 __attribute__((ext_vector_type(16)));
typedef unsigned u32x4 __attribute__((ext_vector_type(4)));
typedef unsigned u32x2 __attribute__((ext_vector_type(2)));
typedef int i32x8 __attribute__((ext_vector_type(8)));

#ifndef PROBE_DUP
#define PROBE_DUP 0
#endif
#ifndef STAGGER_TICKS
#define STAGGER_TICKS 0
#endif
#ifndef PROBE_REAL
#define PROBE_REAL 0
#endif
#ifndef PROBE_GEMM_MASK
#define PROBE_GEMM_MASK 31
#endif
#ifndef MK_PER_PHASE
#define MK_PER_PHASE 0
#endif

constexpr int DM = 2048, NB = 16, SEQ = 2048, CTXL = 256, HD = 128, HID = 8192, DEPTH = 2;
constexpr int QA0 = 0, QB0 = 1024, KA0 = 2048, VA0 = 3072, KB0 = 4096, VB0 = 4352, CB0 = 4608, CC0 = 5632, CX0 = 6656, G0 = 7680, INW = 13824;
constexpr int NLAT = NB * SEQ, NCTX = NB * CTXL, MALL = NLAT + NCTX;
constexpr int CHROWS = 16384, PAN_CH = 64, PAN_LAT = 128, PAN_CTX = 16;
constexpr float LN_EPS = 1e-6f, DN_ALPHA = 1.4142135623730951f, ATT_SCALE = 0.08838834764831845f;
constexpr int MODW = 6 * DM;

constexpr size_t MiB = 1u << 20;
constexpr size_t WS_CTL = 0, CTL_ZERO_BYTES = 1 * MiB;
constexpr size_t WS_MOD = 1 * MiB;
constexpr size_t WS_ROPE = 3 * MiB;
constexpr size_t WS_STATS = 3 * MiB + 512 * 1024;
constexpr int NQKV = CB0 / 256, NCV = (G0 - CB0) / 256, NGT = (INW - G0) / 256, N8 = NQKV + NGT;
constexpr size_t WS_W = 4 * MiB;
constexpr size_t W_IN = 0, W_G8 = 12 * MiB, W_BR = 34 * MiB, W_O = 46 * MiB, W_UP = 54 * MiB, W_DN = 86 * MiB, W_LAYER = 126 * MiB;
constexpr size_t WS_CTXS = 256 * MiB;
constexpr size_t WS_H = 272 * MiB;
constexpr size_t WS_H8 = 416 * MiB;
constexpr size_t WS_ZC = 488 * MiB;
constexpr size_t WS_Z = 596 * MiB;
constexpr size_t WS_END = 1028 * MiB;
constexpr size_t WS_U0 = WS_END - (size_t)(CHROWS + NCTX) * HID * 2, WS_U1 = WS_H8;
static_assert(WS_U1 + (size_t)CHROWS * HID * 2 <= WS_U0 && WS_U0 >= WS_Z, "U buffers");
static_assert(WS_W + 2 * W_LAYER <= WS_CTXS && WS_CTXS + (size_t)NCTX * DM * 2 <= WS_H && WS_H + (size_t)MALL * DM * 2 <= WS_H8 && WS_H8 + (size_t)MALL * DM <= WS_ZC && WS_ZC + (size_t)NCTX * INW * 2 <= WS_Z && WS_Z + (size_t)CHROWS * INW * 2 <= WS_END, "ws map");
static_assert((size_t)(G0 - CB0) * DM * 2 <= W_G8 && W_G8 + (size_t)N8 * 256 * DM <= W_BR, "weight map");
static_assert((size_t)(CHROWS + NCTX) * HID * 2 <= WS_END - WS_Z, "U overlay");
constexpr int CW_TMO = 0, CW_BAR = 4096;

constexpr int RING_BYTES = 131072;
constexpr int SCR_BYTES = 139264;
constexpr int LDSCTL_OFF = SCR_BYTES, MISC_OFF = LDSCTL_OFF + 64;
constexpr int LDS_BYTES = 147456;

#define RLX_AGENT __ATOMIC_RELAXED, __HIP_MEMORY_SCOPE_AGENT
#define LDS_WAIT() asm volatile("s_waitcnt lgkmcnt(0)" ::: "memory")
#define VM_WAIT() asm volatile("s_waitcnt vmcnt(0)" ::: "memory")
typedef float f32x2_cv __attribute__((ext_vector_type(2))); typedef __bf16 bf16x2_cv __attribute__((ext_vector_type(2)));
__device__ __forceinline__ unsigned cvt_pk_bf16(float lo, float hi) { const f32x2_cv v = {lo, hi}; const bf16x2_cv b = __builtin_convertvector(v, bf16x2_cv); return __builtin_bit_cast(unsigned, b); }
__device__ __forceinline__ float bflo(unsigned w) { return __uint_as_float(w << 16); }
__device__ __forceinline__ float bfhi(unsigned w) { return __uint_as_float(w & 0xffff0000u); }
typedef _Float16 h16x2 __attribute__((ext_vector_type(2)));
__device__ __forceinline__ unsigned pk_h2(float a, float b) { a = __builtin_amdgcn_fmed3f(a, -60000.f, 60000.f); b = __builtin_amdgcn_fmed3f(b, -60000.f, 60000.f); h16x2 h = {(_Float16)a, (_Float16)b}; return __builtin_bit_cast(unsigned, h); }
__device__ __forceinline__ f32x2 un_h2(unsigned w) { const h16x2 h = __builtin_bit_cast(h16x2, w); return (f32x2){(float)h.x, (float)h.y}; }
__device__ __forceinline__ void un_h8(const u32x4 w, f32x4& lo, f32x4& hi) { const f32x2 a = un_h2(w.x), b = un_h2(w.y), c = un_h2(w.z), d = un_h2(w.w); lo = (f32x4){a.x, a.y, b.x, b.y}; hi = (f32x4){c.x, c.y, d.x, d.y}; }
constexpr float G8_WSCALE = 32.0f;
__device__ __forceinline__ unsigned pk_fp8x4(float a, float b, float c, float d) { int v = __builtin_amdgcn_cvt_pk_fp8_f32(a, b, 0, false); v = __builtin_amdgcn_cvt_pk_fp8_f32(c, d, v, true); return (unsigned)v; }
__device__ __forceinline__ int lane_id_opaque() { int l; asm volatile("v_mbcnt_lo_u32_b32 %0, -1, 0\n\tv_mbcnt_hi_u32_b32 %0, -1, %0" : "=v"(l)); return l; }
__device__ __forceinline__ float shfl_xor_l(float v, int mask, int lane) { return __uint_as_float((unsigned)__builtin_amdgcn_ds_bpermute((lane ^ mask) << 2, (int)__float_as_uint(v))); }
__device__ __forceinline__ float wave_sum(float v, int lane) {
#pragma unroll
    for (int o = 1; o < 64; o <<= 1) v += shfl_xor_l(v, o, lane);
    return v;
}

#define XB_TMO      128
#define XB_XCNT(j)  (256  + 64 * (j))
#define XB_XSUB(j)  (1280 + 64 * (j))
#define XB_XGEN(j)  (2304 + 64 * (j))
#define XB_TOP      3328
#define XB_TOPGEN   3392
#define XCD_BAR_WORDS 3456
#define XB_SPIN_CAP (1u << 20)
__device__ __forceinline__ unsigned xb_ld(unsigned* p)              { return __hip_atomic_load(p, __ATOMIC_RELAXED, __HIP_MEMORY_SCOPE_AGENT); }
__device__ __forceinline__ unsigned xb_add(unsigned* p, unsigned v) { return __hip_atomic_fetch_add(p, v, __ATOMIC_RELAXED, __HIP_MEMORY_SCOPE_AGENT); }
__device__ __forceinline__ unsigned xb_xcc_id() { return (unsigned)__builtin_amdgcn_s_getreg((3 << 11) | 20) & 0xFu; }
#define XB_SPIN(cond, bar) do { unsigned _sp = 0; while (cond) { __builtin_amdgcn_s_sleep(1); \
    if ((++_sp & 255u) == 0u) { if (xb_ld(&(bar)[XB_TMO])) break; if (_sp > XB_SPIN_CAP) { atomicAdd(&(bar)[XB_TMO], 1u); break; } } } } while (0)
struct XcdBarrier { unsigned* bar; unsigned x; volatile LAS unsigned* st; };
__device__ __forceinline__ XcdBarrier xcd_barrier_post(unsigned* bar, volatile LAS unsigned* st) {
    XcdBarrier b; b.bar = bar; b.x = xb_xcc_id(); b.st = st;
    if (threadIdx.x == 0) (void)xb_add(&bar[XB_XCNT(b.x)], 1u);
    return b;
}
__device__ __forceinline__ void xcd_barrier_complete(unsigned* bar, unsigned x, unsigned& nloc, unsigned& nx) {
    const unsigned G = gridDim.x * gridDim.y * gridDim.z;
    unsigned sum, cnt, mine, sp = 0u;
    for (;;) {
        sum = 0u; cnt = 0u; mine = 0u;
#pragma unroll
        for (unsigned j = 0; j < 16; ++j) { const unsigned c = xb_ld(&bar[XB_XCNT(j)]); sum += c; cnt += (c > 0u) ? 1u : 0u; mine = (j == x) ? c : mine; }
        if (sum == G) break;
        __builtin_amdgcn_s_sleep(1);
        if ((++sp & 255u) == 0u) { if (xb_ld(&bar[XB_TMO])) break; if (sp > XB_SPIN_CAP) { atomicAdd(&bar[XB_TMO], 1u); break; } }
    }
    nloc = mine > 0u ? mine : 1u; nx = cnt > 0u ? cnt : 1u;
}
__device__ __forceinline__ void xcd_barrier(const XcdBarrier& b, const bool leader) {
    asm volatile("s_waitcnt vmcnt(0)" ::: "memory");
    __syncthreads();
    if (leader) {
        unsigned* bar = b.bar;
        __builtin_amdgcn_s_waitcnt(0);
        unsigned nloc = b.st[0], nx = b.st[1];
        if (nloc == 0u) { xcd_barrier_complete(bar, b.x, nloc, nx); b.st[0] = nloc; b.st[1] = nx; }
        const unsigned old = xb_add(&bar[XB_XSUB(b.x)], 1u);
        const unsigned gen = old / nloc;
        if (old + 1u == (gen + 1u) * nloc) {
            __builtin_amdgcn_fence(__ATOMIC_RELEASE, "agent");
            asm volatile("s_waitcnt vmcnt(0)" ::: "memory");
            const unsigned og = xb_add(&bar[XB_TOP], 1u);
            const unsigned tg = og / nx;
            if (og + 1u == (tg + 1u) * nx) xb_add(&bar[XB_TOPGEN], 1u);
            else XB_SPIN(xb_ld(&bar[XB_TOPGEN]) == tg, bar);
            __builtin_amdgcn_fence(__ATOMIC_ACQUIRE, "agent");
            xb_add(&bar[XB_XGEN(b.x)], 1u);
            asm volatile("s_waitcnt vmcnt(0)" ::: "memory");
        } else {
            XB_SPIN(xb_ld(&bar[XB_XGEN(b.x)]) == gen, bar);
            __builtin_amdgcn_fence(__ATOMIC_ACQUIRE, "agent");
            asm volatile("s_waitcnt vmcnt(0)" ::: "memory");
        }
    }
    __syncthreads();
}

namespace pg8 {
constexpr int BM = 256, BK = 64, HALF = 128, HTB = HALF * BK * 2, STAGE_BYTES = 8 * HTB;
__host__ __device__ __forceinline__ int lds_byte(int r, int c) { const int st = (r >> 4) * 2 + (c >> 5), rr = r & 15, cc = c & 31, ob = rr * 64 + cc * 2; return st * 1024 + (ob ^ (((ob >> 9) & 1) << 5)); }
__host__ __device__ __forceinline__ void stage_rc(int b, int& R, int& C) { const int st = b / 1024, sb = b % 1024, swz = sb ^ (((sb >> 9) & 1) << 5); R = (st >> 1) * 16 + swz / 64; C = (st & 1) * 32 + (swz % 64) / 2; }
__host__ __device__ __forceinline__ int perm32(int rho) { const int n = rho >> 4, i = rho & 15; return 8 * (i >> 2) + 4 * n + (i & 3); }
struct Unit { int pm, pn, seg; };
__device__ __forceinline__ void tile_map(int L, int nwg, int nM, int nN, int& pm, int& pn) {
    const int q = nwg / 8, r = nwg % 8, xcd = L % 8, off = L / 8;
    const int wgid = (xcd < r ? xcd * (q + 1) : r * (q + 1) + (xcd - r) * q) + off;
    const int sh = (nN <= 8) ? 2 : 3, WG = 1 << sh;
    const int nig = WG * nN, gid = wgid / nig, rem = wgid - gid * nig; (void)nM;
    pm = gid * WG + (rem & (WG - 1)); pn = rem >> sh;
}

template <class P>
__device__ __forceinline__ void gemm_phase(LAS unsigned char* lds, const P& p, const int tid) {
    const int wid = __builtin_amdgcn_readfirstlane(tid >> 6), lane = tid & 63, wr = wid >> 2, wc = wid & 3, fr = lane & 15, fq = lane >> 4;
    constexpr int nt = P::NT;
    unsigned voffA[2], voffB[2];
#pragma unroll
    for (int i = 0; i < 2; ++i) { int R, C; stage_rc(tid * 16 + i * 8192, R, C); const int Rb = P::PERM ? ((R & ~31) + perm32(R & 31)) : R;
        voffA[i] = (unsigned)(R * p.lda + C) * 2u; voffB[i] = (unsigned)(Rb * p.ldb + C) * 2u; }
    const size_t kstepA = (size_t)p.kstepA, kstepB = (size_t)p.kstepB;
    const size_t hstepA = (size_t)HALF * p.lda * 2, hstepB = (size_t)HALF * p.ldb * 2;
    const unsigned ldsw = (unsigned)wid * 1024u;
    const int aoff = P::FP8 ? lds_byte(wr * 64 + fr, fq * 16) : lds_byte(wr * 64 + fr, fq * 8), boff = P::FP8 ? lds_byte(wc * 32 + fr, fq * 16) : lds_byte(wc * 32 + fr, fq * 8);
#define PG8_SA(b, h) (((b) * 2 + (h)) * HTB)
#define PG8_SB(b, h) ((4 + (b) * 2 + (h)) * HTB)
#define PG8_STAGE(bufoff, gbase, voff) do { _Pragma("unroll") for (int _i = 0; _i < 2; ++_i) \
        __builtin_amdgcn_global_load_lds((const unsigned*)((const char*)(gbase) + (voff)[_i]), (LAS unsigned*)(lds + (bufoff) + ldsw + _i * 8192), 16, 0, 0); } while (0)
typedef int i32x4_t __attribute__((ext_vector_type(4)));
#define PG8_LD32(p) __builtin_shufflevector(*(const LAS i32x4_t*)(p), *(const LAS i32x4_t*)((p) + 16), 0, 1, 2, 3, 4, 5, 6, 7)
#define PG8_LDA(dst, b, h) do { if constexpr (P::FP8) { _Pragma("unroll") for (int m = 0; m < 4; ++m) dst##8[m] = PG8_LD32(lds + PG8_SA(b, h) + aoff + m * 2048); } \
        else { _Pragma("unroll") for (int m = 0; m < 4; ++m) _Pragma("unroll") for (int k = 0; k < 2; ++k) dst[m][k] = *(const LAS bf16x8*)(lds + PG8_SA(b, h) + aoff + m * 2048 + k * 1024); } } while (0)
#define PG8_LDB(dst, b, h) do { if constexpr (P::FP8) { _Pragma("unroll") for (int n = 0; n < 2; ++n) dst##8[n] = PG8_LD32(lds + PG8_SB(b, h) + boff + n * 2048); } \
        else { _Pragma("unroll") for (int n = 0; n < 2; ++n) _Pragma("unroll") for (int k = 0; k < 2; ++k) dst[n][k] = *(const LAS bf16x8*)(lds + PG8_SB(b, h) + boff + n * 2048 + k * 1024); } } while (0)
#define PG8_MMA(ai, bj, At, Bt) do { __builtin_amdgcn_s_setprio(1); _Pragma("unroll") for (int m = 0; m < 4; ++m) _Pragma("unroll") for (int n = 0; n < 2; ++n) { \
        if constexpr (P::FP8) asm volatile("v_mfma_f32_16x16x128_f8f6f4 %0, %1, %2, %0" : "+v"(acc[ai][bj][m][n]) : "v"(Bt##8[n]), "v"(At##8[m])); \
        else { _Pragma("unroll") for (int k = 0; k < 2; ++k) acc[ai][bj][m][n] = __builtin_amdgcn_mfma_f32_16x16x32_bf16(Bt[n][k], At[m][k], acc[ai][bj][m][n], 0, 0, 0); } } __builtin_amdgcn_s_setprio(0); } while (0)
#define PG8_WAIT_V(n) asm volatile("s_waitcnt vmcnt(" #n ")" ::: "memory")
#define PG8_WAIT_L(n) asm volatile("s_waitcnt lgkmcnt(" #n ")" ::: "memory")
#define PG8_BAR __builtin_amdgcn_s_barrier()
#define PG8_SCHED __builtin_amdgcn_sched_barrier(0)
    Unit cur, nxt; int ui = 0;
    if (!p.next(0, cur)) return;
    if (STAGGER_TICKS > 0) {
        const unsigned long long t0 = __builtin_amdgcn_s_memrealtime(), dl = (unsigned long long)(((unsigned)blockIdx.x >> 3) & 7u) * STAGGER_TICKS;
        while (__builtin_amdgcn_s_memrealtime() - t0 < dl) __builtin_amdgcn_s_sleep(4);
    }
    f32x4 acc[2][2][4][2];
#pragma unroll
    for (int a = 0; a < 2; ++a)
#pragma unroll
        for (int b = 0; b < 2; ++b)
#pragma unroll
            for (int m = 0; m < 4; ++m)
#pragma unroll
                for (int n = 0; n < 2; ++n) acc[a][b][m][n] = (f32x4){0.f, 0.f, 0.f, 0.f};
    bf16x8 At[4][2], B0[2][2], B1[2][2]; i32x8 At8[4], B08[2], B18[2]; (void)At; (void)B0; (void)B1; (void)At8; (void)B08; (void)B18;
    const char* cA = p.a_ptr(cur); const char* cB = p.b_ptr(cur);
    PG8_STAGE(PG8_SB(0, 0), cB, voffB); PG8_STAGE(PG8_SB(0, 1), cB + hstepB, voffB); PG8_STAGE(PG8_SA(0, 0), cA, voffA); PG8_STAGE(PG8_SA(0, 1), cA + hstepA, voffA);
    if (wr == 1) PG8_BAR;
    PG8_WAIT_V(2); PG8_BAR;
    PG8_STAGE(PG8_SB(1, 0), cB + kstepB, voffB); PG8_STAGE(PG8_SA(1, 0), cA + kstepA, voffA); PG8_STAGE(PG8_SB(1, 1), cB + hstepB + kstepB, voffB);
    PG8_WAIT_V(6); PG8_BAR;
    for (;;) {
        const bool has_next = p.next(ui + 1, nxt);
        const char* nA = has_next ? p.a_ptr(nxt) : cA; const char* nB = has_next ? p.b_ptr(nxt) : cB;
        _Pragma("nounroll") for (int t = 0; t < nt; t += 2) {
            const bool last = (t == nt - 2);
            const char* a1 = cA + (size_t)(t + 1) * kstepA;
            const char* a2 = last ? nA : cA + (size_t)(t + 2) * kstepA; const char* b2 = last ? nB : cB + (size_t)(t + 2) * kstepB;
            const char* a3 = a2 + kstepA; const char* b3 = b2 + kstepB;
            PG8_LDB(B0, 0, 0); PG8_LDB(B1, 0, 1); PG8_SCHED; PG8_LDA(At, 0, 0); PG8_STAGE(PG8_SA(1, 1), a1 + hstepA, voffA);
            PG8_WAIT_V(8); PG8_WAIT_L(0); PG8_BAR; PG8_MMA(0, 0, At, B0); PG8_MMA(0, 1, At, B1); PG8_BAR; PG8_SCHED;
            PG8_LDA(At, 0, 1); PG8_STAGE(PG8_SB(0, 0), b2, voffB); PG8_STAGE(PG8_SB(0, 1), b2 + hstepB, voffB); PG8_STAGE(PG8_SA(0, 0), a2, voffA);
            PG8_WAIT_V(8); PG8_WAIT_L(0); PG8_BAR; PG8_MMA(1, 0, At, B0); PG8_MMA(1, 1, At, B1); PG8_BAR; PG8_SCHED;
            PG8_LDB(B0, 1, 0); PG8_LDB(B1, 1, 1); PG8_SCHED; PG8_LDA(At, 1, 0); PG8_STAGE(PG8_SA(0, 1), a2 + hstepA, voffA);
            PG8_WAIT_V(8); PG8_WAIT_L(0); PG8_BAR; PG8_MMA(0, 0, At, B0); PG8_MMA(0, 1, At, B1); PG8_BAR; PG8_SCHED;
            PG8_LDA(At, 1, 1); PG8_STAGE(PG8_SB(1, 0), b3, voffB); PG8_STAGE(PG8_SB(1, 1), b3 + hstepB, voffB); PG8_STAGE(PG8_SA(1, 0), a3, voffA);
            PG8_WAIT_V(8); PG8_WAIT_L(0); PG8_BAR; PG8_MMA(1, 0, At, B0); PG8_MMA(1, 1, At, B1); PG8_BAR; PG8_SCHED;
        }
        if (wr == 0) PG8_BAR;
        if constexpr (P::FP8) asm volatile("s_nop 15\n\ts_nop 15" ::: "memory");
        p.epi(acc, cur, wr, wc, fr, fq);
        if (!has_next) break;
        if (!p.keep(cur)) {
#pragma unroll
            for (int a = 0; a < 2; ++a)
#pragma unroll
                for (int b = 0; b < 2; ++b)
#pragma unroll
                    for (int m = 0; m < 4; ++m)
#pragma unroll
                        for (int n = 0; n < 2; ++n) acc[a][b][m][n] = (f32x4){0.f, 0.f, 0.f, 0.f};
        }
        cur = nxt; cA = nA; cB = nB; ++ui;
        if (wr == 1) PG8_BAR;
    }
    PG8_WAIT_V(0);
    PG8_BAR;
#undef PG8_SA
#undef PG8_SB
#undef PG8_STAGE
#undef PG8_LDA
#undef PG8_LDB
#undef PG8_MMA
#undef PG8_WAIT_V
#undef PG8_WAIT_L
#undef PG8_BAR
#undef PG8_SCHED
}
}
using pg8::Unit;

struct TwoPart {
    int lat0, nNa, nMb, nNb, pn0b, G, c, pmb0;
    __device__ __forceinline__ bool map(int L, Unit& u) const {
        const int nA = PAN_CH * nNa, nB = nMb * nNb; int pm, pn;
        if (L < nA) { pg8::tile_map(L, nA, PAN_CH, nNa, pm, pn); u.pm = lat0 + pm; u.pn = pn; return true; }
        if (L < nA + nB) { pg8::tile_map(L - nA, nB, nMb, nNb, pm, pn); u.pm = pmb0 + pm; u.pn = pn0b + pn; return true; }
        return false;
    }
};
__device__ __forceinline__ int skew_deal(int i, int G, int c, int nlo, int cbase, int span) {
    if (i < nlo) return i * G + c;
    return ((unsigned)(c - cbase) < (unsigned)span) ? nlo * G + (i - nlo) * span + (c - cbase) : 0x3fffffff;
}
__device__ __forceinline__ float sigmoid_c(float x) { x = fminf(fmaxf(x, -30.f), 30.f); return __builtin_amdgcn_rcpf(1.f + __builtin_amdgcn_exp2f(-1.4426950408889634f * x)); }

__device__ __forceinline__ unsigned gate_u8(float x) { const unsigned q = (unsigned)(sigmoid_c(x) * 255.f + 0.5f); return q < 1u ? 1u : q; }
__device__ __forceinline__ void epi_z(const f32x4 (&acc)[2][2][4][2], bf16_t* base, int pn, bool gate, float scale, int wr, int wc, int fr, int fq) {
    int row0 = wr * 64 + fr, col0 = pn * 256 + wc * 32 + 8 * fq;
    asm volatile("" : "+v"(row0), "+v"(col0));
#pragma unroll
    for (int ai = 0; ai < 2; ++ai)
#pragma unroll
        for (int m = 0; m < 4; ++m) { bf16_t* rowp = base + (size_t)(row0 + ai * 128 + m * 16) * INW + col0;
#pragma unroll
            for (int bj = 0; bj < 2; ++bj) { f32x4 v0 = acc[ai][bj][m][0], v1 = acc[ai][bj][m][1];
                v0 = v0 * scale; v1 = v1 * scale;
                if (gate) {
                    u32x2 w; w.x = gate_u8(v0[0]) | (gate_u8(v0[1]) << 8) | (gate_u8(v0[2]) << 16) | (gate_u8(v0[3]) << 24);
                    w.y = gate_u8(v1[0]) | (gate_u8(v1[1]) << 8) | (gate_u8(v1[2]) << 16) | (gate_u8(v1[3]) << 24);
                    *(u32x2*)((unsigned char*)(rowp - col0 + G0) + (col0 - G0) + bj * 128) = w;
                } else {
                u32x4 w; w.x = cvt_pk_bf16(v0[0], v0[1]); w.y = cvt_pk_bf16(v0[2], v0[3]); w.z = cvt_pk_bf16(v1[0], v1[1]); w.w = cvt_pk_bf16(v1[2], v1[3]);
                *(u32x4*)(rowp + bj * 128) = w; } } }
}
struct GInProj {
    static constexpr int NT = DM / 64; static constexpr bool PERM = true, FP8 = false;
    const bf16_t* H; const bf16_t* W; bf16_t* Z; bf16_t* ZC; TwoPart tp; int lda, ldb, dry, kstepA, kstepB;
    __device__ __forceinline__ bool next(int i, Unit& u) const { u.seg = 0; return tp.map(i * tp.G + tp.c, u); }
    __device__ __forceinline__ const char* a_ptr(const Unit& u) const { return (const char*)(H + (size_t)u.pm * 256 * DM); }
    __device__ __forceinline__ const char* b_ptr(const Unit& u) const { return (const char*)(W + (size_t)u.pn * 256 * DM); }
    __device__ __forceinline__ bool keep(const Unit&) const { return false; }
    __device__ __forceinline__ void epi(const f32x4 (&acc)[2][2][4][2], const Unit& u, int wr, int wc, int fr, int fq) const {
        if (PROBE_DUP && dry) return;
        bf16_t* base = (u.pm < PAN_LAT) ? Z + (size_t)(u.pm - tp.lat0) * 256 * INW : ZC + (size_t)(u.pm - PAN_LAT) * 256 * INW;
        epi_z(acc, base, NQKV + u.pn, false, 1.f, wr, wc, fr, fq);
    }
};
struct GGate8 {
    static constexpr int NT = DM / 128; static constexpr bool PERM = true, FP8 = true;
    const unsigned char* H8; const unsigned char* W8; bf16_t* Z; bf16_t* ZC; TwoPart tp; int lda, ldb, dry, kstepA, kstepB;
    int nlo, cbase, span;
    __device__ __forceinline__ bool next(int i, Unit& u) const { u.seg = 0; return tp.map(skew_deal(i, tp.G, tp.c, nlo, cbase, span), u); }
    __device__ __forceinline__ const char* a_ptr(const Unit& u) const { return (const char*)(H8 + (size_t)u.pm * 256 * DM); }
    __device__ __forceinline__ const char* b_ptr(const Unit& u) const { return (const char*)(W8 + (size_t)u.pn * 256 * DM); }
    __device__ __forceinline__ bool keep(const Unit&) const { return false; }
    __device__ __forceinline__ void epi(const f32x4 (&acc)[2][2][4][2], const Unit& u, int wr, int wc, int fr, int fq) const {
        bf16_t* base = (u.pm < PAN_LAT) ? Z + (size_t)(u.pm - tp.lat0) * 256 * INW : ZC + (size_t)(u.pm - PAN_LAT) * 256 * INW;
        if (u.pn < NQKV) epi_z(acc, base, u.pn, false, 1.0f / G8_WSCALE, wr, wc, fr, fq);
        else epi_z(acc, base, u.pn + NCV, true, 1.0f / G8_WSCALE, wr, wc, fr, fq);
    }
};

#define UB0(x) ((float)(((x) >> 0) & 0xffu))
#define UB1(x) ((float)(((x) >> 8) & 0xffu))
#define UB2(x) ((float)(((x) >> 16) & 0xffu))
#define UB3(x) ((float)(((x) >> 24) & 0xffu))
struct GBranch {
    static constexpr int NT = 1024 / 64; static constexpr bool PERM = true, FP8 = false;
    const bf16_t* Z; const bf16_t* ZC; const bf16_t* W; bf16_t* Hout; TwoPart tp; int lda, ldb, dry, kstepA, kstepB;
    __device__ __forceinline__ bool next(int i, Unit& u) const { const int t = i / 3; u.seg = i - 3 * t; return tp.map(t * tp.G + tp.c, u); }
    __device__ __forceinline__ const bf16_t* zrow(const Unit& u) const { return (u.pm < PAN_LAT) ? Z + (size_t)(u.pm - tp.lat0) * 256 * INW : ZC + (size_t)(u.pm - PAN_LAT) * 256 * INW; }
    __device__ __forceinline__ const char* a_ptr(const Unit& u) const { return (const char*)(zrow(u) + (u.seg == 0 ? QA0 : (u.seg == 1 ? QB0 : CB0))); }
    __device__ __forceinline__ const char* b_ptr(const Unit& u) const { return (const char*)(W + (size_t)u.pn * 256 * 3072 + u.seg * 1024); }
    __device__ __forceinline__ bool keep(const Unit& u) const { return u.seg < 2; }
    __device__ __forceinline__ void epi(f32x4 (&acc)[2][2][4][2], const Unit& u, int wr, int wc, int fr, int fq) const {
        if (PROBE_DUP && dry) return;
        const unsigned char* zb = (const unsigned char*)(zrow(u) + G0); const int row0 = wr * 64 + fr, col0 = u.pn * 256 + wc * 32 + 8 * fq;
        const int seg = u.seg;
#pragma unroll
        for (int ai = 0; ai < 2; ++ai)
#pragma unroll
            for (int m = 0; m < 4; ++m) { const unsigned char* zr = zb + (size_t)(row0 + ai * 128 + m * 16) * (INW * 2) + col0;
                if (seg < 2) {
#pragma unroll
                    for (int bj = 0; bj < 2; ++bj) { const u32x2 gp = *(const u32x2*)(zr + seg * 2048 + bj * 128), gn = *(const u32x2*)(zr + (seg + 1) * 2048 + bj * 128);
                        f32x4 r0, r1;
                        r0[0] = UB0(gp.x) * __builtin_amdgcn_rcpf(UB0(gn.x)); r0[1] = UB1(gp.x) * __builtin_amdgcn_rcpf(UB1(gn.x));
                        r0[2] = UB2(gp.x) * __builtin_amdgcn_rcpf(UB2(gn.x)); r0[3] = UB3(gp.x) * __builtin_amdgcn_rcpf(UB3(gn.x));
                        r1[0] = UB0(gp.y) * __builtin_amdgcn_rcpf(UB0(gn.y)); r1[1] = UB1(gp.y) * __builtin_amdgcn_rcpf(UB1(gn.y));
                        r1[2] = UB2(gp.y) * __builtin_amdgcn_rcpf(UB2(gn.y)); r1[3] = UB3(gp.y) * __builtin_amdgcn_rcpf(UB3(gn.y));
                        acc[ai][bj][m][0] *= r0; acc[ai][bj][m][1] *= r1; }
                } else {
                    bf16_t* orow = Hout + (size_t)(u.pm * 256 + row0 + ai * 128 + m * 16) * DM + col0;
#pragma unroll
                    for (int bj = 0; bj < 2; ++bj) { const u32x2 g = *(const u32x2*)(zr + 2 * 2048 + bj * 128);
                        const f32x4 v0 = acc[ai][bj][m][0] * ((f32x4){UB0(g.x), UB1(g.x), UB2(g.x), UB3(g.x)} * (1.0f / 255.f)), v1 = acc[ai][bj][m][1] * ((f32x4){UB0(g.y), UB1(g.y), UB2(g.y), UB3(g.y)} * (1.0f / 255.f));
                        u32x4 w; w.x = cvt_pk_bf16(v0[0], v0[1]); w.y = cvt_pk_bf16(v0[2], v0[3]); w.z = cvt_pk_bf16(v1[0], v1[1]); w.w = cvt_pk_bf16(v1[2], v1[3]);
                        *(u32x4*)(orow + bj * 128) = w; }
                }
                asm volatile("" ::: "memory"); }
    }
};

typedef unsigned short half_t;
template <bool LNRES>
__device__ __forceinline__ void epi_residual(const f32x4 (&acc)[2][2][4][2], const void* res, half_t* out, const float* modv, const float* stats, const float* lg, const float* lb, int pn, int wr, int wc, int fr, int fq) {
    int row0 = wr * 64 + fr, col0 = pn * 256 + wc * 32 + 8 * fq;
    asm volatile("" : "+v"(row0), "+v"(col0));
    f32x4 gv[2][2], gl[2][2], bl[2][2];
#pragma unroll
    for (int bj = 0; bj < 2; ++bj)
#pragma unroll
        for (int n = 0; n < 2; ++n) { gv[bj][n] = *(const f32x4*)(modv + col0 + bj * 128 + n * 4);
            if (LNRES) { gl[bj][n] = *(const f32x4*)(lg + col0 + bj * 128 + n * 4) * DN_ALPHA; bl[bj][n] = *(const f32x4*)(lb + col0 + bj * 128 + n * 4) * DN_ALPHA; } }
#pragma unroll
    for (int ai = 0; ai < 2; ++ai)
#pragma unroll
        for (int m = 0; m < 4; ++m) { const int rr = row0 + ai * 128 + m * 16; const size_t off = (size_t)rr * DM + col0;
            f32x2 st = (f32x2){0.f, 1.f}; if (LNRES) st = *(const f32x2*)(stats + 2 * rr);
#pragma unroll
            for (int bj = 0; bj < 2; ++bj) { f32x4 r0, r1, o0, o1;
                if (LNRES) { un_h8(*(const u32x4*)((const half_t*)res + off + bj * 128), r0, r1);
                    o0 = ((r0 - st.x) * st.y) * gl[bj][0] + bl[bj][0] + gv[bj][0] * acc[ai][bj][m][0]; o1 = ((r1 - st.x) * st.y) * gl[bj][1] + bl[bj][1] + gv[bj][1] * acc[ai][bj][m][1]; }
                else { r0 = *(const f32x4*)((const float*)res + off + bj * 128); r1 = *(const f32x4*)((const float*)res + off + bj * 128 + 4);
                    o0 = r0 * DN_ALPHA + gv[bj][0] * acc[ai][bj][m][0]; o1 = r1 * DN_ALPHA + gv[bj][1] * acc[ai][bj][m][1]; }
                u32x4 w; w.x = pk_h2(o0[0], o0[1]); w.y = pk_h2(o0[2], o0[3]); w.z = pk_h2(o1[0], o1[1]); w.w = pk_h2(o1[2], o1[3]);
                *(u32x4*)(out + off + bj * 128) = w; }
            asm volatile("" ::: "memory"); }
}
struct GRes {
    static constexpr bool PERM = true, FP8 = false;
    const bf16_t* A_lat; const bf16_t* A_ctx;
    int a_lat0; const bf16_t* W; const void* res_lat; const void* res_ctx; half_t* out_lat; half_t* out_ctx; const float* mod; int modj; TwoPart tp; int lda, ldb, dry, kstepA, kstepB;
    int apan;
    const float* stats; const float* lg; const float* lb; int lnres;
    __device__ __forceinline__ bool nextu(int i, Unit& u) const { u.seg = 0; return tp.map(i * tp.G + tp.c, u); }
    __device__ __forceinline__ const char* a_ptr(const Unit& u) const { return (const char*)((u.pm < PAN_LAT) ? A_lat + (size_t)(u.pm - a_lat0) * apan : A_ctx + (size_t)(u.pm - PAN_LAT) * apan); }
    __device__ __forceinline__ const char* b_ptr(const Unit& u) const { return (const char*)(W + (size_t)u.pn * 256 * ldb); }
    __device__ __forceinline__ bool keep(const Unit&) const { return false; }
    __device__ __forceinline__ void epi(const f32x4 (&acc)[2][2][4][2], const Unit& u, int wr, int wc, int fr, int fq) const {
        if (PROBE_DUP && dry) return;
        const bool lat = u.pm < PAN_LAT; const size_t prow = (size_t)(lat ? u.pm : u.pm - PAN_LAT) * 256;
        half_t* o = (lat ? out_lat : out_ctx) + prow * DM;
        const float* mv = mod + (size_t)(lat ? (u.pm >> 3) : 16) * MODW + modj * DM; const float* st = stats + (size_t)u.pm * 256 * 2;
        if (lnres) epi_residual<true>(acc, (const half_t*)(lat ? res_lat : res_ctx) + prow * DM, o, mv, st, lg, lb, u.pn, wr, wc, fr, fq);
        else epi_residual<false>(acc, (const float*)(lat ? res_lat : res_ctx) + prow * DM, o, mv, st, lg, lb, u.pn, wr, wc, fr, fq);
    }
};
struct GWo : GRes { static constexpr int NT = DM / 64; __device__ __forceinline__ bool next(int i, Unit& u) const { return nextu(i, u); } };
struct GDown : GRes { static constexpr int NT = HID / 64; __device__ __forceinline__ bool next(int i, Unit& u) const { return nextu(i, u); } };

struct GUp {
    static constexpr int NT = DM / 64; static constexpr bool PERM = true, FP8 = false;
    const bf16_t* H; const bf16_t* W; bf16_t* U; TwoPart tp; int lda, ldb, dry, kstepA, kstepB; int nlo, cbase, span;
    __device__ __forceinline__ bool next(int i, Unit& u) const { u.seg = 0; return tp.map(skew_deal(i, tp.G, tp.c, nlo, cbase, span), u); }
    __device__ __forceinline__ const char* a_ptr(const Unit& u) const { return (const char*)(H + (size_t)u.pm * 256 * DM); }
    __device__ __forceinline__ const char* b_ptr(const Unit& u) const { return (const char*)(W + (size_t)u.pn * 256 * DM); }
    __device__ __forceinline__ bool keep(const Unit&) const { return false; }
    __device__ __forceinline__ void epi(const f32x4 (&acc)[2][2][4][2], const Unit& u, int wr, int wc, int fr, int fq) const {
        if (PROBE_DUP && dry) return;
        bf16_t* base = U + (size_t)((u.pm < PAN_LAT) ? (u.pm - tp.lat0) : (PAN_CH + u.pm - PAN_LAT)) * 256 * HID;
        const int row0 = wr * 64 + fr, col0 = u.pn * 256 + wc * 32 + 8 * fq;
#pragma unroll
        for (int ai = 0; ai < 2; ++ai)
#pragma unroll
            for (int m = 0; m < 4; ++m) { bf16_t* rowp = base + (size_t)(col0 >> 6) * (256 * 64) + (size_t)(row0 + ai * 128 + m * 16) * 64 + (col0 & 63);
#pragma unroll
                for (int bj = 0; bj < 2; ++bj) { f32x4 v0 = acc[ai][bj][m][0], v1 = acc[ai][bj][m][1];
                    v0 = __builtin_elementwise_max(v0, (f32x4){0.f, 0.f, 0.f, 0.f}); v1 = __builtin_elementwise_max(v1, (f32x4){0.f, 0.f, 0.f, 0.f}); v0 = v0 * v0; v1 = v1 * v1;
                    u32x4 w; w.x = cvt_pk_bf16(v0[0], v0[1]); w.y = cvt_pk_bf16(v0[2], v0[3]); w.z = cvt_pk_bf16(v1[0], v1[1]); w.w = cvt_pk_bf16(v1[2], v1[3]);
                    *(u32x4*)(rowp + bj * 2 * (256 * 64)) = w; } }
    }
};

namespace att {
constexpr int NW = 8, QBLK = 32, KVBLK = 64, LDZ = INW;
constexpr float SCALE = ATT_SCALE, THR = 8.f, NEG = -1e30f;
constexpr int SHM_V = 16384, SHM_K = 16384, OFF_WS = 65536, OFF_TAB = OFF_WS + 2048, LDS_ATTN = OFF_TAB + 15 * 512;
static_assert(LDS_ATTN <= SCR_BYTES, "attention LDS");
struct AUnit { const bf16_t* Q; const bf16_t* P0; const bf16_t* P1; int nfirst, NT, vofs; int r0, lo; const float* rpb; int dry; const float* qgain; const float* ropec; int pos0; };
#define KSWZ(row, colB) ((row) * 256 + ((colB) ^ (((row) & 7) << 4)))
#define SBAR() __builtin_amdgcn_sched_barrier(0)
__device__ __forceinline__ int crow(int r, int hi) { return (r & 3) + 8 * (r >> 2) + 4 * hi; }
__device__ __forceinline__ void partialSM(f32x16& p0, f32x16& p1, float& m_reg, float& mn, float& alpha) {
  constexpr float C = SCALE * 1.4426950408889634f;
  float pmax = p0[0];
#pragma unroll
  for (int r = 1; r < 16; ++r) pmax = fmaxf(pmax, p0[r]);
#pragma unroll
  for (int r = 0; r < 16; ++r) pmax = fmaxf(pmax, p1[r]);
  { auto rr = __builtin_amdgcn_permlane32_swap(__float_as_uint(pmax), __float_as_uint(pmax), false, false);
    pmax = fmaxf(__uint_as_float(rr[0]), __uint_as_float(rr[1])); }
  if (__builtin_expect(__all(pmax - m_reg <= THR / SCALE), 1)) { mn = m_reg; alpha = 1.f; }
  else { mn = fmaxf(m_reg, pmax); alpha = __builtin_amdgcn_exp2f((m_reg - mn) * C); m_reg = mn; }
  float mnC = -mn * C;
#pragma unroll
  for (int r = 0; r < 16; ++r) p0[r] = fmaf(p0[r], C, mnC);
#pragma unroll
  for (int r = 0; r < 16; ++r) p1[r] = fmaf(p1[r], C, mnC);
#pragma unroll
  for (int r = 0; r < 16; ++r) p0[r] = __builtin_amdgcn_exp2f(p0[r]);
}
__device__ __forceinline__ void finishSM(f32x16& p0, f32x16& p1, float alpha, float& l_reg, bf16x8& pa0, bf16x8& pa1, bf16x8& pa2, bf16x8& pa3) {
#pragma unroll
  for (int r = 0; r < 16; ++r) p1[r] = __builtin_amdgcn_exp2f(p1[r]);
  float ps = 0;
#pragma unroll
  for (int r = 0; r < 16; ++r) ps += p0[r];
#pragma unroll
  for (int r = 0; r < 16; ++r) ps += p1[r];
  { auto rr = __builtin_amdgcn_permlane32_swap(__float_as_uint(ps), __float_as_uint(ps), false, false);
    ps = __uint_as_float(rr[0]) + __uint_as_float(rr[1]); }
  l_reg = l_reg * alpha + ps;
#define PK4(P, BASE, OUT) do { unsigned a0 = cvt_pk_bf16(P[BASE + 0], P[BASE + 1]), a1 = cvt_pk_bf16(P[BASE + 2], P[BASE + 3]);   \
    unsigned b0 = cvt_pk_bf16(P[BASE + 4], P[BASE + 5]), b1 = cvt_pk_bf16(P[BASE + 6], P[BASE + 7]);                              \
    auto r0 = __builtin_amdgcn_permlane32_swap(a0, b0, false, false); auto r1 = __builtin_amdgcn_permlane32_swap(a1, b1, false, false); \
    u32x4 w = {r0[0], r1[0], r0[1], r1[1]}; OUT = *reinterpret_cast<bf16x8*>(&w); } while (0)
  PK4(p0, 0, pa0); PK4(p0, 8, pa1); PK4(p1, 0, pa2); PK4(p1, 8, pa3);
#undef PK4
}
__device__ __forceinline__ void qkt(f32x16& p0, f32x16& p1, const char* Ks, const bf16x8* qr, int r32, int hi) {
  p0 = f32x16{}; p1 = f32x16{};
  __builtin_amdgcn_s_setprio(1);
#pragma unroll
  for (int d0 = 0; d0 < 8; ++d0) { int cb = (d0 * 16 + hi * 8) * 2;
    bf16x8 b0 = *reinterpret_cast<const bf16x8*>(Ks + KSWZ(r32, cb));
    bf16x8 b1 = *reinterpret_cast<const bf16x8*>(Ks + KSWZ(32 + r32, cb));
    p0 = __builtin_amdgcn_mfma_f32_32x32x16_bf16(b0, qr[d0], p0, 0, 0, 0);
    p1 = __builtin_amdgcn_mfma_f32_32x32x16_bf16(b1, qr[d0], p1, 0, 0, 0); }
  __builtin_amdgcn_s_setprio(0);
}
__device__ __forceinline__ int v_st(int k, int c) { const int kk = (k & ~0xC) | ((k & 4) << 1) | ((k & 8) >> 1); return ((kk >> 3) * 4 + (c >> 5)) * 512 + ((kk & 7) * 32 + (c & 31)) * 2; }
__device__ __forceinline__ int v_rd_base(int lane) { return ((lane & 3) << 3) | (((lane >> 2) & 3) << 6) | (((lane >> 4) & 1) << 5) | (((lane >> 5) & 1) << 8); }
constexpr int v_rd_off(int d0, int ks, int half) { return d0 * 512 + ks * 4096 + half * 2048; }
template <int OFF> __device__ __forceinline__ s16x4 tr_read(int vb) {
  s16x4 r; asm volatile("ds_read_b64_tr_b16 %0, %1 offset:%2" : "=&v"(r) : "v"(vb), "i"(OFF) : "memory"); return r;
}
template <int D0> __device__ __forceinline__ void pv_one(f32x16& od, int vb, bf16x8 pa0, bf16x8 pa1, bf16x8 pa2, bf16x8 pa3) {
  const s16x4 l0 = tr_read<v_rd_off(D0, 0, 0)>(vb), h0 = tr_read<v_rd_off(D0, 0, 1)>(vb), l1 = tr_read<v_rd_off(D0, 1, 0)>(vb), h1 = tr_read<v_rd_off(D0, 1, 1)>(vb);
  const s16x4 l2 = tr_read<v_rd_off(D0, 2, 0)>(vb), h2 = tr_read<v_rd_off(D0, 2, 1)>(vb), l3 = tr_read<v_rd_off(D0, 3, 0)>(vb), h3 = tr_read<v_rd_off(D0, 3, 1)>(vb);
  asm volatile("s_waitcnt lgkmcnt(0)" ::: "memory"); SBAR();
#define PK(L, H) (bf16x8){L[0], L[1], L[2], L[3], H[0], H[1], H[2], H[3]}
  __builtin_amdgcn_s_setprio(1);
  od = __builtin_amdgcn_mfma_f32_32x32x16_bf16(pa0, PK(l0, h0), od, 0, 0, 0);
  od = __builtin_amdgcn_mfma_f32_32x32x16_bf16(pa1, PK(l1, h1), od, 0, 0, 0);
  od = __builtin_amdgcn_mfma_f32_32x32x16_bf16(pa2, PK(l2, h2), od, 0, 0, 0);
  od = __builtin_amdgcn_mfma_f32_32x32x16_bf16(pa3, PK(l3, h3), od, 0, 0, 0);
  __builtin_amdgcn_s_setprio(0);
#undef PK
}
__device__ __forceinline__ void pv_d0(f32x16* o, int vb, bf16x8 pa0, bf16x8 pa1, bf16x8 pa2, bf16x8 pa3) {
  pv_one<0>(o[0], vb, pa0, pa1, pa2, pa3); pv_one<1>(o[1], vb, pa0, pa1, pa2, pa3); pv_one<2>(o[2], vb, pa0, pa1, pa2, pa3); pv_one<3>(o[3], vb, pa0, pa1, pa2, pa3);
}
__device__ __forceinline__ void na_fix(f32x16& p0, f32x16& p1, int j, int lo, int qrow, int rsq, const float* tabl  , int cs4  ) {
  if (j < 4) return;
  const int kr = lo + (j - 4);
  if (kr < rsq || kr >= rsq + 8) {
#pragma unroll
    for (int r = 0; r < 16; ++r) { p0[r] = NEG; p1[r] = NEG; }
    return;
  }
  const float* tb = tabl + (kr - qrow + 7) * 128;
#pragma unroll
  for (int r = 0; r < 16; ++r) { const int kcc = (r & 3) + 8 * (r >> 2);
    const float b0 = tb[kcc], b1 = tb[kcc + 32];
    p0[r] = ((unsigned)(kcc - cs4) < 16u) ? p0[r] + b0 : NEG; p1[r] = ((unsigned)(kcc + 32 - cs4) < 16u) ? p1[r] + b1 : NEG; }
}

__device__ __forceinline__ void q_norm_rope(bf16x8 (&qr)[8], const float* gain, const float* ropec, int pos, int hi) {
  float ss = 0.f;
#pragma unroll
  for (int d0 = 0; d0 < 8; ++d0) { const u32x4 w = __builtin_bit_cast(u32x4, qr[d0]);
    ss += bflo(w.x) * bflo(w.x) + bfhi(w.x) * bfhi(w.x) + bflo(w.y) * bflo(w.y) + bfhi(w.y) * bfhi(w.y) + bflo(w.z) * bflo(w.z) + bfhi(w.z) * bfhi(w.z) + bflo(w.w) * bflo(w.w) + bfhi(w.w) * bfhi(w.w); }
  { auto rr = __builtin_amdgcn_permlane32_swap(__float_as_uint(ss), __float_as_uint(ss), false, false); ss = __uint_as_float(rr[0]) + __uint_as_float(rr[1]); }
  const float rinv = 1.0f / sqrtf(ss * (1.f / 128.f) + LN_EPS);
#pragma unroll
  for (int p = 0; p < 4; ++p) { const int a = (p & 1) + 4 * (p >> 1), b = a + 2, da = a * 16 + hi * 8;
    const f32x4 ga0 = *(const f32x4*)(gain + da), ga1 = *(const f32x4*)(gain + da + 4), gb0 = *(const f32x4*)(gain + da + 32), gb1 = *(const f32x4*)(gain + da + 36);
    f32x4 c0 = {1.f, 1.f, 1.f, 1.f}, c1 = c0, s0 = {0.f, 0.f, 0.f, 0.f}, s1 = s0;
    if (ropec) { const float* tc = ropec + ((a >= 4) ? 32 + (pos & 63) : (pos >> 6)) * 32 + (da & 31); c0 = *(const f32x4*)tc; c1 = *(const f32x4*)(tc + 4); s0 = *(const f32x4*)(tc + 96 * 32); s1 = *(const f32x4*)(tc + 96 * 32 + 4); }
    const u32x4 wa = __builtin_bit_cast(u32x4, qr[a]), wb = __builtin_bit_cast(u32x4, qr[b]);
    f32x4 xa0 = (f32x4){bflo(wa.x), bfhi(wa.x), bflo(wa.y), bfhi(wa.y)} * rinv * ga0, xa1 = (f32x4){bflo(wa.z), bfhi(wa.z), bflo(wa.w), bfhi(wa.w)} * rinv * ga1;
    f32x4 xb0 = (f32x4){bflo(wb.x), bfhi(wb.x), bflo(wb.y), bfhi(wb.y)} * rinv * gb0, xb1 = (f32x4){bflo(wb.z), bfhi(wb.z), bflo(wb.w), bfhi(wb.w)} * rinv * gb1;
    const f32x4 ya0 = xa0 * c0 - xb0 * s0, ya1 = xa1 * c1 - xb1 * s1, yb0 = xb0 * c0 + xa0 * s0, yb1 = xb1 * c1 + xa1 * s1;
    u32x4 oa, ob; oa.x = cvt_pk_bf16(ya0[0], ya0[1]); oa.y = cvt_pk_bf16(ya0[2], ya0[3]); oa.z = cvt_pk_bf16(ya1[0], ya1[1]); oa.w = cvt_pk_bf16(ya1[2], ya1[3]);
    ob.x = cvt_pk_bf16(yb0[0], yb0[1]); ob.y = cvt_pk_bf16(yb0[2], yb0[3]); ob.z = cvt_pk_bf16(yb1[0], yb1[1]); ob.w = cvt_pk_bf16(yb1[2], yb1[3]);
    qr[a] = __builtin_bit_cast(bf16x8, oa); qr[b] = __builtin_bit_cast(bf16x8, ob); }
}
template <bool NA>
__device__ __forceinline__ void attn_unit(const AUnit& U, char* lds, LAS unsigned char* ldl, int tid) {
  asm volatile("" : "+v"(tid));
  const int wid = tid >> 6, lane = tid & 63, r32 = lane & 31, hi = lane >> 5;
  char* V_lds = lds; char* K_lds = lds + 2 * SHM_V;
  float* ws = (float*)(lds + OFF_WS) + wid * 64; float* li_l = ws; float* al_l = ws + 32;
  float* tab = (float*)(lds + OFF_TAB);
  float m_reg = NEG, l_reg = 0; f32x16 o[4] = {}; bf16x8 qr[8];
  const bf16_t* Qw = U.Q + (size_t)(wid * QBLK + r32) * LDZ + hi * 8;
#pragma unroll
  for (int d0 = 0; d0 < 8; ++d0) qr[d0] = *reinterpret_cast<const bf16x8*>(Qw + d0 * 16);
  if constexpr (!NA) { if (U.qgain) q_norm_rope(qr, U.qgain, U.ropec, U.pos0 + wid * QBLK + r32, hi); }
  int qrow = 0, rsq = 0, cs4 = 0; const float* tabl = tab;
  if constexpr (NA) {
    const int wu = __builtin_amdgcn_readfirstlane(wid);
    qrow = U.r0 + (wu >> 1); rsq = min(max(qrow - 4, 0), 24);
    const int qc = (wu & 1) * 32 + r32, cs = min(max(qc - 8, 0), 48);
    cs4 = cs - 4 * hi;
    tabl = tab + (4 * hi - qc + 64);
    for (int e = tid; e < 15 * 128; e += 512) { const int dri = e >> 7, dc = (e & 127) - 64; tab[e] = (dc >= -15 && dc <= 15) ? U.rpb[dri * 31 + dc + 15] * (1.0f / SCALE) : 0.f; }
  }
  const int vb0 = (int)(uintptr_t)V_lds + v_rd_base(lane);
  const int wq = __builtin_amdgcn_readfirstlane(wid);
  int kof[2], vof[2];
#pragma unroll
  for (int i = 0; i < 2; ++i) { const int row = wq * 8 + i * 4 + (lane >> 4); kof[i] = row * LDZ + (((lane & 15) ^ (row & 7)) << 3);
    const int sl = (wq * 2 + i) * 64 + lane, blk = sl >> 5, kk = ((blk >> 2) << 3) | ((sl >> 2) & 7), k = (kk & ~0xC) | ((kk & 4) << 1) | ((kk & 8) >> 1), c = ((blk & 3) << 5) | ((sl & 3) << 3);
    vof[i] = k * LDZ + c + U.vofs; }
  const int nfirst = U.nfirst; const bf16_t* P0 = U.P0; const bf16_t* P1 = U.P1;
  LAS unsigned char* const lV = ldl + wq * 2048; LAS unsigned char* const lK = ldl + 2 * SHM_V + wq * 2048;
#define TILEB(j) ((j) < nfirst ? P0 + (size_t)(j) * 64 * LDZ : P1 + (size_t)((j) - nfirst) * 64 * LDZ)
#define DMA_K(b, j) do { const bf16_t* tp_ = TILEB(j); _Pragma("unroll") for (int i_ = 0; i_ < 2; ++i_) \
    __builtin_amdgcn_global_load_lds((const unsigned*)(tp_ + kof[i_]), (LAS unsigned*)(lK + (b) * SHM_K + i_ * 1024), 16, 0, 0); } while (0)
#define DMA_V(b, j) do { const bf16_t* tp_ = TILEB(j); _Pragma("unroll") for (int i_ = 0; i_ < 2; ++i_) \
    __builtin_amdgcn_global_load_lds((const unsigned*)(tp_ + vof[i_]), (LAS unsigned*)(lV + (b) * SHM_V + i_ * 1024), 16, 0, 0); } while (0)
#define STEP_END() do { asm volatile("s_waitcnt vmcnt(0)" ::: "memory"); __syncthreads(); } while (0)
#define RESC(a) do { if (__any((a) < 1.f)) { if (hi == 0) al_l[r32] = (a); asm volatile("s_waitcnt lgkmcnt(0)" ::: "memory"); \
    _Pragma("unroll") for (int d = 0; d < 4; ++d) _Pragma("unroll") for (int r = 0; r < 16; ++r) o[d][r] *= al_l[crow(r, hi)]; } } while (0)
#define NAFIX(PA, PB, j) do { if constexpr (NA) na_fix(PA, PB, (j), U.lo, qrow, rsq, tabl, cs4); } while (0)
  f32x16 pA0, pA1, pB0, pB1; float mnA, mnB, alA, alB; bf16x8 pa0, pa1, pa2, pa3; const int NT = U.NT;
  DMA_K(0, 0); STEP_END();
  DMA_K(1, 1); DMA_V(0, 0); SBAR();
  qkt(pA0, pA1, K_lds, qr, r32, hi); NAFIX(pA0, pA1, 0); partialSM(pA0, pA1, m_reg, mnA, alA);
  STEP_END();
  for (int j = 1; j + 1 < NT; j += 2) {
    DMA_K(0, j + 1); DMA_V(1, j);
    SBAR(); qkt(pB0, pB1, K_lds + SHM_K, qr, r32, hi);
    finishSM(pA0, pA1, alA, l_reg, pa0, pa1, pa2, pa3); SBAR();
    pv_d0(o, vb0, pa0, pa1, pa2, pa3); NAFIX(pB0, pB1, j); partialSM(pB0, pB1, m_reg, mnB, alB);
    RESC(alB); STEP_END();
    if (j + 2 < NT) DMA_K(1, j + 2);
    DMA_V(0, j + 1);
    SBAR(); qkt(pA0, pA1, K_lds, qr, r32, hi);
    finishSM(pB0, pB1, alB, l_reg, pa0, pa1, pa2, pa3); SBAR();
    pv_d0(o, vb0 + SHM_V, pa0, pa1, pa2, pa3); NAFIX(pA0, pA1, j + 1); partialSM(pA0, pA1, m_reg, mnA, alA);
    RESC(alA); STEP_END();
  }
  DMA_V(1, NT - 1);
  SBAR(); qkt(pB0, pB1, K_lds + SHM_K, qr, r32, hi);
  finishSM(pA0, pA1, alA, l_reg, pa0, pa1, pa2, pa3); SBAR();
  pv_d0(o, vb0, pa0, pa1, pa2, pa3); NAFIX(pB0, pB1, NT - 1); partialSM(pB0, pB1, m_reg, mnB, alB);
  RESC(alB); STEP_END();
  finishSM(pB0, pB1, alB, l_reg, pa0, pa1, pa2, pa3); SBAR();
  pv_d0(o, vb0 + SHM_V, pa0, pa1, pa2, pa3);
  if (hi == 0) li_l[r32] = l_reg; asm volatile("s_waitcnt lgkmcnt(0)" ::: "memory");
  float rli[16];
#pragma unroll
  for (int r = 0; r < 16; ++r) rli[r] = __builtin_amdgcn_rcpf(li_l[crow(r, hi)]);
  __syncthreads();
  bf16_t* ost = (bf16_t*)(lds + wid * 8192);
#pragma unroll
  for (int r = 0; r < 16; ++r) { const int orow = crow(r, hi);
#pragma unroll
    for (int d0 = 0; d0 < 4; ++d0) { const unsigned w = cvt_pk_bf16(o[d0][r] * rli[r], 0.f); ost[orow * 128 + d0 * 32 + r32] = (bf16_t)(w & 0xffffu); } }
  asm volatile("s_waitcnt lgkmcnt(0)" ::: "memory");
  bf16_t* Ow = (bf16_t*)U.Q + (size_t)(wid * QBLK) * LDZ;
  if (!(PROBE_DUP && U.dry)) {
#pragma unroll
  for (int i = 0; i < 8; ++i) { const int id = i * 64 + lane, row = id >> 4, c16 = id & 15;
    *(u32x4*)(Ow + (size_t)row * LDZ + c16 * 8) = *(const u32x4*)(ost + row * 128 + c16 * 8); } }
  __syncthreads();
#undef TILEB
#undef DMA_K
#undef DMA_V
#undef STEP_END
#undef RESC
#undef NAFIX
}
}

struct Args { const float* in[17]; float* out; unsigned char* ws; int ph_lo, ph_hi; };
static_assert(sizeof(Args) == 17 * 8 + 8 + 8 + 8, "Args has no padding");


__device__ __forceinline__ void transpose_item(const float* W, int N, bf16_t* WT, int ldt, LAS float* scr, int kb, int nb, int lane) {
    const int k0 = 64 * kb, n0 = 32 * nb;
#pragma unroll 8
    for (int i = 0; i < 32; ++i) { const int kk = 2 * i + (lane >> 5); scr[kk * 33 + (lane & 31)] = W[(size_t)(k0 + kk) * N + n0 + (lane & 31)]; }
    LDS_WAIT(); asm volatile("" ::: "memory");
    const int c = lane & 7;
#pragma unroll
    for (int j = 0; j < 4; ++j) { const int n = (lane >> 3) + 8 * j; const LAS float* s = scr + (8 * c) * 33 + n;
        u32x4 o; o.x = cvt_pk_bf16(s[0 * 33], s[1 * 33]); o.y = cvt_pk_bf16(s[2 * 33], s[3 * 33]); o.z = cvt_pk_bf16(s[4 * 33], s[5 * 33]); o.w = cvt_pk_bf16(s[6 * 33], s[7 * 33]);
        *(u32x4*)(WT + (size_t)(n0 + n) * ldt + k0 + 8 * c) = o; }
    LDS_WAIT(); asm volatile("" ::: "memory");
}
__device__ __forceinline__ void transpose_item8(const float* W, int N, unsigned char* WT8, int ldt, LAS float* scr, int kb, int nb, int nrow0, int lane) {
    const int k0 = 64 * kb, n0 = 32 * nb;
#pragma unroll 8
    for (int i = 0; i < 32; ++i) { const int kk = 2 * i + (lane >> 5); scr[kk * 33 + (lane & 31)] = W[(size_t)(k0 + kk) * N + n0 + (lane & 31)]; }
    LDS_WAIT(); asm volatile("" ::: "memory");
    const int c = lane & 7;
#pragma unroll
    for (int j = 0; j < 4; ++j) { const int n = (lane >> 3) + 8 * j; const LAS float* s = scr + (8 * c) * 33 + n;
        u32x2 o; o.x = pk_fp8x4(s[0 * 33] * G8_WSCALE, s[1 * 33] * G8_WSCALE, s[2 * 33] * G8_WSCALE, s[3 * 33] * G8_WSCALE); o.y = pk_fp8x4(s[4 * 33] * G8_WSCALE, s[5 * 33] * G8_WSCALE, s[6 * 33] * G8_WSCALE, s[7 * 33] * G8_WSCALE);
        *(u32x2*)(WT8 + (size_t)(n0 - nrow0 + n) * ldt + k0 + 8 * c) = o; }
    LDS_WAIT(); asm volatile("" ::: "memory");
}

__device__ __forceinline__ void row_stats(const f32x4 (&v)[8], float& mean, float& rstd, int lane) {
    float s = 0.f;
#pragma unroll
    for (int j = 0; j < 8; ++j) s += (v[j].x + v[j].y) + (v[j].z + v[j].w);
    mean = wave_sum(s, lane) * (1.f / DM); float s2 = 0.f;
#pragma unroll
    for (int j = 0; j < 8; ++j) { const f32x4 d = v[j] - mean; s2 += (d.x * d.x + d.y * d.y) + (d.z * d.z + d.w * d.w); }
    rstd = 1.0f / sqrtf(wave_sum(s2, lane) * (1.f / DM) + LN_EPS);
}
struct LnArgs { int nrows; const void* src_lat; const void* src_ctx; float* dst_lat; float* dst_ctx; bf16_t* H; unsigned char* H8; float* stats; const float* g; const float* b; const float* modl; int shift_j, scale_j; };
template <int MODE>
__device__ __forceinline__ void ln_load(const LnArgs& a, int m, f32x4 (&v)[8], int lane) {
    if (MODE == 0) {
        const f32x4* sp = (const f32x4*)(m < NLAT ? (const float*)a.src_lat + (size_t)m * DM : (const float*)a.src_ctx + (size_t)(m - NLAT) * DM) + 2 * lane;
#pragma unroll
        for (int j = 0; j < 4; ++j) { v[2 * j] = sp[128 * j]; v[2 * j + 1] = sp[128 * j + 1]; }
    } else {
        const u32x4* sp = (const u32x4*)(m < NLAT ? (const half_t*)a.src_lat + (size_t)m * DM : (const half_t*)a.src_ctx + (size_t)(m - NLAT) * DM) + lane;
#pragma unroll
        for (int j = 0; j < 4; ++j) v[2 * j] = __builtin_bit_cast(f32x4, sp[64 * j]);
    }
}
template <int MODE>
__device__ __forceinline__ void ln_unpack(f32x4 (&v)[8]) {
    if (MODE != 0) {
#pragma unroll
        for (int j = 0; j < 4; ++j) { const u32x4 w = __builtin_bit_cast(u32x4, v[2 * j]); un_h8(w, v[2 * j], v[2 * j + 1]); }
    }
}
struct LnVecs { f32x4 gg[8], bb[8], sc[8], sh[8]; };
template <int MODE>
__device__ __forceinline__ void ln_process(const LnArgs& a, int m, f32x4 (&v)[8], const LnVecs& V, int lane) {
    const bool lat = m < NLAT;
    ln_unpack<MODE>(v);
    float mean, rstd; row_stats(v, mean, rstd, lane);
    if (MODE >= 1) {
        if (MODE == 1 && lane == 0) *(f32x2*)(a.stats + 2 * (size_t)m) = (f32x2){mean, rstd};
        f32x4* dp = (f32x4*)(lat ? a.dst_lat + (size_t)m * DM : a.dst_ctx + (size_t)(m - NLAT) * DM) + 2 * lane;
#pragma unroll
        for (int j = 0; j < 4; ++j)
#pragma unroll
            for (int e = 0; e < 2; ++e) { v[2 * j + e] = (v[2 * j + e] - mean) * rstd * V.gg[2 * j + e] + V.bb[2 * j + e]; if (MODE == 2) dp[128 * j + e] = v[2 * j + e]; }
        if (MODE == 1) row_stats(v, mean, rstd, lane);
    }
    if (MODE <= 1) {
        u32x4* hp = (u32x4*)(a.H + (size_t)m * DM) + lane;
#pragma unroll
        for (int j = 0; j < 4; ++j) { const f32x4 h0 = (v[2 * j] - mean) * rstd * V.sc[2 * j] + V.sh[2 * j], h1 = (v[2 * j + 1] - mean) * rstd * V.sc[2 * j + 1] + V.sh[2 * j + 1];
            u32x4 o; o.x = cvt_pk_bf16(h0.x, h0.y); o.y = cvt_pk_bf16(h0.z, h0.w); o.z = cvt_pk_bf16(h1.x, h1.y); o.w = cvt_pk_bf16(h1.z, h1.w); hp[64 * j] = o;
            if (a.H8) { u32x2 o8; o8.x = pk_fp8x4(h0.x, h0.y, h0.z, h0.w); o8.y = pk_fp8x4(h1.x, h1.y, h1.z, h1.w); ((u32x2*)(a.H8 + (size_t)m * DM))[lane + 64 * j] = o8; } }
    }
}
__device__ __forceinline__ void ln_modvecs(const LnArgs& a, int bi, LnVecs& V, int lane) {
    const float* md = a.modl + (size_t)bi * MODW; const f32x4* scp = (const f32x4*)(md + a.scale_j * DM) + 2 * lane; const f32x4* shp = (const f32x4*)(md + a.shift_j * DM) + 2 * lane;
#pragma unroll
    for (int j = 0; j < 4; ++j)
#pragma unroll
        for (int e = 0; e < 2; ++e) { V.sc[2 * j + e] = scp[128 * j + e] + 1.0f; V.sh[2 * j + e] = shp[128 * j + e]; }
}
template <int MODE>
__device__ __forceinline__ void ln_block(const LnArgs& a, int m0, int R, int bi, int lane) {
    LnVecs V;
    if (MODE >= 1) { const f32x4* gp = (const f32x4*)a.g + 2 * lane; const f32x4* bp = (const f32x4*)a.b + 2 * lane;
#pragma unroll
        for (int j = 0; j < 4; ++j)
#pragma unroll
            for (int e = 0; e < 2; ++e) { V.gg[2 * j + e] = gp[128 * j + e]; V.bb[2 * j + e] = bp[128 * j + e]; } }
    if (MODE <= 1) ln_modvecs(a, bi, V, lane);
    if constexpr (MODE != 2) {
    f32x4 va[8], vb[8];
    ln_load<MODE>(a, m0, va, lane);
    for (int k = 0; k + 2 < R; k += 2) {
        ln_load<MODE>(a, m0 + k + 1, vb, lane);
        asm volatile("" ::: "memory");
        ln_process<MODE>(a, m0 + k, va, V, lane);
        ln_load<MODE>(a, m0 + k + 2, va, lane);
        asm volatile("" ::: "memory");
        ln_process<MODE>(a, m0 + k + 1, vb, V, lane);
    }
    ln_load<MODE>(a, m0 + R - 1, vb, lane);
    asm volatile("" ::: "memory");
    ln_process<MODE>(a, m0 + R - 2, va, V, lane);
    ln_process<MODE>(a, m0 + R - 1, vb, V, lane);
    } else {
    f32x4 va[8], vb[8], vc[8];
    ln_load<MODE>(a, m0, va, lane); ln_load<MODE>(a, m0 + 1, vb, lane);
    int k = 0;
    for (; k + 5 <= R; k += 3) {
        ln_load<MODE>(a, m0 + k + 2, vc, lane);
        asm volatile("" ::: "memory");
        ln_process<MODE>(a, m0 + k, va, V, lane);
        ln_load<MODE>(a, m0 + k + 3, va, lane);
        asm volatile("" ::: "memory");
        ln_process<MODE>(a, m0 + k + 1, vb, V, lane);
        ln_load<MODE>(a, m0 + k + 4, vb, lane);
        asm volatile("" ::: "memory");
        ln_process<MODE>(a, m0 + k + 2, vc, V, lane);
    }
    const int rem = R - k;
    if (rem >= 3) ln_load<MODE>(a, m0 + k + 2, vc, lane);
    asm volatile("" ::: "memory");
    ln_process<MODE>(a, m0 + k, va, V, lane);
    if (rem >= 4) ln_load<MODE>(a, m0 + k + 3, va, lane);
    asm volatile("" ::: "memory");
    ln_process<MODE>(a, m0 + k + 1, vb, V, lane);
    if (rem >= 3) ln_process<MODE>(a, m0 + k + 2, vc, V, lane);
    if (rem >= 4) ln_process<MODE>(a, m0 + k + 3, va, V, lane);
    }
}
template <int MODE>
__device__ __forceinline__ void ln_phase(const LnArgs& a, int gw, int NGW, int lane) {
    const int Rl = NLAT / NGW, Rc = NCTX / NGW;
    if (Rl * NGW == NLAT && (Rl & 1) == 0 && Rl >= 2 && SEQ % Rl == 0 && Rc * NGW == NCTX && (Rc & 1) == 0 && Rc >= 2) {
        ln_block<MODE>(a, gw * Rl, Rl, (gw * Rl) >> 11, lane);
        if (a.nrows > NLAT) ln_block<MODE>(a, NLAT + gw * Rc, Rc, 16, lane);
    } else {
        for (int m = gw; m < a.nrows; m += NGW) { LnVecs V; const int bi = (m < NLAT) ? (m >> 11) : 16;
            if (MODE >= 1) { const f32x4* gp = (const f32x4*)a.g + 2 * lane; const f32x4* bp = (const f32x4*)a.b + 2 * lane;
#pragma unroll
                for (int j = 0; j < 8; ++j) { V.gg[j] = gp[128 * (j >> 1) + (j & 1)]; V.bb[j] = bp[128 * (j >> 1) + (j & 1)]; } }
            if (MODE <= 1) ln_modvecs(a, bi, V, lane);
            f32x4 v[8]; ln_load<MODE>(a, m, v, lane); ln_process<MODE>(a, m, v, V, lane); }
    }
}

struct Raw16 { u32x4 a, b; };
__device__ __forceinline__ Raw16 ldraw(const bf16_t* p) { Raw16 r; r.a = *(const u32x4*)p; r.b = *(const u32x4*)(p + 8); return r; }
__device__ __forceinline__ void dec16(const Raw16& r, float (&v)[16]) {
    v[0] = bflo(r.a.x); v[1] = bfhi(r.a.x); v[2] = bflo(r.a.y); v[3] = bfhi(r.a.y); v[4] = bflo(r.a.z); v[5] = bfhi(r.a.z); v[6] = bflo(r.a.w); v[7] = bfhi(r.a.w);
    v[8] = bflo(r.b.x); v[9] = bfhi(r.b.x); v[10] = bflo(r.b.y); v[11] = bfhi(r.b.y); v[12] = bflo(r.b.z); v[13] = bfhi(r.b.z); v[14] = bflo(r.b.w); v[15] = bfhi(r.b.w);
}
__device__ __forceinline__ void store16(bf16_t* p, const float (&v)[16]) {
    u32x4 a, b; a.x = cvt_pk_bf16(v[0], v[1]); a.y = cvt_pk_bf16(v[2], v[3]); a.z = cvt_pk_bf16(v[4], v[5]); a.w = cvt_pk_bf16(v[6], v[7]);
    b.x = cvt_pk_bf16(v[8], v[9]); b.y = cvt_pk_bf16(v[10], v[11]); b.z = cvt_pk_bf16(v[12], v[13]); b.w = cvt_pk_bf16(v[14], v[15]);
    *(u32x4*)p = a; *(u32x4*)(p + 8) = b;
}
__device__ __forceinline__ void qk_norm_rope(const Raw16& raw, bf16_t* p, const float* gain, const float* ropec, const float* ropes, int pos, int lane, bool dry) {
    float v[16]; dec16(raw, v);
    float ss = 0.f;
#pragma unroll
    for (int j = 0; j < 16; ++j) ss += v[j] * v[j];
    ss += shfl_xor_l(ss, 1, lane); ss += shfl_xor_l(ss, 2, lane); ss += shfl_xor_l(ss, 4, lane);
    const float rinv = 1.0f / sqrtf(ss * (1.f / 128.f) + LN_EPS);
    const int l8 = lane & 7;
#pragma unroll
    for (int j = 0; j < 16; ++j) v[j] = v[j] * rinv * gain[l8 * 16 + j];
    if (pos >= 0) {
        const int ti = ((l8 & 4) ? 32 + (pos & 63) : (pos >> 6)) * 32 + 16 * (l8 & 1);
#pragma unroll
        for (int j = 0; j < 16; ++j) { const float pr = shfl_xor_l(v[j], 2, lane); const float c = ropec[ti + j], sn = ropes[ti + j]; v[j] = v[j] * c + ((l8 & 2) ? pr : -pr) * sn; }
    }
    if (!(PROBE_DUP && dry)) store16(p, v);
}
__device__ __forceinline__ void prep_row(bf16_t* zr, int pos, int seqlen, bool rope, bool do_q, bool do_conv, const float* qg, const float* kg, const float* cw, const float* ropec, const float* ropes, int lane, bool dry = false) {
    const int ch = lane * 16; const bool hp = pos > 0, hn = pos < seqlen - 1;
    Raw16 rq, rk, rb, rc, ru, rcp, rup, rcn, run;
    rq = rk = rb = rc = ru = rcp = rup = rcn = run = Raw16{(u32x4){0u, 0u, 0u, 0u}, (u32x4){0u, 0u, 0u, 0u}};
    if (do_q) rq = ldraw(zr + QB0 + ch);
    if (lane < 16) rk = ldraw(zr + KB0 + ch);
    if (do_conv) { rb = ldraw(zr + CB0 + ch); rc = ldraw(zr + CC0 + ch); ru = ldraw(zr + CX0 + ch);
        if (hp) { rcp = ldraw(zr - INW + CC0 + ch); rup = ldraw(zr - INW + CX0 + ch); }
        if (hn) { rcn = ldraw(zr + INW + CC0 + ch); run = ldraw(zr + INW + CX0 + ch); } }
    asm volatile("" ::: "memory");
    if (do_q) qk_norm_rope(rq, zr + QB0 + ch, qg, ropec, ropes, rope ? pos : -1, lane, dry);
    if (lane < 16) qk_norm_rope(rk, zr + KB0 + ch, kg, ropec, ropes, rope ? pos : -1, lane, dry);
    if (do_conv) {
        float bg[16], c1[16], u1[16], accv[16];
        dec16(rb, bg); dec16(rc, c1); dec16(ru, u1);
#pragma unroll
        for (int j = 0; j < 16; ++j) accv[j] = cw[1024 + ch + j] * (c1[j] * u1[j]);
        dec16(rcp, c1); dec16(rup, u1);
#pragma unroll
        for (int j = 0; j < 16; ++j) accv[j] += cw[ch + j] * (c1[j] * u1[j]);
        dec16(rcn, c1); dec16(run, u1);
#pragma unroll
        for (int j = 0; j < 16; ++j) accv[j] += cw[2048 + ch + j] * (c1[j] * u1[j]);
#pragma unroll
        for (int j = 0; j < 16; ++j) accv[j] *= bg[j];
        if (!(PROBE_DUP && dry)) store16(zr + CB0 + ch, accv);
    }
}

typedef const __attribute__((address_space(4))) Args* KArgs;
#define PHASE_CTX \
    KArgs ap = (KArgs)__builtin_amdgcn_kernarg_segment_ptr(); asm volatile("" : "+s"(ap)); \
    const int lane = lane_id_opaque(); const int wave = wave_s; int tid = wave_s * 64 + lane; asm volatile("" : "+v"(tid)); \
    const int G = gridDim.x, bx = blockIdx.x, vcu = (G % 8 == 0) ? (bx % 8) * (G / 8) + bx / 8 : bx; \
    const int gw = vcu * 8 + wave, NGW = G * 8; \
    unsigned char* ws = ap->ws; (void)lane; (void)gw; (void)NGW;
#define WSP(T, off) ((T*)(ws + (off)))

__global__ void __launch_bounds__(512, 2) mk_fwd(Args args) {
    extern __shared__ __attribute__((aligned(16))) unsigned char lds[];
    LAS unsigned char* const ldsl = (LAS unsigned char*)lds;
    {
        const int t0 = threadIdx.x;
        for (int u = t0; u < (LDS_BYTES - LDSCTL_OFF) / 4; u += 512) ((LAS unsigned*)(ldsl + LDSCTL_OFF))[u] = 0u;
    }
    __syncthreads();
    const int wave_s = __builtin_amdgcn_readfirstlane((int)threadIdx.x >> 6);
    const int lo = args.ph_lo, hi = args.ph_hi;
    XcdBarrier bar; bar.bar = (unsigned*)(args.ws + WS_CTL) + CW_BAR; bar.x = 0; bar.st = (volatile LAS unsigned*)(ldsl + MISC_OFF + 32);
    if (hi - lo > 1) bar = xcd_barrier_post((unsigned*)(args.ws + WS_CTL) + CW_BAR, (volatile LAS unsigned*)(ldsl + MISC_OFF + 32));
    int pid = 0;
#define PHASE_BEGIN if (lo <= pid && pid < hi) { PHASE_CTX
#define PHASE_END   if (pid + 1 < hi) { xcd_barrier(bar, tid == 0); if (PROBE_DUP & 16) xcd_barrier(bar, tid == 0); } } ++pid;

    PHASE_BEGIN
    _Pragma("unroll 1") for (int rep = (PROBE_DUP & 4) ? 0 : 1; rep < 2; ++rep)
    {
        const float* c_in = ap->in[1]; const float* cctx_in = ap->in[3]; const float* w_mod = ap->in[4]; const float* b_mod = ap->in[5];
        float* MOD = WSP(float, WS_MOD); float* ROPEC = WSP(float, WS_ROPE); float* ROPES = ROPEC + 96 * 32;
        if (bx < 192) {
            const int l = bx / 96, n0 = (bx % 96) * 128;
            LAS float* cact = (LAS float*)ldsl;
            for (int i = tid; i < 17 * DM; i += 512) { const int b = i >> 11, k = i & 2047; const float v = (b < 16) ? c_in[b * DM + k] : cctx_in[k]; cact[i] = v / (1.0f + __expf(-v)); }
            __syncthreads();
            const int c4 = tid & 31, kg = tid >> 5;
            f32x4 acc[17];
#pragma unroll
            for (int b = 0; b < 17; ++b) acc[b] = (f32x4){0.f, 0.f, 0.f, 0.f};
            const float* wp = w_mod + ((size_t)l * DM + kg * 128) * MODW + n0 + 4 * c4;
            for (int kk = 0; kk < 128; kk += 4) {
                const f32x4 w0 = *(const f32x4*)(wp + (size_t)(kk + 0) * MODW), w1 = *(const f32x4*)(wp + (size_t)(kk + 1) * MODW), w2 = *(const f32x4*)(wp + (size_t)(kk + 2) * MODW), w3 = *(const f32x4*)(wp + (size_t)(kk + 3) * MODW);
#pragma unroll
                for (int b = 0; b < 17; ++b) { const f32x4 a = *(const LAS f32x4*)(cact + b * DM + kg * 128 + kk); acc[b] += w0 * a.x + w1 * a.y + w2 * a.z + w3 * a.w; }
            }
            __syncthreads();
            LAS float* part = (LAS float*)ldsl;
            const int tid2 = wave_s * 64 + lane_id_opaque(), c4b = tid2 & 31, kgb = tid2 >> 5;
#pragma unroll
            for (int b = 0; b < 17; ++b) *(LAS f32x4*)(part + (kgb * 17 + b) * 128 + 4 * c4b) = acc[b];
            __syncthreads();
            for (int o = tid2; o < 17 * 128; o += 512) { const int b = o >> 7, n = o & 127; float sacc = b_mod[l * MODW + n0 + n];
#pragma unroll
                for (int g = 0; g < 16; ++g) sacc += part[(g * 17 + b) * 128 + n];
                MOD[((size_t)l * 17 + b) * MODW + n0 + n] = sacc; }
            __syncthreads();
        } else if (bx == 192) {
            for (int i = tid; i < 96 * 32; i += 512) { const int pos = i >> 5, fi = i & 31; const float p = (float)(pos < 32 ? pos : pos - 32);
                const float freq = powf(10000.0f, -(float)(2 * fi) / 64.0f); const float ang = p * freq; ROPEC[i] = cosf(ang); ROPES[i] = sinf(ang); }
        }
        const float* w_in = ap->in[6]; const float* w_branch = ap->in[11]; const float* w_o = ap->in[12]; const float* w_up = ap->in[13]; const float* w_down = ap->in[14];
        LAS float* scr = (LAS float*)(ldsl + wave * 16384);
        constexpr int I_IN = (DM / 64) * (INW / 32), I_BR = (1024 / 64) * (DM / 32), I_O = (DM / 64) * (DM / 32), I_UP = (DM / 64) * (HID / 32), I_DN = (HID / 64) * (DM / 32);
        constexpr int I_LAYER = I_IN + 3 * I_BR + I_O + I_UP + I_DN;
        for (int it = gw; it < 2 * I_LAYER; it += NGW) {
            const int l = it / I_LAYER; int r = it - l * I_LAYER; unsigned char* wl = ws + WS_W + (size_t)l * W_LAYER;
            if (r < I_IN) { const int kb_ = r / (INW / 32), nb_ = r % (INW / 32), n0_ = 32 * nb_;
                if (n0_ >= CB0 && n0_ < G0) transpose_item(w_in + (size_t)l * DM * INW + CB0, INW, (bf16_t*)(wl + W_IN), DM, scr, kb_, nb_ - CB0 / 32, lane);
                else if ((kb_ & 1) == 0) {
                    const int row0_ = (n0_ < CB0) ? 0 : (G0 - CB0);
                    transpose_item8(w_in + (size_t)l * DM * INW, INW, wl + W_G8, DM, scr, kb_, nb_, row0_, lane); transpose_item8(w_in + (size_t)l * DM * INW, INW, wl + W_G8, DM, scr, kb_ + 1, nb_, row0_, lane); }
                continue; } r -= I_IN;
            if (r < 3 * I_BR) { const int i = r / I_BR, rr = r % I_BR; transpose_item(w_branch + ((size_t)l * 3 + i) * 1024 * DM, DM, (bf16_t*)(wl + W_BR) + i * 1024, 3072, scr, rr / (DM / 32), rr % (DM / 32), lane); continue; } r -= 3 * I_BR;
            if (r < I_O) { transpose_item(w_o + (size_t)l * DM * DM, DM, (bf16_t*)(wl + W_O), DM, scr, r / (DM / 32), r % (DM / 32), lane); continue; } r -= I_O;
            if (r < I_UP) { transpose_item(w_up + (size_t)l * DM * HID, HID, (bf16_t*)(wl + W_UP), DM, scr, r / (HID / 32), r % (HID / 32), lane); continue; } r -= I_UP;
            transpose_item(w_down + (size_t)l * HID * DM, DM, (bf16_t*)(wl + W_DN), HID, scr, r / (DM / 32), r % (DM / 32), lane);
        }
        if (PROBE_DUP & 4) __syncthreads();
    }
    PHASE_END

    PHASE_BEGIN
    {
        const float* x_in = ap->in[0]; const float* ctx_in = ap->in[2]; const float* MOD = WSP(float, WS_MOD); bf16_t* H = WSP(bf16_t, WS_H);
        const LnArgs la{MALL, x_in, ctx_in, nullptr, nullptr, H, WSP(unsigned char, WS_H8), nullptr, nullptr, nullptr, MOD, 0, 1};
        _Pragma("unroll 1") for (int rep = (PROBE_DUP & 8) ? 0 : 1; rep < 2; ++rep)
        ln_phase<0>(la, gw, NGW, lane);
    }
    PHASE_END

    for (int l = 0; l < DEPTH; ++l) {
        const bool with_ctx = (l == 0);
        for (int k = -1; k < 2; ++k) {
            PHASE_BEGIN
            {
                if (k >= 0) {
                    const int ch = k; const bool ctx_here = (ch == 0);
                GWo P; P.A_lat = WSP(bf16_t, WS_H); P.A_ctx = P.A_lat + (size_t)NLAT * DM; P.a_lat0 = 0; P.W = (const bf16_t*)(ws + WS_W + (size_t)l * W_LAYER + W_O); P.lda = DM; P.ldb = DM; P.kstepA = 128; P.kstepB = 128; P.apan = 256 * DM;
                P.res_lat = (l == 0) ? (const void*)ap->in[0] : (const void*)ap->out; P.res_ctx = ap->in[2]; P.out_lat = (half_t*)ap->out; P.out_ctx = WSP(half_t, WS_CTXS);   P.mod = WSP(float, WS_MOD) + (size_t)l * 17 * MODW; P.modj = 2;
                P.lnres = (l > 0); P.stats = WSP(float, WS_STATS); P.lg = ap->in[15] + (size_t)((l > 0 ? l - 1 : 0) * 2 + 1) * DM; P.lb = ap->in[16] + (size_t)((l > 0 ? l - 1 : 0) * 2 + 1) * DM;
                P.tp = TwoPart{ch * PAN_CH, DM / 256, (with_ctx && ctx_here) ? PAN_CTX : 0, DM / 256, 0, G, bx, PAN_LAT};
                P.dry = 0; pg8::gemm_phase<GWo>(ldsl, P, tid);
                }
                if (k + 1 < 2) {
                    const int ch = k + 1; const bool ctx_here = (ch == 0);
                    const int skn = with_ctx ? (ch == 0 ? 13 : 10) : (1 << 20), skc = with_ctx ? (ch == 0 ? 192 : 128) : 0, sks = with_ctx ? (ch == 0 ? 64 : 128) : 1;
                {
                GInProj P; P.H = WSP(bf16_t, WS_H); P.W = (const bf16_t*)(ws + WS_W + (size_t)l * W_LAYER + W_IN); P.Z = WSP(bf16_t, WS_Z); P.ZC = WSP(bf16_t, WS_ZC); P.lda = DM; P.ldb = DM; P.kstepA = 128; P.kstepB = 128; P.dry = 0;
                P.tp = TwoPart{ch * PAN_CH, NCV, (with_ctx && ctx_here) ? PAN_CTX : 0, NCV, 0, G, bx, PAN_LAT};
                int tid_c = wave_s * 64 + lane_id_opaque(); asm volatile("" : "+v"(tid_c));
                pg8::gemm_phase<GInProj>(ldsl, P, tid_c);
                }
                {
                GGate8 P; P.H8 = WSP(unsigned char, WS_H8); P.W8 = ws + WS_W + (size_t)l * W_LAYER + W_G8; P.Z = WSP(bf16_t, WS_Z); P.ZC = WSP(bf16_t, WS_ZC); P.lda = DM / 2; P.ldb = DM / 2; P.kstepA = 128; P.kstepB = 128; P.dry = 0;
                P.tp = with_ctx ? TwoPart{ch * PAN_CH, N8, ctx_here ? PAN_CTX : 0, N8, 0, G, bx, PAN_LAT}
                                : TwoPart{ch * PAN_CH, N8, PAN_CTX / 2, (CB0 - KA0) / 256, KA0 / 256, G, bx, PAN_LAT + ch * (PAN_CTX / 2)};
                P.nlo = skn; P.cbase = skc; P.span = sks;
                int tid_g = wave_s * 64 + lane_id_opaque(); asm volatile("" : "+v"(tid_g));
                pg8::gemm_phase<GGate8>(ldsl, P, tid_g);
                }
                }
            }
            PHASE_END
            if (k + 1 >= 2) break;
            const int ch = k + 1; const bool ctx_here = (ch == 0);
            PHASE_BEGIN
            {
                const float* qg = ap->in[8] + l * 128; const float* kg = ap->in[9] + l * 128; const float* cw = ap->in[10] + (size_t)l * 3 * 1024;
                const float* ROPEC = WSP(float, WS_ROPE); const float* ROPES = ROPEC + 96 * 32; bf16_t* Z = WSP(bf16_t, WS_Z); bf16_t* ZC = WSP(bf16_t, WS_ZC);
                const int nctx = with_ctx ? (ctx_here ? NCTX : 0) : NCTX / 2, ctx0 = with_ctx ? 0 : ch * (NCTX / 2);
                const int nrows = CHROWS + nctx;
                _Pragma("unroll 1") for (int rep = (PROBE_DUP & 32) ? 0 : 1; rep < 2; ++rep)
                for (int m = gw; m < nrows; m += NGW) {
                    if (m < CHROWS) prep_row(Z + (size_t)m * INW, m & 2047, SEQ, true, false, true, qg, kg, cw, ROPEC, ROPES, lane, rep == 0);
                    else { const int mc = ctx0 + m - CHROWS; prep_row(ZC + (size_t)mc * INW, mc & 255, CTXL, false, with_ctx, with_ctx, qg, kg, cw, ROPEC, ROPES, lane, rep == 0); }
                }
            }
            PHASE_END
            PHASE_BEGIN
            {
                bf16_t* Z = WSP(bf16_t, WS_Z); bf16_t* ZC = WSP(bf16_t, WS_ZC); const float* rpb = ap->in[7];
                const int n_dense = 512 + ((with_ctx && ctx_here) ? 256 : 0);
                _Pragma("unroll 1") for (int rep = (PROBE_DUP & 2) ? 0 : 1; rep < 2; ++rep) {
                for (int id = bx; id < n_dense; id += G) {
                    att::AUnit A; A.r0 = 0; A.lo = 0; A.rpb = nullptr; A.dry = (rep == 0); A.qgain = nullptr; A.ropec = nullptr; A.pos0 = 0;
                    if (id < 512) {
                        const int it = id >> 8, cc = id & 255, pair = (cc & 7) + 8 * it, j = cc >> 3;
                        const int bl = pair >> 1, qh = (pair & 1) * 4 + (j >> 3), qb = j & 7, b = ch * 8 + bl;
                        A.Q = Z + ((size_t)(bl * SEQ + qb * 256) * INW + QB0 + qh * 128);
                        A.P0 = Z + ((size_t)(bl * SEQ) * INW + KB0 + (qh >> 2) * 128); A.P1 = ZC + ((size_t)(b * CTXL) * INW + KB0 + (qh >> 2) * 128);
                        A.nfirst = 32; A.NT = 36; A.vofs = VB0 - KB0; A.qgain = ap->in[8] + l * 128; A.ropec = WSP(float, WS_ROPE); A.pos0 = qb * 256;
                    } else {
                        const int i2 = id - 512, b = i2 >> 4, hh = i2 & 15; const bf16_t* zb = ZC + (size_t)(b * CTXL) * INW;
                        if (hh < 8) { A.Q = zb + QA0 + hh * 128; A.P0 = zb + KA0 + hh * 128; A.vofs = VA0 - KA0; }
                        else { const int qh = hh - 8; A.Q = zb + QB0 + qh * 128; A.P0 = zb + KB0 + (qh >> 2) * 128; A.vofs = VB0 - KB0; }
                        A.P1 = A.P0; A.nfirst = 4; A.NT = 4;
                    }
                    att::attn_unit<false>(A, (char*)lds, ldsl, tid);
                }
                for (int id = bx; id < 512; id += G) {
                    const int it = id >> 8, cc = id & 255, pairn = (cc & 7) * 8 + 4 * it + (cc >> 6), r0 = 4 * ((cc >> 3) & 7);
                    const int bl = pairn >> 3, h = pairn & 7;
                    const int b = ch * 8 + bl; const bool edge = (r0 == 0 || r0 == 28); const int lo_ = (r0 == 0) ? 0 : (r0 == 28 ? 24 : r0 - 4);
                    att::AUnit A; A.Q = Z + ((size_t)(bl * SEQ + r0 * 64) * INW + QA0 + h * 128);
                    A.P0 = ZC + ((size_t)(b * CTXL) * INW + KA0 + h * 128); A.P1 = Z + ((size_t)(bl * SEQ + lo_ * 64) * INW + KA0 + h * 128);
                    A.nfirst = 4; A.NT = 4 + (edge ? 8 : 12); A.vofs = VA0 - KA0; A.r0 = r0; A.lo = lo_; A.rpb = rpb + ((size_t)l * 8 + h) * 15 * 31; A.dry = (rep == 0); A.qgain = nullptr; A.ropec = nullptr; A.pos0 = 0;
                    att::attn_unit<true>(A, (char*)lds, ldsl, tid);
                }
                }
            }
            PHASE_END
            PHASE_BEGIN
            {
                GBranch P; P.Z = WSP(bf16_t, WS_Z); P.ZC = WSP(bf16_t, WS_ZC); P.W = (const bf16_t*)(ws + WS_W + (size_t)l * W_LAYER + W_BR); P.Hout = WSP(bf16_t, WS_H); P.lda = INW; P.ldb = 3072; P.kstepA = 128; P.kstepB = 128;
                P.tp = TwoPart{ch * PAN_CH, DM / 256, (with_ctx && ctx_here) ? PAN_CTX : 0, DM / 256, 0, G, bx, PAN_LAT};
                _Pragma("unroll 1") for (int rep = (((PROBE_DUP & 1) != 0) && ((PROBE_GEMM_MASK & 2) != 0)) ? 0 : 1; rep < 2; ++rep) { P.dry = (rep == 0) && !PROBE_REAL; pg8::gemm_phase<GBranch>(ldsl, P, tid); }
            }
            PHASE_END
        }
        PHASE_BEGIN
        {
            const int nrows = with_ctx ? MALL : NLAT; const float* g = ap->in[15] + (size_t)(l * 2 + 0) * DM; const float* bb = ap->in[16] + (size_t)(l * 2 + 0) * DM;
            float* OUT = ap->out; float* CTXS = WSP(float, WS_CTXS); bf16_t* H = WSP(bf16_t, WS_H); const float* MODL = WSP(float, WS_MOD) + (size_t)l * 17 * MODW;
            const LnArgs la{nrows, (const void*)OUT, (const void*)CTXS, OUT, CTXS, H, nullptr, WSP(float, WS_STATS), g, bb, MODL, 3, 4};
            _Pragma("unroll 1") for (int rep = (PROBE_DUP & 64) ? 0 : 1; rep < 2; ++rep)
            ln_phase<1>(la, gw, NGW, lane);
        }
        PHASE_END
        for (int st = 0; st < 3; ++st) {
            PHASE_BEGIN
            {
                if (st >= 1) {
                    const int ch = st - 1; const bool ctx_here = (ch == 0) && with_ctx;
                GDown P; P.A_lat = WSP(bf16_t, ch == 0 ? WS_U0 : WS_U1); P.A_ctx = P.A_lat + (size_t)CHROWS * HID; P.a_lat0 = ch * PAN_CH; P.W = (const bf16_t*)(ws + WS_W + (size_t)l * W_LAYER + W_DN); P.lda = 64; P.ldb = HID; P.kstepA = 256 * 64 * 2; P.kstepB = 128; P.apan = 256 * HID;
                P.res_lat = ap->out; P.res_ctx = WSP(half_t, WS_CTXS); P.out_lat = (l + 1 < DEPTH) ? (half_t*)ap->out : WSP(half_t, WS_H); P.out_ctx = WSP(half_t, WS_CTXS);   P.mod = WSP(float, WS_MOD) + (size_t)l * 17 * MODW; P.modj = 5;
                P.lnres = 1; P.stats = WSP(float, WS_STATS); P.lg = ap->in[15] + (size_t)(l * 2 + 0) * DM; P.lb = ap->in[16] + (size_t)(l * 2 + 0) * DM;
                P.tp = TwoPart{ch * PAN_CH, DM / 256, ctx_here ? PAN_CTX : 0, DM / 256, 0, G, bx, PAN_LAT};
                P.dry = 0; pg8::gemm_phase<GDown>(ldsl, P, tid);
                }
                if (st < 2) {
                    const int ch = st; const bool ctx_here = (ch == 0) && with_ctx;
                GUp P; P.H = WSP(bf16_t, WS_H); P.W = (const bf16_t*)(ws + WS_W + (size_t)l * W_LAYER + W_UP); P.U = WSP(bf16_t, ch == 0 ? WS_U0 : WS_U1); P.lda = DM; P.ldb = DM; P.kstepA = 128; P.kstepB = 128;
                P.tp = TwoPart{ch * PAN_CH, HID / 256, ctx_here ? PAN_CTX : 0, HID / 256, 0, G, bx, PAN_LAT};
                P.dry = 0; P.nlo = (with_ctx && ch == 1) ? 6 : (1 << 20); P.cbase = 128; P.span = 128;
                int tid_u = wave_s * 64 + lane_id_opaque(); asm volatile("" : "+v"(tid_u));
                pg8::gemm_phase<GUp>(ldsl, P, tid_u);
                }
            }
            PHASE_END
        }
        PHASE_BEGIN
        {
            const int nrows = with_ctx ? MALL : NLAT; const float* g = ap->in[15] + (size_t)(l * 2 + 1) * DM; const float* bb = ap->in[16] + (size_t)(l * 2 + 1) * DM;
            float* OUT = ap->out; float* CTXS = WSP(float, WS_CTXS); bf16_t* H = WSP(bf16_t, WS_H); const float* MODN = WSP(float, WS_MOD) + (size_t)(l + 1) * 17 * MODW;
            const LnArgs la{nrows, (l + 1 < DEPTH) ? (const void*)OUT : (const void*)H, (const void*)CTXS, OUT, CTXS, H, WSP(unsigned char, WS_H8), WSP(float, WS_STATS), g, bb, MODN, 0, 1};
            if (l + 1 < DEPTH) { _Pragma("unroll 1") for (int rep = (PROBE_DUP & 64) ? 0 : 1; rep < 2; ++rep) ln_phase<1>(la, gw, NGW, lane); }
            else ln_phase<2>(la, gw, NGW, lane);
        }
        PHASE_END
    }
#undef PHASE_BEGIN
#undef PHASE_END
}
constexpr int N_PHASES = 2 + DEPTH * (3 + 2 * 3 + 1 + 3 + 1);

extern "C" void kernel_launch(void* const* d_in, const int* in_sizes, int n_in, void* d_out, int out_size, void* d_ws, size_t ws_size, hipStream_t stream) {
    static int grid = 0;
    if (grid == 0) {
        if (n_in != 17 || in_sizes[0] != NLAT * DM || out_size != NLAT * DM || ws_size < WS_END) { fprintf(stderr, "kernel_launch: shape / workspace mismatch (ws %zu, need %zu)\n", ws_size, (size_t)WS_END); grid = -1; return; }
        int dev = 0, cus = 0, per_cu = 0;
        if (hipGetDevice(&dev) != hipSuccess || hipDeviceGetAttribute(&cus, hipDeviceAttributeMultiprocessorCount, dev) != hipSuccess) { grid = -1; return; }
        if (hipFuncSetAttribute((const void*)mk_fwd, hipFuncAttributeMaxDynamicSharedMemorySize, LDS_BYTES) != hipSuccess) { fprintf(stderr, "kernel_launch: hipFuncSetAttribute failed\n"); grid = -1; return; }
        if (hipOccupancyMaxActiveBlocksPerMultiprocessor(&per_cu, (const void*)mk_fwd, 512, LDS_BYTES) != hipSuccess || per_cu < 1) fprintf(stderr, "kernel_launch: occupancy query says %d\n", per_cu);
        (void)hipGetLastError();
        if (cus != 256) { fprintf(stderr, "kernel_launch: the skewed unit deals are laid out for 256 CUs (have %d)\n", cus); grid = -1; return; }
        grid = cus;
    }
    if (grid < 0) return;
    if (hipMemsetAsync((char*)d_ws + WS_CTL, 0, CTL_ZERO_BYTES, stream) != hipSuccess) return;
    Args a{};
    for (int i = 0; i < 17; ++i) a.in[i] = (const float*)d_in[i];
    a.out = (float*)d_out; a.ws = (unsigned char*)d_ws;
#if MK_PER_PHASE
    for (int p = 0; p < N_PHASES; ++p) { a.ph_lo = p; a.ph_hi = p + 1; hipLaunchKernelGGL(mk_fwd, dim3(grid), dim3(512), LDS_BYTES, stream, a); }
#else
    a.ph_lo = 0; a.ph_hi = N_PHASES;
    hipLaunchKernelGGL(mk_fwd, dim3(grid), dim3(512), LDS_BYTES, stream, a);
#endif
    const hipError_t le = hipPeekAtLastError();
    if (le != hipSuccess) fprintf(stderr, "kernel_launch: launch failed: %s\n", hipGetErrorName(le));
}
```

```cpp
#include <hip/hip_runtime.h>
#include <cstdio>
#include <cstdint>
#include <cmath>

#define LAS __attribute__((address_space(3)))
#define GAS __attribute__((address_space(1)))
typedef unsigned short bf16_t;
typedef short bf16x8 __attribute__((ext_vector_type(8)));
typedef short bf16x16_t __attribute__((ext_vector_type(16)));
typedef short s16x4 __attribute__((ext_vector_type(4)));
typedef float f32x4 __attribute__((ext_vector_type(4)));
typedef float f32x2 __attribute__((ext_vector_type(2)));
typedef float f32x16 __attribute__((ext_vector_type(16)));
typedef unsigned u32x4 __attribute__((ext_vector_type(4)));
typedef unsigned u32x2 __attribute__((ext_vector_type(2)));
typedef int i32x8 __attribute__((ext_vector_type(8)));

#ifndef PROBE_DUP
#define PROBE_DUP 0
#endif
#ifndef STAGGER_TICKS
#define STAGGER_TICKS 0
#endif
#ifndef PROBE_REAL
#define PROBE_REAL 0
#endif
#ifndef PROBE_GEMM_MASK
#define PROBE_GEMM_MASK 31
#endif
#ifndef MK_PER_PHASE
#define MK_PER_PHASE 0
#endif

constexpr int DM = 2048, NB = 16, SEQ = 2048, CTXL = 256, HD = 128, HID = 8192, DEPTH = 2;
constexpr int QA0 = 0, QB0 = 1024, KA0 = 2048, VA0 = 3072, KB0 = 4096, VB0 = 4352, CB0 = 4608, CC0 = 5632, CX0 = 6656, G0 = 7680, INW = 13824;
constexpr int NLAT = NB * SEQ, NCTX = NB * CTXL, MALL = NLAT + NCTX;
constexpr int CHROWS = 16384, PAN_CH = 64, PAN_LAT = 128, PAN_CTX = 16;
constexpr float LN_EPS = 1e-6f, DN_ALPHA = 1.4142135623730951f, ATT_SCALE = 0.08838834764831845f;
constexpr int MODW = 6 * DM;

constexpr size_t MiB = 1u << 20;
constexpr size_t WS_CTL = 0, CTL_ZERO_BYTES = 1 * MiB;
constexpr size_t WS_MOD = 1 * MiB;
constexpr size_t WS_ROPE = 3 * MiB;
constexpr size_t WS_STATS = 3 * MiB + 512 * 1024;
constexpr int NQKV = CB0 / 256, NCV = (G0 - CB0) / 256, NGT = (INW - G0) / 256, N8 = NQKV + NGT;
constexpr size_t WS_W = 4 * MiB;
constexpr size_t W_IN = 0, W_G8 = 12 * MiB, W_BR = 34 * MiB, W_O = 46 * MiB, W_UP = 54 * MiB, W_DN = 86 * MiB, W_LAYER = 126 * MiB;
constexpr size_t WS_CTXS = 256 * MiB;
constexpr size_t WS_H = 272 * MiB;
constexpr size_t WS_H8 = 416 * MiB;
constexpr size_t WS_ZC = 488 * MiB;
constexpr size_t WS_Z = 596 * MiB;
constexpr size_t WS_END = 1028 * MiB;
constexpr size_t WS_U0 = WS_END - (size_t)(CHROWS + NCTX) * HID * 2, WS_U1 = WS_H8;
static_assert(WS_U1 + (size_t)CHROWS * HID * 2 <= WS_U0 && WS_U0 >= WS_Z, "U buffers");
static_assert(WS_W + 2 * W_LAYER <= WS_CTXS && WS_CTXS + (size_t)NCTX * DM * 2 <= WS_H && WS_H + (size_t)MALL * DM * 2 <= WS_H8 && WS_H8 + (size_t)MALL * DM <= WS_ZC && WS_ZC + (size_t)NCTX * INW * 2 <= WS_Z && WS_Z + (size_t)CHROWS * INW * 2 <= WS_END, "ws map");
static_assert((size_t)(G0 - CB0) * DM * 2 <= W_G8 && W_G8 + (size_t)N8 * 256 * DM <= W_BR, "weight map");
static_assert((size_t)(CHROWS + NCTX) * HID * 2 <= WS_END - WS_Z, "U overlay");
constexpr int CW_TMO = 0, CW_BAR = 4096;

constexpr int RING_BYTES = 131072;
constexpr int SCR_BYTES = 139264;
constexpr int LDSCTL_OFF = SCR_BYTES, MISC_OFF = LDSCTL_OFF + 64;
constexpr int LDS_BYTES = 147456;

#define RLX_AGENT __ATOMIC_RELAXED, __HIP_MEMORY_SCOPE_AGENT
#define LDS_WAIT() asm volatile("s_waitcnt lgkmcnt(0)" ::: "memory")
#define VM_WAIT() asm volatile("s_waitcnt vmcnt(0)" ::: "memory")
typedef float f32x2_cv __attribute__((ext_vector_type(2))); typedef __bf16 bf16x2_cv __attribute__((ext_vector_type(2)));
__device__ __forceinline__ unsigned cvt_pk_bf16(float lo, float hi) { const f32x2_cv v = {lo, hi}; const bf16x2_cv b = __builtin_convertvector(v, bf16x2_cv); return __builtin_bit_cast(unsigned, b); }
__device__ __forceinline__ float bflo(unsigned w) { return __uint_as_float(w << 16); }
__device__ __forceinline__ float bfhi(unsigned w) { return __uint_as_float(w & 0xffff0000u); }
typedef _Float16 h16x2 __attribute__((ext_vector_type(2)));
__device__ __forceinline__ unsigned pk_h2(float a, float b) { a = __builtin_amdgcn_fmed3f(a, -60000.f, 60000.f); b = __builtin_amdgcn_fmed3f(b, -60000.f, 60000.f); h16x2 h = {(_Float16)a, (_Float16)b}; return __builtin_bit_cast(unsigned, h); }
__device__ __forceinline__ f32x2 un_h2(unsigned w) { const h16x2 h = __builtin_bit_cast(h16x2, w); return (f32x2){(float)h.x, (float)h.y}; }
__device__ __forceinline__ void un_h8(const u32x4 w, f32x4& lo, f32x4& hi) { const f32x2 a = un_h2(w.x), b = un_h2(w.y), c = un_h2(w.z), d = un_h2(w.w); lo = (f32x4){a.x, a.y, b.x, b.y}; hi = (f32x4){c.x, c.y, d.x, d.y}; }
constexpr float G8_WSCALE = 32.0f;
__device__ __forceinline__ unsigned pk_fp8x4(float a, float b, float c, float d) { int v = __builtin_amdgcn_cvt_pk_fp8_f32(a, b, 0, false); v = __builtin_amdgcn_cvt_pk_fp8_f32(c, d, v, true); return (unsigned)v; }
__device__ __forceinline__ int lane_id_opaque() { int l; asm volatile("v_mbcnt_lo_u32_b32 %0, -1, 0\n\tv_mbcnt_hi_u32_b32 %0, -1, %0" : "=v"(l)); return l; }
__device__ __forceinline__ float shfl_xor_l(float v, int mask, int lane) { return __uint_as_float((unsigned)__builtin_amdgcn_ds_bpermute((lane ^ mask) << 2, (int)__float_as_uint(v))); }
__device__ __forceinline__ float wave_sum(float v, int lane) {
#pragma unroll
    for (int o = 1; o < 64; o <<= 1) v += shfl_xor_l(v, o, lane);
    return v;
}

#define XB_TMO      128
#define XB_XCNT(j)  (256  + 64 * (j))
#define XB_XSUB(j)  (1280 + 64 * (j))
#define XB_XGEN(j)  (2304 + 64 * (j))
#define XB_TOP      3328
#define XB_TOPGEN   3392
#define XCD_BAR_WORDS 3456
#define XB_SPIN_CAP (1u << 20)
__device__ __forceinline__ unsigned xb_ld(unsigned* p)              { return __hip_atomic_load(p, __ATOMIC_RELAXED, __HIP_MEMORY_SCOPE_AGENT); }
__device__ __forceinline__ unsigned xb_add(unsigned* p, unsigned v) { return __hip_atomic_fetch_add(p, v, __ATOMIC_RELAXED, __HIP_MEMORY_SCOPE_AGENT); }
__device__ __forceinline__ unsigned xb_xcc_id() { return (unsigned)__builtin_amdgcn_s_getreg((3 << 11) | 20) & 0xFu; }
#define XB_SPIN(cond, bar) do { unsigned _sp = 0; while (cond) { __builtin_amdgcn_s_sleep(1); \
    if ((++_sp & 255u) == 0u) { if (xb_ld(&(bar)[XB_TMO])) break; if (_sp > XB_SPIN_CAP) { atomicAdd(&(bar)[XB_TMO], 1u); break; } } } } while (0)
struct XcdBarrier { unsigned* bar; unsigned x; volatile LAS unsigned* st; };
__device__ __forceinline__ XcdBarrier xcd_barrier_post(unsigned* bar, volatile LAS unsigned* st) {
    XcdBarrier b; b.bar = bar; b.x = xb_xcc_id(); b.st = st;
    if (threadIdx.x == 0) (void)xb_add(&bar[XB_XCNT(b.x)], 1u);
    return b;
}
__device__ __forceinline__ void xcd_barrier_complete(unsigned* bar, unsigned x, unsigned& nloc, unsigned& nx) {
    const unsigned G = gridDim.x * gridDim.y * gridDim.z;
    unsigned sum, cnt, mine, sp = 0u;
    for (;;) {
        sum = 0u; cnt = 0u; mine = 0u;
#pragma unroll
        for (unsigned j = 0; j < 16; ++j) { const unsigned c = xb_ld(&bar[XB_XCNT(j)]); sum += c; cnt += (c > 0u) ? 1u : 0u; mine = (j == x) ? c : mine; }
        if (sum == G) break;
        __builtin_amdgcn_s_sleep(1);
        if ((++sp & 255u) == 0u) { if (xb_ld(&bar[XB_TMO])) break; if (sp > XB_SPIN_CAP) { atomicAdd(&bar[XB_TMO], 1u); break; } }
    }
    nloc = mine > 0u ? mine : 1u; nx = cnt > 0u ? cnt : 1u;
}
__device__ __forceinline__ void xcd_barrier(const XcdBarrier& b, const bool leader) {
    asm volatile("s_waitcnt vmcnt(0)" ::: "memory");
    __syncthreads();
    if (leader) {
        unsigned* bar = b.bar;
        __builtin_amdgcn_s_waitcnt(0);
        unsigned nloc = b.st[0], nx = b.st[1];
        if (nloc == 0u) { xcd_barrier_complete(bar, b.x, nloc, nx); b.st[0] = nloc; b.st[1] = nx; }
        const unsigned old = xb_add(&bar[XB_XSUB(b.x)], 1u);
        const unsigned gen = old / nloc;
        if (old + 1u == (gen + 1u) * nloc) {
            __builtin_amdgcn_fence(__ATOMIC_RELEASE, "agent");
            asm volatile("s_waitcnt vmcnt(0)" ::: "memory");
            const unsigned og = xb_add(&bar[XB_TOP], 1u);
            const unsigned tg = og / nx;
            if (og + 1u == (tg + 1u) * nx) xb_add(&bar[XB_TOPGEN], 1u);
            else XB_SPIN(xb_ld(&bar[XB_TOPGEN]) == tg, bar);
            __builtin_amdgcn_fence(__ATOMIC_ACQUIRE, "agent");
            xb_add(&bar[XB_XGEN(b.x)], 1u);
            asm volatile("s_waitcnt vmcnt(0)" ::: "memory");
        } else {
            XB_SPIN(xb_ld(&bar[XB_XGEN(b.x)]) == gen, bar);
            __builtin_amdgcn_fence(__ATOMIC_ACQUIRE, "agent");
            asm volatile("s_waitcnt vmcnt(0)" ::: "memory");
        }
    }
    __syncthreads();
}

namespace pg8 {
constexpr int BM = 256, BK = 64, HALF = 128, HTB = HALF * BK * 2, STAGE_BYTES = 8 * HTB;
__host__ __device__ __forceinline__ int lds_byte(int r, int c) { const int st = (r >> 4) * 2 + (c >> 5), rr = r & 15, cc = c & 31, ob = rr * 64 + cc * 2; return st * 1024 + (ob ^ (((ob >> 9) & 1) << 5)); }
__host__ __device__ __forceinline__ void stage_rc(int b, int& R, int& C) { const int st = b / 1024, sb = b % 1024, swz = sb ^ (((sb >> 9) & 1) << 5); R = (st >> 1) * 16 + swz / 64; C = (st & 1) * 32 + (swz % 64) / 2; }
__host__ __device__ __forceinline__ int perm32(int rho) { const int n = rho >> 4, i = rho & 15; return 8 * (i >> 2) + 4 * n + (i & 3); }
struct Unit { int pm, pn, seg; };
__device__ __forceinline__ void tile_map(int L, int nwg, int nM, int nN, int& pm, int& pn) {
    const int q = nwg / 8, r = nwg % 8, xcd = L % 8, off = L / 8;
    const int wgid = (xcd < r ? xcd * (q + 1) : r * (q + 1) + (xcd - r) * q) + off;
    const int sh = (nN <= 8) ? 2 : 3, WG = 1 << sh;
    const int nig = WG * nN, gid = wgid / nig, rem = wgid - gid * nig; (void)nM;
    pm = gid * WG + (rem & (WG - 1)); pn = rem >> sh;
}

template <class P>
__device__ __forceinline__ void gemm_phase(LAS unsigned char* lds, const P& p, const int tid) {
    const int wid = __builtin_amdgcn_readfirstlane(tid >> 6), lane = tid & 63, wr = wid >> 2, wc = wid & 3, fr = lane & 15, fq = lane >> 4;
    constexpr int nt = P::NT;
    unsigned voffA[2], voffB[2];
#pragma unroll
    for (int i = 0; i < 2; ++i) { int R, C; stage_rc(tid * 16 + i * 8192, R, C); const int Rb = P::PERM ? ((R & ~31) + perm32(R & 31)) : R;
        voffA[i] = (unsigned)(R * p.lda + C) * 2u; voffB[i] = (unsigned)(Rb * p.ldb + C) * 2u; }
    const size_t kstepA = (size_t)p.kstepA, kstepB = (size_t)p.kstepB;
    const size_t hstepA = (size_t)HALF * p.lda * 2, hstepB = (size_t)HALF * p.ldb * 2;
    const unsigned ldsw = (unsigned)wid * 1024u;
    const int aoff = P::FP8 ? lds_byte(wr * 64 + fr, fq * 16) : lds_byte(wr * 64 + fr, fq * 8), boff = P::FP8 ? lds_byte(wc * 32 + fr, fq * 16) : lds_byte(wc * 32 + fr, fq * 8);
#define PG8_SA(b, h) (((b) * 2 + (h)) * HTB)
#define PG8_SB(b, h) ((4 + (b) * 2 + (h)) * HTB)
#define PG8_STAGE(bufoff, gbase, voff) do { _Pragma("unroll") for (int _i = 0; _i < 2; ++_i) \
        __builtin_amdgcn_global_load_lds((const unsigned*)((const char*)(gbase) + (voff)[_i]), (LAS unsigned*)(lds + (bufoff) + ldsw + _i * 8192), 16, 0, 0); } while (0)
typedef int i32x4_t __attribute__((ext_vector_type(4)));
#define PG8_LD32(p) __builtin_shufflevector(*(const LAS i32x4_t*)(p), *(const LAS i32x4_t*)((p) + 16), 0, 1, 2, 3, 4, 5, 6, 7)
#define PG8_LDA(dst, b, h) do { if constexpr (P::FP8) { _Pragma("unroll") for (int m = 0; m < 4; ++m) dst##8[m] = PG8_LD32(lds + PG8_SA(b, h) + aoff + m * 2048); } \
        else { _Pragma("unroll") for (int m = 0; m < 4; ++m) _Pragma("unroll") for (int k = 0; k < 2; ++k) dst[m][k] = *(const LAS bf16x8*)(lds + PG8_SA(b, h) + aoff + m * 2048 + k * 1024); } } while (0)
#define PG8_LDB(dst, b, h) do { if constexpr (P::FP8) { _Pragma("unroll") for (int n = 0; n < 2; ++n) dst##8[n] = PG8_LD32(lds + PG8_SB(b, h) + boff + n * 2048); } \
        else { _Pragma("unroll") for (int n = 0; n < 2; ++n) _Pragma("unroll") for (int k = 0; k < 2; ++k) dst[n][k] = *(const LAS bf16x8*)(lds + PG8_SB(b, h) + boff + n * 2048 + k * 1024); } } while (0)
#define PG8_MMA(ai, bj, At, Bt) do { __builtin_amdgcn_s_setprio(1); _Pragma("unroll") for (int m = 0; m < 4; ++m) _Pragma("unroll") for (int n = 0; n < 2; ++n) { \
        if constexpr (P::FP8) asm volatile("v_mfma_f32_16x16x128_f8f6f4 %0, %1, %2, %0" : "+v"(acc[ai][bj][m][n]) : "v"(Bt##8[n]), "v"(At##8[m])); \
        else { _Pragma("unroll") for (int k = 0; k < 2; ++k) acc[ai][bj][m][n] = __builtin_amdgcn_mfma_f32_16x16x32_bf16(Bt[n][k], At[m][k], acc[ai][bj][m][n], 0, 0, 0); } } __builtin_amdgcn_s_setprio(0); } while (0)
#define PG8_WAIT_V(n) asm volatile("s_waitcnt vmcnt(" #n ")" ::: "memory")
#define PG8_WAIT_L(n) asm volatile("s_waitcnt lgkmcnt(" #n ")" ::: "memory")
#define PG8_BAR __builtin_amdgcn_s_barrier()
#define PG8_SCHED __builtin_amdgcn_sched_barrier(0)
    Unit cur, nxt; int ui = 0;
    if (!p.next(0, cur)) return;
    if (STAGGER_TICKS > 0) {
        const unsigned long long t0 = __builtin_amdgcn_s_memrealtime(), dl = (unsigned long long)(((unsigned)blockIdx.x >> 3) & 7u) * STAGGER_TICKS;
        while (__builtin_amdgcn_s_memrealtime() - t0 < dl) __builtin_amdgcn_s_sleep(4);
    }
    f32x4 acc[2][2][4][2];
#pragma unroll
    for (int a = 0; a < 2; ++a)
#pragma unroll
        for (int b = 0; b < 2; ++b)
#pragma unroll
            for (int m = 0; m < 4; ++m)
#pragma unroll
                for (int n = 0; n < 2; ++n) acc[a][b][m][n] = (f32x4){0.f, 0.f, 0.f, 0.f};
    bf16x8 At[4][2], B0[2][2], B1[2][2]; i32x8 At8[4], B08[2], B18[2]; (void)At; (void)B0; (void)B1; (void)At8; (void)B08; (void)B18;
    const char* cA = p.a_ptr(cur); const char* cB = p.b_ptr(cur);
    PG8_STAGE(PG8_SB(0, 0), cB, voffB); PG8_STAGE(PG8_SB(0, 1), cB + hstepB, voffB); PG8_STAGE(PG8_SA(0, 0), cA, voffA); PG8_STAGE(PG8_SA(0, 1), cA + hstepA, voffA);
    if (wr == 1) PG8_BAR;
    PG8_WAIT_V(2); PG8_BAR;
    PG8_STAGE(PG8_SB(1, 0), cB + kstepB, voffB); PG8_STAGE(PG8_SA(1, 0), cA + kstepA, voffA); PG8_STAGE(PG8_SB(1, 1), cB + hstepB + kstepB, voffB);
    PG8_WAIT_V(6); PG8_BAR;
    for (;;) {
        const bool has_next = p.next(ui + 1, nxt);
        const char* nA = has_next ? p.a_ptr(nxt) : cA; const char* nB = has_next ? p.b_ptr(nxt) : cB;
        _Pragma("nounroll") for (int t = 0; t < nt; t += 2) {
            const bool last = (t == nt - 2);
            const char* a1 = cA + (size_t)(t + 1) * kstepA;
            const char* a2 = last ? nA : cA + (size_t)(t + 2) * kstepA; const char* b2 = last ? nB : cB + (size_t)(t + 2) * kstepB;
            const char* a3 = a2 + kstepA; const char* b3 = b2 + kstepB;
            PG8_LDB(B0, 0, 0); PG8_LDB(B1, 0, 1); PG8_SCHED; PG8_LDA(At, 0, 0); PG8_STAGE(PG8_SA(1, 1), a1 + hstepA, voffA);
            PG8_WAIT_V(8); PG8_WAIT_L(0); PG8_BAR; PG8_MMA(0, 0, At, B0); PG8_MMA(0, 1, At, B1); PG8_BAR; PG8_SCHED;
            PG8_LDA(At, 0, 1); PG8_STAGE(PG8_SB(0, 0), b2, voffB); PG8_STAGE(PG8_SB(0, 1), b2 + hstepB, voffB); PG8_STAGE(PG8_SA(0, 0), a2, voffA);
            PG8_WAIT_V(8); PG8_WAIT_L(0); PG8_BAR; PG8_MMA(1, 0, At, B0); PG8_MMA(1, 1, At, B1); PG8_BAR; PG8_SCHED;
            PG8_LDB(B0, 1, 0); PG8_LDB(B1, 1, 1); PG8_SCHED; PG8_LDA(At, 1, 0); PG8_STAGE(PG8_SA(0, 1), a2 + hstepA, voffA);
            PG8_WAIT_V(8); PG8_WAIT_L(0); PG8_BAR; PG8_MMA(0, 0, At, B0); PG8_MMA(0, 1, At, B1); PG8_BAR; PG8_SCHED;
            PG8_LDA(At, 1, 1); PG8_STAGE(PG8_SB(1, 0), b3, voffB); PG8_STAGE(PG8_SB(1, 1), b3 + hstepB, voffB); PG8_STAGE(PG8_SA(1, 0), a3, voffA);
            PG8_WAIT_V(8); PG8_WAIT_L(0); PG8_BAR; PG8_MMA(1, 0, At, B0); PG8_MMA(1, 1, At, B1); PG8_BAR; PG8_SCHED;
        }
        if (wr == 0) PG8_BAR;
        if constexpr (P::FP8) asm volatile("s_nop 15\n\ts_nop 15" ::: "memory");
        p.epi(acc, cur, wr, wc, fr, fq);
        if (!has_next) break;
        if (!p.keep(cur)) {
#pragma unroll
            for (int a = 0; a < 2; ++a)
#pragma unroll
                for (int b = 0; b < 2; ++b)
#pragma unroll
                    for (int m = 0; m < 4; ++m)
#pragma unroll
                        for (int n = 0; n < 2; ++n) acc[a][b][m][n] = (f32x4){0.f, 0.f, 0.f, 0.f};
        }
        cur = nxt; cA = nA; cB = nB; ++ui;
        if (wr == 1) PG8_BAR;
    }
    PG8_WAIT_V(0);
    PG8_BAR;
#undef PG8_SA
#undef PG8_SB
#undef PG8_STAGE
#undef PG8_LDA
#undef PG8_LDB
#undef PG8_MMA
#undef PG8_WAIT_V
#undef PG8_WAIT_L
#undef PG8_BAR
#undef PG8_SCHED
}
}
using pg8::Unit;

struct TwoPart {
    int lat0, nNa, nMb, nNb, pn0b, G, c, pmb0;
    __device__ __forceinline__ bool map(int L, Unit& u) const {
        const int nA = PAN_CH * nNa, nB = nMb * nNb; int pm, pn;
        if (L < nA) { pg8::tile_map(L, nA, PAN_CH, nNa, pm, pn); u.pm = lat0 + pm; u.pn = pn; return true; }
        if (L < nA + nB) { pg8::tile_map(L - nA, nB, nMb, nNb, pm, pn); u.pm = pmb0 + pm; u.pn = pn0b + pn; return true; }
        return false;
    }
};
__device__ __forceinline__ int skew_deal(int i, int G, int c, int nlo, int cbase, int span) {
    if (i < nlo) return i * G + c;
    return ((unsigned)(c - cbase) < (unsigned)span) ? nlo * G + (i - nlo) * span + (c - cbase) : 0x3fffffff;
}
__device__ __forceinline__ float sigmoid_c(float x) { x = fminf(fmaxf(x, -30.f), 30.f); return __builtin_amdgcn_rcpf(1.f + __builtin_amdgcn_exp2f(-1.4426950408889634f * x)); }

__device__ __forceinline__ unsigned gate_u8(float x) { const unsigned q = (unsigned)(sigmoid_c(x) * 255.f + 0.5f); return q < 1u ? 1u : q; }
__device__ __forceinline__ void epi_z(const f32x4 (&acc)[2][2][4][2], bf16_t* base, int pn, bool gate, float scale, int wr, int wc, int fr, int fq) {
    int row0 = wr * 64 + fr, col0 = pn * 256 + wc * 32 + 8 * fq;
    asm volatile("" : "+v"(row0), "+v"(col0));
#pragma unroll
    for (int ai = 0; ai < 2; ++ai)
#pragma unroll
        for (int m = 0; m < 4; ++m) { bf16_t* rowp = base + (size_t)(row0 + ai * 128 + m * 16) * INW + col0;
#pragma unroll
            for (int bj = 0; bj < 2; ++bj) { f32x4 v0 = acc[ai][bj][m][0], v1 = acc[ai][bj][m][1];
                v0 = v0 * scale; v1 = v1 * scale;
                if (gate) {
                    u32x2 w; w.x = gate_u8(v0[0]) | (gate_u8(v0[1]) << 8) | (gate_u8(v0[2]) << 16) | (gate_u8(v0[3]) << 24);
                    w.y = gate_u8(v1[0]) | (gate_u8(v1[1]) << 8) | (gate_u8(v1[2]) << 16) | (gate_u8(v1[3]) << 24);
                    *(u32x2*)((unsigned char*)(rowp - col0 + G0) + (col0 - G0) + bj * 128) = w;
                } else {
                u32x4 w; w.x = cvt_pk_bf16(v0[0], v0[1]); w.y = cvt_pk_bf16(v0[2], v0[3]); w.z = cvt_pk_bf16(v1[0], v1[1]); w.w = cvt_pk_bf16(v1[2], v1[3]);
                *(u32x4*)(rowp + bj * 128) = w; } } }
}
struct GInProj {
    static constexpr int NT = DM / 64; static constexpr bool PERM = true, FP8 = false;
    const bf16_t* H; const bf16_t* W; bf16_t* Z; bf16_t* ZC; TwoPart tp; int lda, ldb, dry, kstepA, kstepB;
    __device__ __forceinline__ bool next(int i, Unit& u) const { u.seg = 0; return tp.map(i * tp.G + tp.c, u); }
    __device__ __forceinline__ const char* a_ptr(const Unit& u) const { return (const char*)(H + (size_t)u.pm * 256 * DM); }
    __device__ __forceinline__ const char* b_ptr(const Unit& u) const { return (const char*)(W + (size_t)u.pn * 256 * DM); }
    __device__ __forceinline__ bool keep(const Unit&) const { return false; }
    __device__ __forceinline__ void epi(const f32x4 (&acc)[2][2][4][2], const Unit& u, int wr, int wc, int fr, int fq) const {
        if (PROBE_DUP && dry) return;
        bf16_t* base = (u.pm < PAN_LAT) ? Z + (size_t)(u.pm - tp.lat0) * 256 * INW : ZC + (size_t)(u.pm - PAN_LAT) * 256 * INW;
        epi_z(acc, base, NQKV + u.pn, false, 1.f, wr, wc, fr, fq);
    }
};
struct GGate8 {
    static constexpr int NT = DM / 128; static constexpr bool PERM = true, FP8 = true;
    const unsigned char* H8; const unsigned char* W8; bf16_t* Z; bf16_t* ZC; TwoPart tp; int lda, ldb, dry, kstepA, kstepB;
    int nlo, cbase, span;
    __device__ __forceinline__ bool next(int i, Unit& u) const { u.seg = 0; return tp.map(skew_deal(i, tp.G, tp.c, nlo, cbase, span), u); }
    __device__ __forceinline__ const char* a_ptr(const Unit& u) const { return (const char*)(H8 + (size_t)u.pm * 256 * DM); }
    __device__ __forceinline__ const char* b_ptr(const Unit& u) const { return (const char*)(W8 + (size_t)u.pn * 256 * DM); }
    __device__ __forceinline__ bool keep(const Unit&) const { return false; }
    __device__ __forceinline__ void epi(const f32x4 (&acc)[2][2][4][2], const Unit& u, int wr, int wc, int fr, int fq) const {
        bf16_t* base = (u.pm < PAN_LAT) ? Z + (size_t)(u.pm - tp.lat0) * 256 * INW : ZC + (size_t)(u.pm - PAN_LAT) * 256 * INW;
        if (u.pn < NQKV) epi_z(acc, base, u.pn, false, 1.0f / G8_WSCALE, wr, wc, fr, fq);
        else epi_z(acc, base, u.pn + NCV, true, 1.0f / G8_WSCALE, wr, wc, fr, fq);
    }
};

#define UB0(x) ((float)(((x) >> 0) & 0xffu))
#define UB1(x) ((float)(((x) >> 8) & 0xffu))
#define UB2(x) ((float)(((x) >> 16) & 0xffu))
#define UB3(x) ((float)(((x) >> 24) & 0xffu))
struct GBranch {
    static constexpr int NT = 1024 / 64; static constexpr bool PERM = true, FP8 = false;
    const bf16_t* Z; const bf16_t* ZC; const bf16_t* W; bf16_t* Hout; TwoPart tp; int lda, ldb, dry, kstepA, kstepB;
    __device__ __forceinline__ bool next(int i, Unit& u) const { const int t = i / 3; u.seg = i - 3 * t; return tp.map(t * tp.G + tp.c, u); }
    __device__ __forceinline__ const bf16_t* zrow(const Unit& u) const { return (u.pm < PAN_LAT) ? Z + (size_t)(u.pm - tp.lat0) * 256 * INW : ZC + (size_t)(u.pm - PAN_LAT) * 256 * INW; }
    __device__ __forceinline__ const char* a_ptr(const Unit& u) const { return (const char*)(zrow(u) + (u.seg == 0 ? QA0 : (u.seg == 1 ? QB0 : CB0))); }
    __device__ __forceinline__ const char* b_ptr(const Unit& u) const { return (const char*)(W + (size_t)u.pn * 256 * 3072 + u.seg * 1024); }
    __device__ __forceinline__ bool keep(const Unit& u) const { return u.seg < 2; }
    __device__ __forceinline__ void epi(f32x4 (&acc)[2][2][4][2], const Unit& u, int wr, int wc, int fr, int fq) const {
        if (PROBE_DUP && dry) return;
        const unsigned char* zb = (const unsigned char*)(zrow(u) + G0); const int row0 = wr * 64 + fr, col0 = u.pn * 256 + wc * 32 + 8 * fq;
        const int seg = u.seg;
#pragma unroll
        for (int ai = 0; ai < 2; ++ai)
#pragma unroll
            for (int m = 0; m < 4; ++m) { const unsigned char* zr = zb + (size_t)(row0 + ai * 128 + m * 16) * (INW * 2) + col0;
                if (seg < 2) {
#pragma unroll
                    for (int bj = 0; bj < 2; ++bj) { const u32x2 gp = *(const u32x2*)(zr + seg * 2048 + bj * 128), gn = *(const u32x2*)(zr + (seg + 1) * 2048 + bj * 128);
                        f32x4 r0, r1;
                        r0[0] = UB0(gp.x) * __builtin_amdgcn_rcpf(UB0(gn.x)); r0[1] = UB1(gp.x) * __builtin_amdgcn_rcpf(UB1(gn.x));
                        r0[2] = UB2(gp.x) * __builtin_amdgcn_rcpf(UB2(gn.x)); r0[3] = UB3(gp.x) * __builtin_amdgcn_rcpf(UB3(gn.x));
                        r1[0] = UB0(gp.y) * __builtin_amdgcn_rcpf(UB0(gn.y)); r1[1] = UB1(gp.y) * __builtin_amdgcn_rcpf(UB1(gn.y));
                        r1[2] = UB2(gp.y) * __builtin_amdgcn_rcpf(UB2(gn.y)); r1[3] = UB3(gp.y) * __builtin_amdgcn_rcpf(UB3(gn.y));
                        acc[ai][bj][m][0] *= r0; acc[ai][bj][m][1] *= r1; }
                } else {
                    bf16_t* orow = Hout + (size_t)(u.pm * 256 + row0 + ai * 128 + m * 16) * DM + col0;
#pragma unroll
                    for (int bj = 0; bj < 2; ++bj) { const u32x2 g = *(const u32x2*)(zr + 2 * 2048 + bj * 128);
                        const f32x4 v0 = acc[ai][bj][m][0] * ((f32x4){UB0(g.x), UB1(g.x), UB2(g.x), UB3(g.x)} * (1.0f / 255.f)), v1 = acc[ai][bj][m][1] * ((f32x4){UB0(g.y), UB1(g.y), UB2(g.y), UB3(g.y)} * (1.0f / 255.f));
                        u32x4 w; w.x = cvt_pk_bf16(v0[0], v0[1]); w.y = cvt_pk_bf16(v0[2], v0[3]); w.z = cvt_pk_bf16(v1[0], v1[1]); w.w = cvt_pk_bf16(v1[2], v1[3]);
                        *(u32x4*)(orow + bj * 128) = w; }
                }
                asm volatile("" ::: "memory"); }
    }
};

typedef unsigned short half_t;
template <bool LNRES>
__device__ __forceinline__ void epi_residual(const f32x4 (&acc)[2][2][4][2], const void* res, half_t* out, const float* modv, const float* stats, const float* lg, const float* lb, int pn, int wr, int wc, int fr, int fq) {
    int row0 = wr * 64 + fr, col0 = pn * 256 + wc * 32 + 8 * fq;
    asm volatile("" : "+v"(row0), "+v"(col0));
    f32x4 gv[2][2], gl[2][2], bl[2][2];
#pragma unroll
    for (int bj = 0; bj < 2; ++bj)
#pragma unroll
        for (int n = 0; n < 2; ++n) { gv[bj][n] = *(const f32x4*)(modv + col0 + bj * 128 + n * 4);
            if (LNRES) { gl[bj][n] = *(const f32x4*)(lg + col0 + bj * 128 + n * 4) * DN_ALPHA; bl[bj][n] = *(const f32x4*)(lb + col0 + bj * 128 + n * 4) * DN_ALPHA; } }
#pragma unroll
    for (int ai = 0; ai < 2; ++ai)
#pragma unroll
        for (int m = 0; m < 4; ++m) { const int rr = row0 + ai * 128 + m * 16; const size_t off = (size_t)rr * DM + col0;
            f32x2 st = (f32x2){0.f, 1.f}; if (LNRES) st = *(const f32x2*)(stats + 2 * rr);
#pragma unroll
            for (int bj = 0; bj < 2; ++bj) { f32x4 r0, r1, o0, o1;
                if (LNRES) { un_h8(*(const u32x4*)((const half_t*)res + off + bj * 128), r0, r1);
                    o0 = ((r0 - st.x) * st.y) * gl[bj][0] + bl[bj][0] + gv[bj][0] * acc[ai][bj][m][0]; o1 = ((r1 - st.x) * st.y) * gl[bj][1] + bl[bj][1] + gv[bj][1] * acc[ai][bj][m][1]; }
                else { r0 = *(const f32x4*)((const float*)res + off + bj * 128); r1 = *(const f32x4*)((const float*)res + off + bj * 128 + 4);
                    o0 = r0 * DN_ALPHA + gv[bj][0] * acc[ai][bj][m][0]; o1 = r1 * DN_ALPHA + gv[bj][1] * acc[ai][bj][m][1]; }
                u32x4 w; w.x = pk_h2(o0[0], o0[1]); w.y = pk_h2(o0[2], o0[3]); w.z = pk_h2(o1[0], o1[1]); w.w = pk_h2(o1[2], o1[3]);
                *(u32x4*)(out + off + bj * 128) = w; }
            asm volatile("" ::: "memory"); }
}
struct GRes {
    static constexpr bool PERM = true, FP8 = false;
    const bf16_t* A_lat; const bf16_t* A_ctx;
    int a_lat0; const bf16_t* W; const void* res_lat; const void* res_ctx; half_t* out_lat; half_t* out_ctx; const float* mod; int modj; TwoPart tp; int lda, ldb, dry, kstepA, kstepB;
    int apan;
    const float* stats; const float* lg; const float* lb; int lnres;
    __device__ __forceinline__ bool nextu(int i, Unit& u) const { u.seg = 0; return tp.map(i * tp.G + tp.c, u); }
    __device__ __forceinline__ const char* a_ptr(const Unit& u) const { return (const char*)((u.pm < PAN_LAT) ? A_lat + (size_t)(u.pm - a_lat0) * apan : A_ctx + (size_t)(u.pm - PAN_LAT) * apan); }
    __device__ __forceinline__ const char* b_ptr(const Unit& u) const { return (const char*)(W + (size_t)u.pn * 256 * ldb); }
    __device__ __forceinline__ bool keep(const Unit&) const { return false; }
    __device__ __forceinline__ void epi(const f32x4 (&acc)[2][2][4][2], const Unit& u, int wr, int wc, int fr, int fq) const {
        if (PROBE_DUP && dry) return;
        const bool lat = u.pm < PAN_LAT; const size_t prow = (size_t)(lat ? u.pm : u.pm - PAN_LAT) * 256;
        half_t* o = (lat ? out_lat : out_ctx) + prow * DM;
        const float* mv = mod + (size_t)(lat ? (u.pm >> 3) : 16) * MODW + modj * DM; const float* st = stats + (size_t)u.pm * 256 * 2;
        if (lnres) epi_residual<true>(acc, (const half_t*)(lat ? res_lat : res_ctx) + prow * DM, o, mv, st, lg, lb, u.pn, wr, wc, fr, fq);
        else epi_residual<false>(acc, (const float*)(lat ? res_lat : res_ctx) + prow * DM, o, mv, st, lg, lb, u.pn, wr, wc, fr, fq);
    }
};
struct GWo : GRes { static constexpr int NT = DM / 64; __device__ __forceinline__ bool next(int i, Unit& u) const { return nextu(i, u); } };
struct GDown : GRes { static constexpr int NT = HID / 64; __device__ __forceinline__ bool next(int i, Unit& u) const { return nextu(i, u); } };

struct GUp {
    static constexpr int NT = DM / 64; static constexpr bool PERM = true, FP8 = false;
    const bf16_t* H; const bf16_t* W; bf16_t* U; TwoPart tp; int lda, ldb, dry, kstepA, kstepB; int nlo, cbase, span;
    __device__ __forceinline__ bool next(int i, Unit& u) const { u.seg = 0; return tp.map(skew_deal(i, tp.G, tp.c, nlo, cbase, span), u); }
    __device__ __forceinline__ const char* a_ptr(const Unit& u) const { return (const char*)(H + (size_t)u.pm * 256 * DM); }
    __device__ __forceinline__ const char* b_ptr(const Unit& u) const { return (const char*)(W + (size_t)u.pn * 256 * DM); }
    __device__ __forceinline__ bool keep(const Unit&) const { return false; }
    __device__ __forceinline__ void epi(const f32x4 (&acc)[2][2][4][2], const Unit& u, int wr, int wc, int fr, int fq) const {
        if (PROBE_DUP && dry) return;
        bf16_t* base = U + (size_t)((u.pm < PAN_LAT) ? (u.pm - tp.lat0) : (PAN_CH + u.pm - PAN_LAT)) * 256 * HID;
        const int row0 = wr * 64 + fr, col0 = u.pn * 256 + wc * 32 + 8 * fq;
#pragma unroll
        for (int ai = 0; ai < 2; ++ai)
#pragma unroll
            for (int m = 0; m < 4; ++m) { bf16_t* rowp = base + (size_t)(col0 >> 6) * (256 * 64) + (size_t)(row0 + ai * 128 + m * 16) * 64 + (col0 & 63);
#pragma unroll
                for (int bj = 0; bj < 2; ++bj) { f32x4 v0 = acc[ai][bj][m][0], v1 = acc[ai][bj][m][1];
                    v0 = __builtin_elementwise_max(v0, (f32x4){0.f, 0.f, 0.f, 0.f}); v1 = __builtin_elementwise_max(v1, (f32x4){0.f, 0.f, 0.f, 0.f}); v0 = v0 * v0; v1 = v1 * v1;
                    u32x4 w; w.x = cvt_pk_bf16(v0[0], v0[1]); w.y = cvt_pk_bf16(v0[2], v0[3]); w.z = cvt_pk_bf16(v1[0], v1[1]); w.w = cvt_pk_bf16(v1[2], v1[3]);
                    *(u32x4*)(rowp + bj * 2 * (256 * 64)) = w; } }
    }
};

namespace att {
constexpr int NW = 8, QBLK = 32, KVBLK = 64, LDZ = INW;
constexpr float SCALE = ATT_SCALE, THR = 8.f, NEG = -1e30f;
constexpr int SHM_V = 16384, SHM_K = 16384, OFF_WS = 65536, OFF_TAB = OFF_WS + 2048, LDS_ATTN = OFF_TAB + 15 * 512;
static_assert(LDS_ATTN <= SCR_BYTES, "attention LDS");
struct AUnit { const bf16_t* Q; const bf16_t* P0; const bf16_t* P1; int nfirst, NT, vofs; int r0, lo; const float* rpb; int dry; const float* qgain; const float* ropec; int pos0; };
#define KSWZ(row, colB) ((row) * 256 + ((colB) ^ (((row) & 7) << 4)))
#define SBAR() __builtin_amdgcn_sched_barrier(0)
__device__ __forceinline__ int crow(int r, int hi) { return (r & 3) + 8 * (r >> 2) + 4 * hi; }
__device__ __forceinline__ void partialSM(f32x16& p0, f32x16& p1, float& m_reg, float& mn, float& alpha) {
  constexpr float C = SCALE * 1.4426950408889634f;
  float pmax = p0[0];
#pragma unroll
  for (int r = 1; r < 16; ++r) pmax = fmaxf(pmax, p0[r]);
#pragma unroll
  for (int r = 0; r < 16; ++r) pmax = fmaxf(pmax, p1[r]);
  { auto rr = __builtin_amdgcn_permlane32_swap(__float_as_uint(pmax), __float_as_uint(pmax), false, false);
    pmax = fmaxf(__uint_as_float(rr[0]), __uint_as_float(rr[1])); }
  if (__builtin_expect(__all(pmax - m_reg <= THR / SCALE), 1)) { mn = m_reg; alpha = 1.f; }
  else { mn = fmaxf(m_reg, pmax); alpha = __builtin_amdgcn_exp2f((m_reg - mn) * C); m_reg = mn; }
  float mnC = -mn * C;
#pragma unroll
  for (int r = 0; r < 16; ++r) p0[r] = fmaf(p0[r], C, mnC);
#pragma unroll
  for (int r = 0; r < 16; ++r) p1[r] = fmaf(p1[r], C, mnC);
#pragma unroll
  for (int r = 0; r < 16; ++r) p0[r] = __builtin_amdgcn_exp2f(p0[r]);
}
__device__ __forceinline__ void finishSM(f32x16& p0, f32x16& p1, float alpha, float& l_reg, bf16x8& pa0, bf16x8& pa1, bf16x8& pa2, bf16x8& pa3) {
#pragma unroll
  for (int r = 0; r < 16; ++r) p1[r] = __builtin_amdgcn_exp2f(p1[r]);
  float ps = 0;
#pragma unroll
  for (int r = 0; r < 16; ++r) ps += p0[r];
#pragma unroll
  for (int r = 0; r < 16; ++r) ps += p1[r];
  { auto rr = __builtin_amdgcn_permlane32_swap(__float_as_uint(ps), __float_as_uint(ps), false, false);
    ps = __uint_as_float(rr[0]) + __uint_as_float(rr[1]); }
  l_reg = l_reg * alpha + ps;
#define PK4(P, BASE, OUT) do { unsigned a0 = cvt_pk_bf16(P[BASE + 0], P[BASE + 1]), a1 = cvt_pk_bf16(P[BASE + 2], P[BASE + 3]);   \
    unsigned b0 = cvt_pk_bf16(P[BASE + 4], P[BASE + 5]), b1 = cvt_pk_bf16(P[BASE + 6], P[BASE + 7]);                              \
    auto r0 = __builtin_amdgcn_permlane32_swap(a0, b0, false, false); auto r1 = __builtin_amdgcn_permlane32_swap(a1, b1, false, false); \
    u32x4 w = {r0[0], r1[0], r0[1], r1[1]}; OUT = *reinterpret_cast<bf16x8*>(&w); } while (0)
  PK4(p0, 0, pa0); PK4(p0, 8, pa1); PK4(p1, 0, pa2); PK4(p1, 8, pa3);
#undef PK4
}
__device__ __forceinline__ void qkt(f32x16& p0, f32x16& p1, const char* Ks, const bf16x8* qr, int r32, int hi) {
  p0 = f32x16{}; p1 = f32x16{};
#pragma unroll
  for (int d0 = 0; d0 < 8; ++d0) { int cb = (d0 * 16 + hi * 8) * 2;
    bf16x8 b0 = *reinterpret_cast<const bf16x8*>(Ks + KSWZ(r32, cb));
    bf16x8 b1 = *reinterpret_cast<const bf16x8*>(Ks + KSWZ(32 + r32, cb));
    p0 = __builtin_amdgcn_mfma_f32_32x32x16_bf16(b0, qr[d0], p0, 0, 0, 0);
    p1 = __builtin_amdgcn_mfma_f32_32x32x16_bf16(b1, qr[d0], p1, 0, 0, 0); }
}
__device__ __forceinline__ int v_st(int k, int c) { const int kk = (k & ~0xC) | ((k & 4) << 1) | ((k & 8) >> 1); return ((kk >> 3) * 4 + (c >> 5)) * 512 + ((kk & 7) * 32 + (c & 31)) * 2; }
__device__ __forceinline__ int v_rd_base(int lane) { return ((lane & 3) << 3) | (((lane >> 2) & 3) << 6) | (((lane >> 4) & 1) << 5) | (((lane >> 5) & 1) << 8); }
constexpr int v_rd_off(int d0, int ks, int half) { return d0 * 512 + ks * 4096 + half * 2048; }
template <int OFF> __device__ __forceinline__ s16x4 tr_read(int vb) {
  s16x4 r; asm volatile("ds_read_b64_tr_b16 %0, %1 offset:%2" : "=&v"(r) : "v"(vb), "i"(OFF) : "memory"); return r;
}
template <int D0> __device__ __forceinline__ void pv_one(f32x16& od, int vb, bf16x8 pa0, bf16x8 pa1, bf16x8 pa2, bf16x8 pa3) {
  const s16x4 l0 = tr_read<v_rd_off(D0, 0, 0)>(vb), h0 = tr_read<v_rd_off(D0, 0, 1)>(vb), l1 = tr_read<v_rd_off(D0, 1, 0)>(vb), h1 = tr_read<v_rd_off(D0, 1, 1)>(vb);
  const s16x4 l2 = tr_read<v_rd_off(D0, 2, 0)>(vb), h2 = tr_read<v_rd_off(D0, 2, 1)>(vb), l3 = tr_read<v_rd_off(D0, 3, 0)>(vb), h3 = tr_read<v_rd_off(D0, 3, 1)>(vb);
  asm volatile("s_waitcnt lgkmcnt(0)" ::: "memory"); SBAR();
#define PK(L, H) (bf16x8){L[0], L[1], L[2], L[3], H[0], H[1], H[2], H[3]}
  od = __builtin_amdgcn_mfma_f32_32x32x16_bf16(pa0, PK(l0, h0), od, 0, 0, 0);
  od = __builtin_amdgcn_mfma_f32_32x32x16_bf16(pa1, PK(l1, h1), od, 0, 0, 0);
  od = __builtin_amdgcn_mfma_f32_32x32x16_bf16(pa2, PK(l2, h2), od, 0, 0, 0);
  od = __builtin_amdgcn_mfma_f32_32x32x16_bf16(pa3, PK(l3, h3), od, 0, 0, 0);
#undef PK
}
__device__ __forceinline__ void pv_d0(f32x16* o, int vb, bf16x8 pa0, bf16x8 pa1, bf16x8 pa2, bf16x8 pa3) {
  pv_one<0>(o[0], vb, pa0, pa1, pa2, pa3); pv_one<1>(o[1], vb, pa0, pa1, pa2, pa3); pv_one<2>(o[2], vb, pa0, pa1, pa2, pa3); pv_one<3>(o[3], vb, pa0, pa1, pa2, pa3);
}
__device__ __forceinline__ void na_fix(f32x16& p0, f32x16& p1, int j, int lo, int qrow, int rsq, const float* tabl  , int cs4  ) {
  if (j < 4) return;
  const int kr = lo + (j - 4);
  if (kr < rsq || kr >= rsq + 8) {
#pragma unroll
    for (int r = 0; r < 16; ++r) { p0[r] = NEG; p1[r] = NEG; }
    return;
  }
  const float* tb = tabl + (kr - qrow + 7) * 128;
#pragma unroll
  for (int r = 0; r < 16; ++r) { const int kcc = (r & 3) + 8 * (r >> 2);
    const float b0 = tb[kcc], b1 = tb[kcc + 32];
    p0[r] = ((unsigned)(kcc - cs4) < 16u) ? p0[r] + b0 : NEG; p1[r] = ((unsigned)(kcc + 32 - cs4) < 16u) ? p1[r] + b1 : NEG; }
}

__device__ __forceinline__ void q_norm_rope(bf16x8 (&qr)[8], const float* gain, const float* ropec, int pos, int hi) {
  float ss = 0.f;
#pragma unroll
  for (int d0 = 0; d0 < 8; ++d0) { const u32x4 w = __builtin_bit_cast(u32x4, qr[d0]);
    ss += bflo(w.x) * bflo(w.x) + bfhi(w.x) * bfhi(w.x) + bflo(w.y) * bflo(w.y) + bfhi(w.y) * bfhi(w.y) + bflo(w.z) * bflo(w.z) + bfhi(w.z) * bfhi(w.z) + bflo(w.w) * bflo(w.w) + bfhi(w.w) * bfhi(w.w); }
  { auto rr = __builtin_amdgcn_permlane32_swap(__float_as_uint(ss), __float_as_uint(ss), false, false); ss = __uint_as_float(rr[0]) + __uint_as_float(rr[1]); }
  const float rinv = 1.0f / sqrtf(ss * (1.f / 128.f) + LN_EPS);
#pragma unroll
  for (int p = 0; p < 4; ++p) { const int a = (p & 1) + 4 * (p >> 1), b = a + 2, da = a * 16 + hi * 8;
    const f32x4 ga0 = *(const f32x4*)(gain + da), ga1 = *(const f32x4*)(gain + da + 4), gb0 = *(const f32x4*)(gain + da + 32), gb1 = *(const f32x4*)(gain + da + 36);
    f32x4 c0 = {1.f, 1.f, 1.f, 1.f}, c1 = c0, s0 = {0.f, 0.f, 0.f, 0.f}, s1 = s0;
    if (ropec) { const float* tc = ropec + ((a >= 4) ? 32 + (pos & 63) : (pos >> 6)) * 32 + (da & 31); c0 = *(const f32x4*)tc; c1 = *(const f32x4*)(tc + 4); s0 = *(const f32x4*)(tc + 96 * 32); s1 = *(const f32x4*)(tc + 96 * 32 + 4); }
    const u32x4 wa = __builtin_bit_cast(u32x4, qr[a]), wb = __builtin_bit_cast(u32x4, qr[b]);
    f32x4 xa0 = (f32x4){bflo(wa.x), bfhi(wa.x), bflo(wa.y), bfhi(wa.y)} * rinv * ga0, xa1 = (f32x4){bflo(wa.z), bfhi(wa.z), bflo(wa.w), bfhi(wa.w)} * rinv * ga1;
    f32x4 xb0 = (f32x4){bflo(wb.x), bfhi(wb.x), bflo(wb.y), bfhi(wb.y)} * rinv * gb0, xb1 = (f32x4){bflo(wb.z), bfhi(wb.z), bflo(wb.w), bfhi(wb.w)} * rinv * gb1;
    const f32x4 ya0 = xa0 * c0 - xb0 * s0, ya1 = xa1 * c1 - xb1 * s1, yb0 = xb0 * c0 + xa0 * s0, yb1 = xb1 * c1 + xa1 * s1;
    u32x4 oa, ob; oa.x = cvt_pk_bf16(ya0[0], ya0[1]); oa.y = cvt_pk_bf16(ya0[2], ya0[3]); oa.z = cvt_pk_bf16(ya1[0], ya1[1]); oa.w = cvt_pk_bf16(ya1[2], ya1[3]);
    ob.x = cvt_pk_bf16(yb0[0], yb0[1]); ob.y = cvt_pk_bf16(yb0[2], yb0[3]); ob.z = cvt_pk_bf16(yb1[0], yb1[1]); ob.w = cvt_pk_bf16(yb1[2], yb1[3]);
    qr[a] = __builtin_bit_cast(bf16x8, oa); qr[b] = __builtin_bit_cast(bf16x8, ob); }
}
template <bool NA>
__device__ __forceinline__ void attn_unit(const AUnit& U, char* lds, LAS unsigned char* ldl, int tid) {
  asm volatile("" : "+v"(tid));
  const int wid = tid >> 6, lane = tid & 63, r32 = lane & 31, hi = lane >> 5;
  char* V_lds = lds; char* K_lds = lds + 2 * SHM_V;
  float* ws = (float*)(lds + OFF_WS) + wid * 64; float* li_l = ws; float* al_l = ws + 32;
  float* tab = (float*)(lds + OFF_TAB);
  float m_reg = NEG, l_reg = 0; f32x16 o[4] = {}; bf16x8 qr[8];
  const bf16_t* Qw = U.Q + (size_t)(wid * QBLK + r32) * LDZ + hi * 8;
#pragma unroll
  for (int d0 = 0; d0 < 8; ++d0) qr[d0] = *reinterpret_cast<const bf16x8*>(Qw + d0 * 16);
  if constexpr (!NA) { if (U.qgain) q_norm_rope(qr, U.qgain, U.ropec, U.pos0 + wid * QBLK + r32, hi); }
  int qrow = 0, rsq = 0, cs4 = 0; const float* tabl = tab;
  if constexpr (NA) {
    const int wu = __builtin_amdgcn_readfirstlane(wid);
    qrow = U.r0 + (wu >> 1); rsq = min(max(qrow - 4, 0), 24);
    const int qc = (wu & 1) * 32 + r32, cs = min(max(qc - 8, 0), 48);
    cs4 = cs - 4 * hi;
    tabl = tab + (4 * hi - qc + 64);
    for (int e = tid; e < 15 * 128; e += 512) { const int dri = e >> 7, dc = (e & 127) - 64; tab[e] = (dc >= -15 && dc <= 15) ? U.rpb[dri * 31 + dc + 15] * (1.0f / SCALE) : 0.f; }
  }
  const int vb0 = (int)(uintptr_t)V_lds + v_rd_base(lane);
  const int wq = __builtin_amdgcn_readfirstlane(wid);
  int kof[2], vof[2];
#pragma unroll
  for (int i = 0; i < 2; ++i) { const int row = wq * 8 + i * 4 + (lane >> 4); kof[i] = row * LDZ + (((lane & 15) ^ (row & 7)) << 3);
    const int sl = (wq * 2 + i) * 64 + lane, blk = sl >> 5, kk = ((blk >> 2) << 3) | ((sl >> 2) & 7), k = (kk & ~0xC) | ((kk & 4) << 1) | ((kk & 8) >> 1), c = ((blk & 3) << 5) | ((sl & 3) << 3);
    vof[i] = k * LDZ + c + U.vofs; }
  const int nfirst = U.nfirst; const bf16_t* P0 = U.P0; const bf16_t* P1 = U.P1;
  LAS unsigned char* const lV = ldl + wq * 2048; LAS unsigned char* const lK = ldl + 2 * SHM_V + wq * 2048;
#define TILEB(j) ((j) < nfirst ? P0 + (size_t)(j) * 64 * LDZ : P1 + (size_t)((j) - nfirst) * 64 * LDZ)
#define DMA_K(b, j) do { const bf16_t* tp_ = TILEB(j); _Pragma("unroll") for (int i_ = 0; i_ < 2; ++i_) \
    __builtin_amdgcn_global_load_lds((const unsigned*)(tp_ + kof[i_]), (LAS unsigned*)(lK + (b) * SHM_K + i_ * 1024), 16, 0, 0); } while (0)
#define DMA_V(b, j) do { const bf16_t* tp_ = TILEB(j); _Pragma("unroll") for (int i_ = 0; i_ < 2; ++i_) \
    __builtin_amdgcn_global_load_lds((const unsigned*)(tp_ + vof[i_]), (LAS unsigned*)(lV + (b) * SHM_V + i_ * 1024), 16, 0, 0); } while (0)
#define STEP_END() do { asm volatile("s_waitcnt vmcnt(0)" ::: "memory"); __syncthreads(); } while (0)
#define RESC(a) do { if (__any((a) < 1.f)) { if (hi == 0) al_l[r32] = (a); asm volatile("s_waitcnt lgkmcnt(0)" ::: "memory"); \
    _Pragma("unroll") for (int d = 0; d < 4; ++d) _Pragma("unroll") for (int r = 0; r < 16; ++r) o[d][r] *= al_l[crow(r, hi)]; } } while (0)
#define NAFIX(PA, PB, j) do { if constexpr (NA) na_fix(PA, PB, (j), U.lo, qrow, rsq, tabl, cs4); } while (0)
  f32x16 pA0, pA1, pB0, pB1; float mnA, mnB, alA, alB; bf16x8 pa0, pa1, pa2, pa3; const int NT = U.NT;
  DMA_K(0, 0); STEP_END();
  DMA_K(1, 1); DMA_V(0, 0); SBAR();
  qkt(pA0, pA1, K_lds, qr, r32, hi); NAFIX(pA0, pA1, 0); partialSM(pA0, pA1, m_reg, mnA, alA);
  STEP_END();
  for (int j = 1; j + 1 < NT; j += 2) {
    DMA_K(0, j + 1); DMA_V(1, j);
    SBAR(); qkt(pB0, pB1, K_lds + SHM_K, qr, r32, hi);
    finishSM(pA0, pA1, alA, l_reg, pa0, pa1, pa2, pa3); SBAR();
    pv_d0(o, vb0, pa0, pa1, pa2, pa3); NAFIX(pB0, pB1, j); partialSM(pB0, pB1, m_reg, mnB, alB);
    RESC(alB); STEP_END();
    if (j + 2 < NT) DMA_K(1, j + 2);
    DMA_V(0, j + 1);
    SBAR(); qkt(pA0, pA1, K_lds, qr, r32, hi);
    finishSM(pB0, pB1, alB, l_reg, pa0, pa1, pa2, pa3); SBAR();
    pv_d0(o, vb0 + SHM_V, pa0, pa1, pa2, pa3); NAFIX(pA0, pA1, j + 1); partialSM(pA0, pA1, m_reg, mnA, alA);
    RESC(alA); STEP_END();
  }
  DMA_V(1, NT - 1);
  SBAR(); qkt(pB0, pB1, K_lds + SHM_K, qr, r32, hi);
  finishSM(pA0, pA1, alA, l_reg, pa0, pa1, pa2, pa3); SBAR();
  pv_d0(o, vb0, pa0, pa1, pa2, pa3); NAFIX(pB0, pB1, NT - 1); partialSM(pB0, pB1, m_reg, mnB, alB);
  RESC(alB); STEP_END();
  finishSM(pB0, pB1, alB, l_reg, pa0, pa1, pa2, pa3); SBAR();
  pv_d0(o, vb0 + SHM_V, pa0, pa1, pa2, pa3);
  if (hi == 0) li_l[r32] = l_reg; asm volatile("s_waitcnt lgkmcnt(0)" ::: "memory");
  float rli[16];
#pragma unroll
  for (int r = 0; r < 16; ++r) rli[r] = __builtin_amdgcn_rcpf(li_l[crow(r, hi)]);
  __syncthreads();
  bf16_t* ost = (bf16_t*)(lds + wid * 8192);
#pragma unroll
  for (int r = 0; r < 16; ++r) { const int orow = crow(r, hi);
#pragma unroll
    for (int d0 = 0; d0 < 4; ++d0) { const unsigned w = cvt_pk_bf16(o[d0][r] * rli[r], 0.f); ost[orow * 128 + d0 * 32 + r32] = (bf16_t)(w & 0xffffu); } }
  asm volatile("s_waitcnt lgkmcnt(0)" ::: "memory");
  bf16_t* Ow = (bf16_t*)U.Q + (size_t)(wid * QBLK) * LDZ;
  if (!(PROBE_DUP && U.dry)) {
#pragma unroll
  for (int i = 0; i < 8; ++i) { const int id = i * 64 + lane, row = id >> 4, c16 = id & 15;
    *(u32x4*)(Ow + (size_t)row * LDZ + c16 * 8) = *(const u32x4*)(ost + row * 128 + c16 * 8); } }
  __syncthreads();
#undef TILEB
#undef DMA_K
#undef DMA_V
#undef STEP_END
#undef RESC
#undef NAFIX
}
}

struct Args { const float* in[17]; float* out; unsigned char* ws; int ph_lo, ph_hi; };
static_assert(sizeof(Args) == 17 * 8 + 8 + 8 + 8, "Args has no padding");


__device__ __forceinline__ void transpose_item(const float* W, int N, bf16_t* WT, int ldt, LAS float* scr, int kb, int nb, int lane) {
    const int k0 = 64 * kb, n0 = 32 * nb;
#pragma unroll 8
    for (int i = 0; i < 32; ++i) { const int kk = 2 * i + (lane >> 5); scr[kk * 33 + (lane & 31)] = W[(size_t)(k0 + kk) * N + n0 + (lane & 31)]; }
    LDS_WAIT(); asm volatile("" ::: "memory");
    const int c = lane & 7;
#pragma unroll
    for (int j = 0; j < 4; ++j) { const int n = (lane >> 3) + 8 * j; const LAS float* s = scr + (8 * c) * 33 + n;
        u32x4 o; o.x = cvt_pk_bf16(s[0 * 33], s[1 * 33]); o.y = cvt_pk_bf16(s[2 * 33], s[3 * 33]); o.z = cvt_pk_bf16(s[4 * 33], s[5 * 33]); o.w = cvt_pk_bf16(s[6 * 33], s[7 * 33]);
        *(u32x4*)(WT + (size_t)(n0 + n) * ldt + k0 + 8 * c) = o; }
    LDS_WAIT(); asm volatile("" ::: "memory");
}
__device__ __forceinline__ void transpose_item8(const float* W, int N, unsigned char* WT8, int ldt, LAS float* scr, int kb, int nb, int nrow0, int lane) {
    const int k0 = 64 * kb, n0 = 32 * nb;
#pragma unroll 8
    for (int i = 0; i < 32; ++i) { const int kk = 2 * i + (lane >> 5); scr[kk * 33 + (lane & 31)] = W[(size_t)(k0 + kk) * N + n0 + (lane & 31)]; }
    LDS_WAIT(); asm volatile("" ::: "memory");
    const int c = lane & 7;
#pragma unroll
    for (int j = 0; j < 4; ++j) { const int n = (lane >> 3) + 8 * j; const LAS float* s = scr + (8 * c) * 33 + n;
        u32x2 o; o.x = pk_fp8x4(s[0 * 33] * G8_WSCALE, s[1 * 33] * G8_WSCALE, s[2 * 33] * G8_WSCALE, s[3 * 33] * G8_WSCALE); o.y = pk_fp8x4(s[4 * 33] * G8_WSCALE, s[5 * 33] * G8_WSCALE, s[6 * 33] * G8_WSCALE, s[7 * 33] * G8_WSCALE);
        *(u32x2*)(WT8 + (size_t)(n0 - nrow0 + n) * ldt + k0 + 8 * c) = o; }
    LDS_WAIT(); asm volatile("" ::: "memory");
}

__device__ __forceinline__ void row_stats(const f32x4 (&v)[8], float& mean, float& rstd, int lane) {
    float s = 0.f;
#pragma unroll
    for (int j = 0; j < 8; ++j) s += (v[j].x + v[j].y) + (v[j].z + v[j].w);
    mean = wave_sum(s, lane) * (1.f / DM); float s2 = 0.f;
#pragma unroll
    for (int j = 0; j < 8; ++j) { const f32x4 d = v[j] - mean; s2 += (d.x * d.x + d.y * d.y) + (d.z * d.z + d.w * d.w); }
    rstd = 1.0f / sqrtf(wave_sum(s2, lane) * (1.f / DM) + LN_EPS);
}
struct LnArgs { int nrows; const void* src_lat; const void* src_ctx; float* dst_lat; float* dst_ctx; bf16_t* H; unsigned char* H8; float* stats; const float* g; const float* b; const float* modl; int shift_j, scale_j; };
template <int MODE>
__device__ __forceinline__ void ln_load(const LnArgs& a, int m, f32x4 (&v)[8], int lane) {
    if (MODE == 0) {
        const f32x4* sp = (const f32x4*)(m < NLAT ? (const float*)a.src_lat + (size_t)m * DM : (const float*)a.src_ctx + (size_t)(m - NLAT) * DM) + 2 * lane;
#pragma unroll
        for (int j = 0; j < 4; ++j) { v[2 * j] = sp[128 * j]; v[2 * j + 1] = sp[128 * j + 1]; }
    } else {
        const u32x4* sp = (const u32x4*)(m < NLAT ? (const half_t*)a.src_lat + (size_t)m * DM : (const half_t*)a.src_ctx + (size_t)(m - NLAT) * DM) + lane;
#pragma unroll
        for (int j = 0; j < 4; ++j) v[2 * j] = __builtin_bit_cast(f32x4, sp[64 * j]);
    }
}
template <int MODE>
__device__ __forceinline__ void ln_unpack(f32x4 (&v)[8]) {
    if (MODE != 0) {
#pragma unroll
        for (int j = 0; j < 4; ++j) { const u32x4 w = __builtin_bit_cast(u32x4, v[2 * j]); un_h8(w, v[2 * j], v[2 * j + 1]); }
    }
}
struct LnVecs { f32x4 gg[8], bb[8], sc[8], sh[8]; };
template <int MODE>
__device__ __forceinline__ void ln_process(const LnArgs& a, int m, f32x4 (&v)[8], const LnVecs& V, int lane) {
    const bool lat = m < NLAT;
    ln_unpack<MODE>(v);
    float mean, rstd; row_stats(v, mean, rstd, lane);
    if (MODE >= 1) {
        if (MODE == 1 && lane == 0) *(f32x2*)(a.stats + 2 * (size_t)m) = (f32x2){mean, rstd};
        f32x4* dp = (f32x4*)(lat ? a.dst_lat + (size_t)m * DM : a.dst_ctx + (size_t)(m - NLAT) * DM) + 2 * lane;
#pragma unroll
        for (int j = 0; j < 4; ++j)
#pragma unroll
            for (int e = 0; e < 2; ++e) { v[2 * j + e] = (v[2 * j + e] - mean) * rstd * V.gg[2 * j + e] + V.bb[2 * j + e]; if (MODE == 2) dp[128 * j + e] = v[2 * j + e]; }
        if (MODE == 1) row_stats(v, mean, rstd, lane);
    }
    if (MODE <= 1) {
        u32x4* hp = (u32x4*)(a.H + (size_t)m * DM) + lane;
#pragma unroll
        for (int j = 0; j < 4; ++j) { const f32x4 h0 = (v[2 * j] - mean) * rstd * V.sc[2 * j] + V.sh[2 * j], h1 = (v[2 * j + 1] - mean) * rstd * V.sc[2 * j + 1] + V.sh[2 * j + 1];
            u32x4 o; o.x = cvt_pk_bf16(h0.x, h0.y); o.y = cvt_pk_bf16(h0.z, h0.w); o.z = cvt_pk_bf16(h1.x, h1.y); o.w = cvt_pk_bf16(h1.z, h1.w); hp[64 * j] = o;
            if (a.H8) { u32x2 o8; o8.x = pk_fp8x4(h0.x, h0.y, h0.z, h0.w); o8.y = pk_fp8x4(h1.x, h1.y, h1.z, h1.w); ((u32x2*)(a.H8 + (size_t)m * DM))[lane + 64 * j] = o8; } }
    }
}
__device__ __forceinline__ void ln_modvecs(const LnArgs& a, int bi, LnVecs& V, int lane) {
    const float* md = a.modl + (size_t)bi * MODW; const f32x4* scp = (const f32x4*)(md + a.scale_j * DM) + 2 * lane; const f32x4* shp = (const f32x4*)(md + a.shift_j * DM) + 2 * lane;
#pragma unroll
    for (int j = 0; j < 4; ++j)
#pragma unroll
        for (int e = 0; e < 2; ++e) { V.sc[2 * j + e] = scp[128 * j + e] + 1.0f; V.sh[2 * j + e] = shp[128 * j + e]; }
}
template <int MODE, int R>
__device__ __forceinline__ void ln_block(const LnArgs& a, int m0, int bi, int lane) {
    LnVecs V;
    if (MODE >= 1) { const f32x4* gp = (const f32x4*)a.g + 2 * lane; const f32x4* bp = (const f32x4*)a.b + 2 * lane;
#pragma unroll
        for (int j = 0; j < 4; ++j)
#pragma unroll
            for (int e = 0; e < 2; ++e) { V.gg[2 * j + e] = gp[128 * j + e]; V.bb[2 * j + e] = bp[128 * j + e]; } }
    if (MODE <= 1) ln_modvecs(a, bi, V, lane);
    if constexpr (MODE == 0) {
    f32x4 va[8], vb[8];
    ln_load<MODE>(a, m0, va, lane);
    for (int k = 0; k + 2 < R; k += 2) {
        ln_load<MODE>(a, m0 + k + 1, vb, lane);
        asm volatile("" ::: "memory");
        ln_process<MODE>(a, m0 + k, va, V, lane);
        ln_load<MODE>(a, m0 + k + 2, va, lane);
        asm volatile("" ::: "memory");
        ln_process<MODE>(a, m0 + k + 1, vb, V, lane);
    }
    ln_load<MODE>(a, m0 + R - 1, vb, lane);
    asm volatile("" ::: "memory");
    ln_process<MODE>(a, m0 + R - 2, va, V, lane);
    ln_process<MODE>(a, m0 + R - 1, vb, V, lane);
    } else {
    f32x4 va[8], vb[8], vc[8];
    ln_load<MODE>(a, m0, va, lane); ln_load<MODE>(a, m0 + 1, vb, lane);
    int k = 0;
    for (; k + 5 <= R; k += 3) {
        ln_load<MODE>(a, m0 + k + 2, vc, lane);
        asm volatile("" ::: "memory");
        ln_process<MODE>(a, m0 + k, va, V, lane);
        ln_load<MODE>(a, m0 + k + 3, va, lane);
        asm volatile("" ::: "memory");
        ln_process<MODE>(a, m0 + k + 1, vb, V, lane);
        ln_load<MODE>(a, m0 + k + 4, vb, lane);
        asm volatile("" ::: "memory");
        ln_process<MODE>(a, m0 + k + 2, vc, V, lane);
    }
    constexpr int rem = (R < 5) ? R : R - 3 * ((R - 2) / 3);
    if (rem >= 3) ln_load<MODE>(a, m0 + k + 2, vc, lane);
    asm volatile("" ::: "memory");
    ln_process<MODE>(a, m0 + k, va, V, lane);
    if (rem >= 4) ln_load<MODE>(a, m0 + k + 3, va, lane);
    asm volatile("" ::: "memory");
    ln_process<MODE>(a, m0 + k + 1, vb, V, lane);
    if (rem >= 3) ln_process<MODE>(a, m0 + k + 2, vc, V, lane);
    if (rem >= 4) ln_process<MODE>(a, m0 + k + 3, va, V, lane);
    }
}
template <int MODE>
__device__ __forceinline__ void ln_phase(const LnArgs& a, int gw, int NGW, int lane) {
    constexpr int Rl = NLAT / 2048, Rc = NCTX / 2048;
    static_assert(Rl * 2048 == NLAT && (Rl & 1) == 0 && SEQ % Rl == 0 && Rc * 2048 == NCTX && (Rc & 1) == 0 && Rc >= 2, "LN row deal");
    (void)NGW;
    ln_block<MODE, Rl>(a, gw * Rl, (gw * Rl) >> 11, lane);
    if (a.nrows > NLAT) ln_block<MODE, Rc>(a, NLAT + gw * Rc, 16, lane);
}

struct Raw16 { u32x4 a, b; };
__device__ __forceinline__ Raw16 ldraw(const bf16_t* p) { Raw16 r; r.a = *(const u32x4*)p; r.b = *(const u32x4*)(p + 8); return r; }
__device__ __forceinline__ void dec16(const Raw16& r, float (&v)[16]) {
    v[0] = bflo(r.a.x); v[1] = bfhi(r.a.x); v[2] = bflo(r.a.y); v[3] = bfhi(r.a.y); v[4] = bflo(r.a.z); v[5] = bfhi(r.a.z); v[6] = bflo(r.a.w); v[7] = bfhi(r.a.w);
    v[8] = bflo(r.b.x); v[9] = bfhi(r.b.x); v[10] = bflo(r.b.y); v[11] = bfhi(r.b.y); v[12] = bflo(r.b.z); v[13] = bfhi(r.b.z); v[14] = bflo(r.b.w); v[15] = bfhi(r.b.w);
}
__device__ __forceinline__ void store16(bf16_t* p, const float (&v)[16]) {
    u32x4 a, b; a.x = cvt_pk_bf16(v[0], v[1]); a.y = cvt_pk_bf16(v[2], v[3]); a.z = cvt_pk_bf16(v[4], v[5]); a.w = cvt_pk_bf16(v[6], v[7]);
    b.x = cvt_pk_bf16(v[8], v[9]); b.y = cvt_pk_bf16(v[10], v[11]); b.z = cvt_pk_bf16(v[12], v[13]); b.w = cvt_pk_bf16(v[14], v[15]);
    *(u32x4*)p = a; *(u32x4*)(p + 8) = b;
}
__device__ __forceinline__ void qk_norm_rope(const Raw16& raw, bf16_t* p, const float* gain, const float* ropec, const float* ropes, int pos, int lane, bool dry) {
    float v[16]; dec16(raw, v);
    float ss = 0.f;
#pragma unroll
    for (int j = 0; j < 16; ++j) ss += v[j] * v[j];
    ss += shfl_xor_l(ss, 1, lane); ss += shfl_xor_l(ss, 2, lane); ss += shfl_xor_l(ss, 4, lane);
    const float rinv = 1.0f / sqrtf(ss * (1.f / 128.f) + LN_EPS);
    const int l8 = lane & 7;
#pragma unroll
    for (int j = 0; j < 16; ++j) v[j] = v[j] * rinv * gain[l8 * 16 + j];
    if (pos >= 0) {
        const int ti = ((l8 & 4) ? 32 + (pos & 63) : (pos >> 6)) * 32 + 16 * (l8 & 1);
#pragma unroll
        for (int j = 0; j < 16; ++j) { const float pr = shfl_xor_l(v[j], 2, lane); const float c = ropec[ti + j], sn = ropes[ti + j]; v[j] = v[j] * c + ((l8 & 2) ? pr : -pr) * sn; }
    }
    if (!(PROBE_DUP && dry)) store16(p, v);
}
__device__ __forceinline__ void prep_row(bf16_t* zr, int pos, int seqlen, bool rope, bool do_q, bool do_conv, const float* qg, const float* kg, const float* cw, const float* ropec, const float* ropes, int lane, bool dry = false) {
    const int ch = lane * 16; const bool hp = pos > 0, hn = pos < seqlen - 1;
    Raw16 rq, rk, rb, rc, ru, rcp, rup, rcn, run;
    rq = rk = rb = rc = ru = rcp = rup = rcn = run = Raw16{(u32x4){0u, 0u, 0u, 0u}, (u32x4){0u, 0u, 0u, 0u}};
    if (do_q) rq = ldraw(zr + QB0 + ch);
    if (lane < 16) rk = ldraw(zr + KB0 + ch);
    if (do_conv) { rb = ldraw(zr + CB0 + ch); rc = ldraw(zr + CC0 + ch); ru = ldraw(zr + CX0 + ch);
        if (hp) { rcp = ldraw(zr - INW + CC0 + ch); rup = ldraw(zr - INW + CX0 + ch); }
        if (hn) { rcn = ldraw(zr + INW + CC0 + ch); run = ldraw(zr + INW + CX0 + ch); } }
    asm volatile("" ::: "memory");
    if (do_q) qk_norm_rope(rq, zr + QB0 + ch, qg, ropec, ropes, rope ? pos : -1, lane, dry);
    if (lane < 16) qk_norm_rope(rk, zr + KB0 + ch, kg, ropec, ropes, rope ? pos : -1, lane, dry);
    if (do_conv) {
        float bg[16], c1[16], u1[16], accv[16];
        dec16(rb, bg); dec16(rc, c1); dec16(ru, u1);
#pragma unroll
        for (int j = 0; j < 16; ++j) accv[j] = cw[1024 + ch + j] * (c1[j] * u1[j]);
        dec16(rcp, c1); dec16(rup, u1);
#pragma unroll
        for (int j = 0; j < 16; ++j) accv[j] += cw[ch + j] * (c1[j] * u1[j]);
        dec16(rcn, c1); dec16(run, u1);
#pragma unroll
        for (int j = 0; j < 16; ++j) accv[j] += cw[2048 + ch + j] * (c1[j] * u1[j]);
#pragma unroll
        for (int j = 0; j < 16; ++j) accv[j] *= bg[j];
        if (!(PROBE_DUP && dry)) store16(zr + CB0 + ch, accv);
    }
}

typedef const __attribute__((address_space(4))) Args* KArgs;
#define PHASE_CTX \
    KArgs ap = (KArgs)__builtin_amdgcn_kernarg_segment_ptr(); asm volatile("" : "+s"(ap)); \
    const int lane = lane_id_opaque(); const int wave = wave_s; int tid = wave_s * 64 + lane; asm volatile("" : "+v"(tid)); \
    const int G = gridDim.x, bx = blockIdx.x, vcu = (G % 8 == 0) ? (bx % 8) * (G / 8) + bx / 8 : bx; \
    const int gw = vcu * 8 + wave, NGW = G * 8; \
    unsigned char* ws = ap->ws; (void)lane; (void)gw; (void)NGW;
#define WSP(T, off) ((T*)(ws + (off)))

__global__ void __launch_bounds__(512, 2) mk_fwd(Args args) {
    extern __shared__ __attribute__((aligned(16))) unsigned char lds[];
    LAS unsigned char* const ldsl = (LAS unsigned char*)lds;
    {
        const int t0 = threadIdx.x;
        for (int u = t0; u < (LDS_BYTES - LDSCTL_OFF) / 4; u += 512) ((LAS unsigned*)(ldsl + LDSCTL_OFF))[u] = 0u;
    }
    __syncthreads();
    const int wave_s = __builtin_amdgcn_readfirstlane((int)threadIdx.x >> 6);
    const int lo = args.ph_lo, hi = args.ph_hi;
    XcdBarrier bar; bar.bar = (unsigned*)(args.ws + WS_CTL) + CW_BAR; bar.x = 0; bar.st = (volatile LAS unsigned*)(ldsl + MISC_OFF + 32);
    if (hi - lo > 1) bar = xcd_barrier_post((unsigned*)(args.ws + WS_CTL) + CW_BAR, (volatile LAS unsigned*)(ldsl + MISC_OFF + 32));
    int pid = 0;
#define PHASE_BEGIN if (lo <= pid && pid < hi) { PHASE_CTX
#define PHASE_END   if (pid + 1 < hi) { xcd_barrier(bar, tid == 0); if (PROBE_DUP & 16) xcd_barrier(bar, tid == 0); } } ++pid;

    PHASE_BEGIN
    _Pragma("unroll 1") for (int rep = (PROBE_DUP & 4) ? 0 : 1; rep < 2; ++rep)
    {
        const float* c_in = ap->in[1]; const float* cctx_in = ap->in[3]; const float* w_mod = ap->in[4]; const float* b_mod = ap->in[5];
        float* MOD = WSP(float, WS_MOD); float* ROPEC = WSP(float, WS_ROPE); float* ROPES = ROPEC + 96 * 32;
        if (bx < 192) {
            const int l = bx / 96, n0 = (bx % 96) * 128;
            LAS float* cact = (LAS float*)ldsl;
            for (int i = tid; i < 17 * DM; i += 512) { const int b = i >> 11, k = i & 2047; const float v = (b < 16) ? c_in[b * DM + k] : cctx_in[k]; cact[i] = v / (1.0f + __expf(-v)); }
            __syncthreads();
            const int c4 = tid & 31, kg = tid >> 5;
            f32x4 acc[17];
#pragma unroll
            for (int b = 0; b < 17; ++b) acc[b] = (f32x4){0.f, 0.f, 0.f, 0.f};
            const float* wp = w_mod + ((size_t)l * DM + kg * 128) * MODW + n0 + 4 * c4;
            for (int kk = 0; kk < 128; kk += 4) {
                const f32x4 w0 = *(const f32x4*)(wp + (size_t)(kk + 0) * MODW), w1 = *(const f32x4*)(wp + (size_t)(kk + 1) * MODW), w2 = *(const f32x4*)(wp + (size_t)(kk + 2) * MODW), w3 = *(const f32x4*)(wp + (size_t)(kk + 3) * MODW);
#pragma unroll
                for (int b = 0; b < 17; ++b) { const f32x4 a = *(const LAS f32x4*)(cact + b * DM + kg * 128 + kk); acc[b] += w0 * a.x + w1 * a.y + w2 * a.z + w3 * a.w; }
            }
            __syncthreads();
            LAS float* part = (LAS float*)ldsl;
            const int tid2 = wave_s * 64 + lane_id_opaque(), c4b = tid2 & 31, kgb = tid2 >> 5;
#pragma unroll
            for (int b = 0; b < 17; ++b) *(LAS f32x4*)(part + (kgb * 17 + b) * 128 + 4 * c4b) = acc[b];
            __syncthreads();
            for (int o = tid2; o < 17 * 128; o += 512) { const int b = o >> 7, n = o & 127; float sacc = b_mod[l * MODW + n0 + n];
#pragma unroll
                for (int g = 0; g < 16; ++g) sacc += part[(g * 17 + b) * 128 + n];
                MOD[((size_t)l * 17 + b) * MODW + n0 + n] = sacc; }
            __syncthreads();
        } else if (bx == 192) {
            for (int i = tid; i < 96 * 32; i += 512) { const int pos = i >> 5, fi = i & 31; const float p = (float)(pos < 32 ? pos : pos - 32);
                const float freq = powf(10000.0f, -(float)(2 * fi) / 64.0f); const float ang = p * freq; ROPEC[i] = cosf(ang); ROPES[i] = sinf(ang); }
        }
        const float* w_in = ap->in[6]; const float* w_branch = ap->in[11]; const float* w_o = ap->in[12]; const float* w_up = ap->in[13]; const float* w_down = ap->in[14];
        LAS float* scr = (LAS float*)(ldsl + wave * 16384);
        constexpr int I_IN = (DM / 64) * (INW / 32), I_BR = (1024 / 64) * (DM / 32), I_O = (DM / 64) * (DM / 32), I_UP = (DM / 64) * (HID / 32), I_DN = (HID / 64) * (DM / 32);
        constexpr int I_LAYER = I_IN + 3 * I_BR + I_O + I_UP + I_DN;
        for (int it = gw; it < 2 * I_LAYER; it += NGW) {
            const int l = it / I_LAYER; int r = it - l * I_LAYER; unsigned char* wl = ws + WS_W + (size_t)l * W_LAYER;
            if (r < I_IN) { const int kb_ = r / (INW / 32), nb_ = r % (INW / 32), n0_ = 32 * nb_;
                if (n0_ >= CB0 && n0_ < G0) transpose_item(w_in + (size_t)l * DM * INW + CB0, INW, (bf16_t*)(wl + W_IN), DM, scr, kb_, nb_ - CB0 / 32, lane);
                else if ((kb_ & 1) == 0) {
                    const int row0_ = (n0_ < CB0) ? 0 : (G0 - CB0);
                    transpose_item8(w_in + (size_t)l * DM * INW, INW, wl + W_G8, DM, scr, kb_, nb_, row0_, lane); transpose_item8(w_in + (size_t)l * DM * INW, INW, wl + W_G8, DM, scr, kb_ + 1, nb_, row0_, lane); }
                continue; } r -= I_IN;
            if (r < 3 * I_BR) { const int i = r / I_BR, rr = r % I_BR; transpose_item(w_branch + ((size_t)l * 3 + i) * 1024 * DM, DM, (bf16_t*)(wl + W_BR) + i * 1024, 3072, scr, rr / (DM / 32), rr % (DM / 32), lane); continue; } r -= 3 * I_BR;
            if (r < I_O) { transpose_item(w_o + (size_t)l * DM * DM, DM, (bf16_t*)(wl + W_O), DM, scr, r / (DM / 32), r % (DM / 32), lane); continue; } r -= I_O;
            if (r < I_UP) { transpose_item(w_up + (size_t)l * DM * HID, HID, (bf16_t*)(wl + W_UP), DM, scr, r / (HID / 32), r % (HID / 32), lane); continue; } r -= I_UP;
            transpose_item(w_down + (size_t)l * HID * DM, DM, (bf16_t*)(wl + W_DN), HID, scr, r / (DM / 32), r % (DM / 32), lane);
        }
        if (PROBE_DUP & 4) __syncthreads();
    }
    PHASE_END

    PHASE_BEGIN
    {
        const float* x_in = ap->in[0]; const float* ctx_in = ap->in[2]; const float* MOD = WSP(float, WS_MOD); bf16_t* H = WSP(bf16_t, WS_H);
        const LnArgs la{MALL, x_in, ctx_in, nullptr, nullptr, H, WSP(unsigned char, WS_H8), nullptr, nullptr, nullptr, MOD, 0, 1};
        _Pragma("unroll 1") for (int rep = (PROBE_DUP & 8) ? 0 : 1; rep < 2; ++rep)
        ln_phase<0>(la, gw, NGW, lane);
    }
    PHASE_END

    for (int l = 0; l < DEPTH; ++l) {
        const bool with_ctx = (l == 0);
        for (int k = -1; k < 2; ++k) {
            PHASE_BEGIN
            {
                if (k >= 0) {
                    const int ch = k; const bool ctx_here = (ch == 0);
                GWo P; P.A_lat = WSP(bf16_t, WS_H); P.A_ctx = P.A_lat + (size_t)NLAT * DM; P.a_lat0 = 0; P.W = (const bf16_t*)(ws + WS_W + (size_t)l * W_LAYER + W_O); P.lda = DM; P.ldb = DM; P.kstepA = 128; P.kstepB = 128; P.apan = 256 * DM;
                P.res_lat = (l == 0) ? (const void*)ap->in[0] : (const void*)ap->out; P.res_ctx = ap->in[2]; P.out_lat = (half_t*)ap->out; P.out_ctx = WSP(half_t, WS_CTXS);   P.mod = WSP(float, WS_MOD) + (size_t)l * 17 * MODW; P.modj = 2;
                P.lnres = (l > 0); P.stats = WSP(float, WS_STATS); P.lg = ap->in[15] + (size_t)((l > 0 ? l - 1 : 0) * 2 + 1) * DM; P.lb = ap->in[16] + (size_t)((l > 0 ? l - 1 : 0) * 2 + 1) * DM;
                P.tp = TwoPart{ch * PAN_CH, DM / 256, (with_ctx && ctx_here) ? PAN_CTX : 0, DM / 256, 0, G, bx, PAN_LAT};
                P.dry = 0; pg8::gemm_phase<GWo>(ldsl, P, tid);
                }
                if (k + 1 < 2) {
                    const int ch = k + 1; const bool ctx_here = (ch == 0);
                    const int skn = with_ctx ? (ch == 0 ? 13 : 10) : (1 << 20), skc = with_ctx ? (ch == 0 ? 192 : 128) : 0, sks = with_ctx ? (ch == 0 ? 64 : 128) : 1;
                {
                GInProj P; P.H = WSP(bf16_t, WS_H); P.W = (const bf16_t*)(ws + WS_W + (size_t)l * W_LAYER + W_IN); P.Z = WSP(bf16_t, WS_Z); P.ZC = WSP(bf16_t, WS_ZC); P.lda = DM; P.ldb = DM; P.kstepA = 128; P.kstepB = 128; P.dry = 0;
                P.tp = TwoPart{ch * PAN_CH, NCV, (with_ctx && ctx_here) ? PAN_CTX : 0, NCV, 0, G, bx, PAN_LAT};
                int tid_c = wave_s * 64 + lane_id_opaque(); asm volatile("" : "+v"(tid_c));
                pg8::gemm_phase<GInProj>(ldsl, P, tid_c);
                }
                {
                GGate8 P; P.H8 = WSP(unsigned char, WS_H8); P.W8 = ws + WS_W + (size_t)l * W_LAYER + W_G8; P.Z = WSP(bf16_t, WS_Z); P.ZC = WSP(bf16_t, WS_ZC); P.lda = DM / 2; P.ldb = DM / 2; P.kstepA = 128; P.kstepB = 128; P.dry = 0;
                P.tp = with_ctx ? TwoPart{ch * PAN_CH, N8, ctx_here ? PAN_CTX : 0, N8, 0, G, bx, PAN_LAT}
                                : TwoPart{ch * PAN_CH, N8, PAN_CTX / 2, (CB0 - KA0) / 256, KA0 / 256, G, bx, PAN_LAT + ch * (PAN_CTX / 2)};
                P.nlo = skn; P.cbase = skc; P.span = sks;
                int tid_g = wave_s * 64 + lane_id_opaque(); asm volatile("" : "+v"(tid_g));
                pg8::gemm_phase<GGate8>(ldsl, P, tid_g);
                }
                }
            }
            PHASE_END
            if (k + 1 >= 2) break;
            const int ch = k + 1; const bool ctx_here = (ch == 0);
            PHASE_BEGIN
            {
                const float* qg = ap->in[8] + l * 128; const float* kg = ap->in[9] + l * 128; const float* cw = ap->in[10] + (size_t)l * 3 * 1024;
                const float* ROPEC = WSP(float, WS_ROPE); const float* ROPES = ROPEC + 96 * 32; bf16_t* Z = WSP(bf16_t, WS_Z); bf16_t* ZC = WSP(bf16_t, WS_ZC);
                const int nctx = with_ctx ? (ctx_here ? NCTX : 0) : NCTX / 2, ctx0 = with_ctx ? 0 : ch * (NCTX / 2);
                const int nrows = CHROWS + nctx;
                _Pragma("unroll 1") for (int rep = (PROBE_DUP & 32) ? 0 : 1; rep < 2; ++rep)
                for (int m = gw; m < nrows; m += NGW) {
                    if (m < CHROWS) prep_row(Z + (size_t)m * INW, m & 2047, SEQ, true, false, true, qg, kg, cw, ROPEC, ROPES, lane, rep == 0);
                    else { const int mc = ctx0 + m - CHROWS; prep_row(ZC + (size_t)mc * INW, mc & 255, CTXL, false, with_ctx, with_ctx, qg, kg, cw, ROPEC, ROPES, lane, rep == 0); }
                }
            }
            PHASE_END
            PHASE_BEGIN
            {
                bf16_t* Z = WSP(bf16_t, WS_Z); bf16_t* ZC = WSP(bf16_t, WS_ZC); const float* rpb = ap->in[7];
                const int n_dense = 512 + ((with_ctx && ctx_here) ? 256 : 0);
                _Pragma("unroll 1") for (int rep = (PROBE_DUP & 2) ? 0 : 1; rep < 2; ++rep) {
                for (int id = bx; id < n_dense; id += G) {
                    att::AUnit A; A.r0 = 0; A.lo = 0; A.rpb = nullptr; A.dry = (rep == 0); A.qgain = nullptr; A.ropec = nullptr; A.pos0 = 0;
                    if (id < 512) {
                        const int it = id >> 8, cc = id & 255, pair = (cc & 7) + 8 * it, j = cc >> 3;
                        const int bl = pair >> 1, qh = (pair & 1) * 4 + (j >> 3), qb = j & 7, b = ch * 8 + bl;
                        A.Q = Z + ((size_t)(bl * SEQ + qb * 256) * INW + QB0 + qh * 128);
                        A.P0 = Z + ((size_t)(bl * SEQ) * INW + KB0 + (qh >> 2) * 128); A.P1 = ZC + ((size_t)(b * CTXL) * INW + KB0 + (qh >> 2) * 128);
                        A.nfirst = 32; A.NT = 36; A.vofs = VB0 - KB0; A.qgain = ap->in[8] + l * 128; A.ropec = WSP(float, WS_ROPE); A.pos0 = qb * 256;
                    } else {
                        const int i2 = id - 512, b = i2 >> 4, hh = i2 & 15; const bf16_t* zb = ZC + (size_t)(b * CTXL) * INW;
                        if (hh < 8) { A.Q = zb + QA0 + hh * 128; A.P0 = zb + KA0 + hh * 128; A.vofs = VA0 - KA0; }
                        else { const int qh = hh - 8; A.Q = zb + QB0 + qh * 128; A.P0 = zb + KB0 + (qh >> 2) * 128; A.vofs = VB0 - KB0; }
                        A.P1 = A.P0; A.nfirst = 4; A.NT = 4;
                    }
                    att::attn_unit<false>(A, (char*)lds, ldsl, tid);
                }
                for (int id = bx; id < 512; id += G) {
                    const int it = id >> 8, cc = id & 255, pairn = (cc & 7) * 8 + 4 * it + (cc >> 6), r0 = 4 * ((cc >> 3) & 7);
                    const int bl = pairn >> 3, h = pairn & 7;
                    const int b = ch * 8 + bl; const bool edge = (r0 == 0 || r0 == 28); const int lo_ = (r0 == 0) ? 0 : (r0 == 28 ? 24 : r0 - 4);
                    att::AUnit A; A.Q = Z + ((size_t)(bl * SEQ + r0 * 64) * INW + QA0 + h * 128);
                    A.P0 = ZC + ((size_t)(b * CTXL) * INW + KA0 + h * 128); A.P1 = Z + ((size_t)(bl * SEQ + lo_ * 64) * INW + KA0 + h * 128);
                    A.nfirst = 4; A.NT = 4 + (edge ? 8 : 12); A.vofs = VA0 - KA0; A.r0 = r0; A.lo = lo_; A.rpb = rpb + ((size_t)l * 8 + h) * 15 * 31; A.dry = (rep == 0); A.qgain = nullptr; A.ropec = nullptr; A.pos0 = 0;
                    att::attn_unit<true>(A, (char*)lds, ldsl, tid);
                }
                }
            }
            PHASE_END
            PHASE_BEGIN
            {
                GBranch P; P.Z = WSP(bf16_t, WS_Z); P.ZC = WSP(bf16_t, WS_ZC); P.W = (const bf16_t*)(ws + WS_W + (size_t)l * W_LAYER + W_BR); P.Hout = WSP(bf16_t, WS_H); P.lda = INW; P.ldb = 3072; P.kstepA = 128; P.kstepB = 128;
                P.tp = TwoPart{ch * PAN_CH, DM / 256, (with_ctx && ctx_here) ? PAN_CTX : 0, DM / 256, 0, G, bx, PAN_LAT};
                _Pragma("unroll 1") for (int rep = (((PROBE_DUP & 1) != 0) && ((PROBE_GEMM_MASK & 2) != 0)) ? 0 : 1; rep < 2; ++rep) { P.dry = (rep == 0) && !PROBE_REAL; pg8::gemm_phase<GBranch>(ldsl, P, tid); }
            }
            PHASE_END
        }
        PHASE_BEGIN
        {
            const int nrows = with_ctx ? MALL : NLAT; const float* g = ap->in[15] + (size_t)(l * 2 + 0) * DM; const float* bb = ap->in[16] + (size_t)(l * 2 + 0) * DM;
            float* OUT = ap->out; float* CTXS = WSP(float, WS_CTXS); bf16_t* H = WSP(bf16_t, WS_H); const float* MODL = WSP(float, WS_MOD) + (size_t)l * 17 * MODW;
            const LnArgs la{nrows, (const void*)OUT, (const void*)CTXS, OUT, CTXS, H, nullptr, WSP(float, WS_STATS), g, bb, MODL, 3, 4};
            _Pragma("unroll 1") for (int rep = (PROBE_DUP & 64) ? 0 : 1; rep < 2; ++rep)
            ln_phase<1>(la, gw, NGW, lane);
        }
        PHASE_END
        for (int st = 0; st < 3; ++st) {
            PHASE_BEGIN
            {
                if (st >= 1) {
                    const int ch = st - 1; const bool ctx_here = (ch == 0) && with_ctx;
                GDown P; P.A_lat = WSP(bf16_t, ch == 0 ? WS_U0 : WS_U1); P.A_ctx = P.A_lat + (size_t)CHROWS * HID; P.a_lat0 = ch * PAN_CH; P.W = (const bf16_t*)(ws + WS_W + (size_t)l * W_LAYER + W_DN); P.lda = 64; P.ldb = HID; P.kstepA = 256 * 64 * 2; P.kstepB = 128; P.apan = 256 * HID;
                P.res_lat = ap->out; P.res_ctx = WSP(half_t, WS_CTXS); P.out_lat = (l + 1 < DEPTH) ? (half_t*)ap->out : WSP(half_t, WS_H); P.out_ctx = WSP(half_t, WS_CTXS);   P.mod = WSP(float, WS_MOD) + (size_t)l * 17 * MODW; P.modj = 5;
                P.lnres = 1; P.stats = WSP(float, WS_STATS); P.lg = ap->in[15] + (size_t)(l * 2 + 0) * DM; P.lb = ap->in[16] + (size_t)(l * 2 + 0) * DM;
                P.tp = TwoPart{ch * PAN_CH, DM / 256, ctx_here ? PAN_CTX : 0, DM / 256, 0, G, bx, PAN_LAT};
                P.dry = 0; pg8::gemm_phase<GDown>(ldsl, P, tid);
                }
                if (st < 2) {
                    const int ch = st; const bool ctx_here = (ch == 0) && with_ctx;
                GUp P; P.H = WSP(bf16_t, WS_H); P.W = (const bf16_t*)(ws + WS_W + (size_t)l * W_LAYER + W_UP); P.U = WSP(bf16_t, ch == 0 ? WS_U0 : WS_U1); P.lda = DM; P.ldb = DM; P.kstepA = 128; P.kstepB = 128;
                P.tp = TwoPart{ch * PAN_CH, HID / 256, ctx_here ? PAN_CTX : 0, HID / 256, 0, G, bx, PAN_LAT};
                P.dry = 0; P.nlo = (with_ctx && ch == 1) ? 6 : (1 << 20); P.cbase = 128; P.span = 128;
                int tid_u = wave_s * 64 + lane_id_opaque(); asm volatile("" : "+v"(tid_u));
                pg8::gemm_phase<GUp>(ldsl, P, tid_u);
                }
            }
            PHASE_END
        }
        PHASE_BEGIN
        {
            const int nrows = with_ctx ? MALL : NLAT; const float* g = ap->in[15] + (size_t)(l * 2 + 1) * DM; const float* bb = ap->in[16] + (size_t)(l * 2 + 1) * DM;
            float* OUT = ap->out; float* CTXS = WSP(float, WS_CTXS); bf16_t* H = WSP(bf16_t, WS_H); const float* MODN = WSP(float, WS_MOD) + (size_t)(l + 1) * 17 * MODW;
            const LnArgs la{nrows, (l + 1 < DEPTH) ? (const void*)OUT : (const void*)H, (const void*)CTXS, OUT, CTXS, H, WSP(unsigned char, WS_H8), WSP(float, WS_STATS), g, bb, MODN, 0, 1};
            if (l + 1 < DEPTH) { _Pragma("unroll 1") for (int rep = (PROBE_DUP & 64) ? 0 : 1; rep < 2; ++rep) ln_phase<1>(la, gw, NGW, lane); }
            else ln_phase<2>(la, gw, NGW, lane);
        }
        PHASE_END
    }
#undef PHASE_BEGIN
#undef PHASE_END
}
constexpr int N_PHASES = 2 + DEPTH * (3 + 2 * 3 + 1 + 3 + 1);

extern "C" void kernel_launch(void* const* d_in, const int* in_sizes, int n_in, void* d_out, int out_size, void* d_ws, size_t ws_size, hipStream_t stream) {
    static int grid = 0;
    if (grid == 0) {
        if (n_in != 17 || in_sizes[0] != NLAT * DM || out_size != NLAT * DM || ws_size < WS_END) { fprintf(stderr, "kernel_launch: shape / workspace mismatch (ws %zu, need %zu)\n", ws_size, (size_t)WS_END); grid = -1; return; }
        int dev = 0, cus = 0, per_cu = 0;
        if (hipGetDevice(&dev) != hipSuccess || hipDeviceGetAttribute(&cus, hipDeviceAttributeMultiprocessorCount, dev) != hipSuccess) { grid = -1; return; }
        if (hipFuncSetAttribute((const void*)mk_fwd, hipFuncAttributeMaxDynamicSharedMemorySize, LDS_BYTES) != hipSuccess) { fprintf(stderr, "kernel_launch: hipFuncSetAttribute failed\n"); grid = -1; return; }
        if (hipOccupancyMaxActiveBlocksPerMultiprocessor(&per_cu, (const void*)mk_fwd, 512, LDS_BYTES) != hipSuccess || per_cu < 1) fprintf(stderr, "kernel_launch: occupancy query says %d\n", per_cu);
        (void)hipGetLastError();
        if (cus != 256) { fprintf(stderr, "kernel_launch: the skewed unit deals are laid out for 256 CUs (have %d)\n", cus); grid = -1; return; }
        grid = cus;
    }
    if (grid < 0) return;
    if (hipMemsetAsync((char*)d_ws + WS_CTL, 0, CTL_ZERO_BYTES, stream) != hipSuccess) return;
    Args a{};
    for (int i = 0; i < 17; ++i) a.in[i] = (const float*)d_in[i];
    a.out = (float*)d_out; a.ws = (unsigned char*)d_ws;
#if MK_PER_PHASE
    for (int p = 0; p < N_PHASES; ++p) { a.ph_lo = p; a.ph_hi = p + 1; hipLaunchKernelGGL(mk_fwd, dim3(grid), dim3(512), LDS_BYTES, stream, a); }
#else
    a.ph_lo = 0; a.ph_hi = N_PHASES;
    hipLaunchKernelGGL(mk_fwd, dim3(grid), dim3(512), LDS_BYTES, stream, a);
#endif
    const hipError_t le = hipPeekAtLastError();
    if (le != hipSuccess) fprintf(stderr, "kernel_launch: launch failed: %s\n", hipGetErrorName(le));
}
```

```cpp
#include <hip/hip_runtime.h>
#include <cstdio>
#include <cstdint>
#include <cmath>

#define LAS __attribute__((address_space(3)))
#define GAS __attribute__((address_space(1)))
typedef unsigned short bf16_t;
typedef short bf16x8 __attribute__((ext_vector_type(8)));
typedef short bf16x16_t __attribute__((ext_vector_type(16)));
typedef short s16x4 __attribute__((ext_vector_type(4)));
typedef float f32x4 __attribute__((ext_vector_type(4)));
typedef float f32x2 __attribute__((ext_vector_type(2)));
typedef float f32x16 __attribute__((ext_vector_type(16)));
typedef unsigned u32x4 __attribute__((ext_vector_type(4)));
typedef unsigned u32x2 __attribute__((ext_vector_type(2)));
typedef int i32x8 __attribute__((ext_vector_type(8)));

#ifndef PROBE_DUP
#define PROBE_DUP 0
#endif
#ifndef STAGGER_TICKS
#define STAGGER_TICKS 0
#endif
#ifndef PROBE_REAL
#define PROBE_REAL 0
#endif
#ifndef PROBE_GEMM_MASK
#define PROBE_GEMM_MASK 31
#endif
#ifndef MK_PER_PHASE
#define MK_PER_PHASE 0
#endif

constexpr int DM = 2048, NB = 16, SEQ = 2048, CTXL = 256, HD = 128, HID = 8192, DEPTH = 2;
constexpr int QA0 = 0, QB0 = 1024, KA0 = 2048, VA0 = 3072, KB0 = 4096, VB0 = 4352, CB0 = 4608, CC0 = 5632, CX0 = 6656, G0 = 7680, INW = 13824;
constexpr int NLAT = NB * SEQ, NCTX = NB * CTXL, MALL = NLAT + NCTX;
constexpr int CHROWS = 16384, PAN_CH = 64, PAN_LAT = 128, PAN_CTX = 16;
constexpr float LN_EPS = 1e-6f, DN_ALPHA = 1.4142135623730951f, ATT_SCALE = 0.08838834764831845f;
constexpr int MODW = 6 * DM;

constexpr size_t MiB = 1u << 20;
constexpr size_t WS_CTL = 0, CTL_ZERO_BYTES = 1 * MiB;
constexpr size_t WS_MOD = 1 * MiB;
constexpr size_t WS_ROPE = 3 * MiB;
constexpr size_t WS_STATS = 3 * MiB + 512 * 1024;
constexpr int NQKV = CB0 / 256, NCV = (G0 - CB0) / 256, NGT = (INW - G0) / 256, N8 = NQKV + NGT;
constexpr size_t WS_W = 4 * MiB;
constexpr size_t W_IN = 0, W_G8 = 12 * MiB, W_BR = 34 * MiB, W_O = 46 * MiB, W_UP = 54 * MiB, W_DN = 86 * MiB, W_LAYER = 126 * MiB;
constexpr size_t WS_CTXS = 256 * MiB;
constexpr size_t WS_H = 272 * MiB;
constexpr size_t WS_H8 = 416 * MiB;
constexpr size_t WS_ZC = 488 * MiB;
constexpr size_t WS_Z = 596 * MiB;
constexpr size_t WS_END = 1028 * MiB;
constexpr size_t WS_U0 = WS_END - (size_t)(CHROWS + NCTX) * HID * 2, WS_U1 = WS_H8;
static_assert(WS_U1 + (size_t)CHROWS * HID * 2 <= WS_U0 && WS_U0 >= WS_Z, "U buffers");
static_assert(WS_W + 2 * W_LAYER <= WS_CTXS && WS_CTXS + (size_t)NCTX * DM * 2 <= WS_H && WS_H + (size_t)MALL * DM * 2 <= WS_H8 && WS_H8 + (size_t)MALL * DM <= WS_ZC && WS_ZC + (size_t)NCTX * INW * 2 <= WS_Z && WS_Z + (size_t)CHROWS * INW * 2 <= WS_END, "ws map");
static_assert((size_t)(G0 - CB0) * DM * 2 <= W_G8 && W_G8 + (size_t)N8 * 256 * DM <= W_BR, "weight map");
static_assert((size_t)(CHROWS + NCTX) * HID * 2 <= WS_END - WS_Z, "U overlay");
constexpr int CW_TMO = 0, CW_BAR = 4096;

constexpr int RING_BYTES = 131072;
constexpr int SCR_BYTES = 139264;
constexpr int LDSCTL_OFF = SCR_BYTES, MISC_OFF = LDSCTL_OFF + 64;
constexpr int LDS_BYTES = 147456;

#define RLX_AGENT __ATOMIC_RELAXED, __HIP_MEMORY_SCOPE_AGENT
#define LDS_WAIT() asm volatile("s_waitcnt lgkmcnt(0)" ::: "memory")
#define VM_WAIT() asm volatile("s_waitcnt vmcnt(0)" ::: "memory")
typedef float f32x2_cv __attribute__((ext_vector_type(2))); typedef __bf16 bf16x2_cv __attribute__((ext_vector_type(2)));
__device__ __forceinline__ unsigned cvt_pk_bf16(float lo, float hi) { const f32x2_cv v = {lo, hi}; const bf16x2_cv b = __builtin_convertvector(v, bf16x2_cv); return __builtin_bit_cast(unsigned, b); }
__device__ __forceinline__ float bflo(unsigned w) { return __uint_as_float(w << 16); }
__device__ __forceinline__ float bfhi(unsigned w) { return __uint_as_float(w & 0xffff0000u); }
typedef _Float16 h16x2 __attribute__((ext_vector_type(2)));
__device__ __forceinline__ unsigned pk_h2(float a, float b) { a = __builtin_amdgcn_fmed3f(a, -60000.f, 60000.f); b = __builtin_amdgcn_fmed3f(b, -60000.f, 60000.f); h16x2 h = {(_Float16)a, (_Float16)b}; return __builtin_bit_cast(unsigned, h); }
__device__ __forceinline__ f32x2 un_h2(unsigned w) { const h16x2 h = __builtin_bit_cast(h16x2, w); return (f32x2){(float)h.x, (float)h.y}; }
__device__ __forceinline__ void un_h8(const u32x4 w, f32x4& lo, f32x4& hi) { const f32x2 a = un_h2(w.x), b = un_h2(w.y), c = un_h2(w.z), d = un_h2(w.w); lo = (f32x4){a.x, a.y, b.x, b.y}; hi = (f32x4){c.x, c.y, d.x, d.y}; }
constexpr float G8_WSCALE = 32.0f;
__device__ __forceinline__ unsigned pk_fp8x4(float a, float b, float c, float d) { int v = __builtin_amdgcn_cvt_pk_fp8_f32(a, b, 0, false); v = __builtin_amdgcn_cvt_pk_fp8_f32(c, d, v, true); return (unsigned)v; }
__device__ __forceinline__ int lane_id_opaque() { int l; asm volatile("v_mbcnt_lo_u32_b32 %0, -1, 0\n\tv_mbcnt_hi_u32_b32 %0, -1, %0" : "=v"(l)); return l; }
__device__ __forceinline__ float shfl_xor_l(float v, int mask, int lane) { return __uint_as_float((unsigned)__builtin_amdgcn_ds_bpermute((lane ^ mask) << 2, (int)__float_as_uint(v))); }
__device__ __forceinline__ float wave_sum(float v, int lane) {
#pragma unroll
    for (int o = 1; o < 64; o <<= 1) v += shfl_xor_l(v, o, lane);
    return v;
}

#define XB_TMO      128
#define XB_XCNT(j)  (256  + 64 * (j))
#define XB_XSUB(j)  (1280 + 64 * (j))
#define XB_XGEN(j)  (2304 + 64 * (j))
#define XB_TOP      3328
#define XB_TOPGEN   3392
#define XCD_BAR_WORDS 3456
#define XB_SPIN_CAP (1u << 20)
__device__ __forceinline__ unsigned xb_ld(unsigned* p)              { return __hip_atomic_load(p, __ATOMIC_RELAXED, __HIP_MEMORY_SCOPE_AGENT); }
__device__ __forceinline__ unsigned xb_add(unsigned* p, unsigned v) { return __hip_atomic_fetch_add(p, v, __ATOMIC_RELAXED, __HIP_MEMORY_SCOPE_AGENT); }
__device__ __forceinline__ unsigned xb_xcc_id() { return (unsigned)__builtin_amdgcn_s_getreg((3 << 11) | 20) & 0xFu; }
#define XB_SPIN(cond, bar) do { unsigned _sp = 0; while (cond) { __builtin_amdgcn_s_sleep(1); \
    if ((++_sp & 255u) == 0u) { if (xb_ld(&(bar)[XB_TMO])) break; if (_sp > XB_SPIN_CAP) { atomicAdd(&(bar)[XB_TMO], 1u); break; } } } } while (0)
struct XcdBarrier { unsigned* bar; unsigned x; volatile LAS unsigned* st; };
__device__ __forceinline__ XcdBarrier xcd_barrier_post(unsigned* bar, volatile LAS unsigned* st) {
    XcdBarrier b; b.bar = bar; b.x = xb_xcc_id(); b.st = st;
    if (threadIdx.x == 0) (void)xb_add(&bar[XB_XCNT(b.x)], 1u);
    return b;
}
__device__ __forceinline__ void xcd_barrier_complete(unsigned* bar, unsigned x, unsigned& nloc, unsigned& nx) {
    const unsigned G = gridDim.x * gridDim.y * gridDim.z;
    unsigned sum, cnt, mine, sp = 0u;
    for (;;) {
        sum = 0u; cnt = 0u; mine = 0u;
#pragma unroll
        for (unsigned j = 0; j < 16; ++j) { const unsigned c = xb_ld(&bar[XB_XCNT(j)]); sum += c; cnt += (c > 0u) ? 1u : 0u; mine = (j == x) ? c : mine; }
        if (sum == G) break;
        __builtin_amdgcn_s_sleep(1);
        if ((++sp & 255u) == 0u) { if (xb_ld(&bar[XB_TMO])) break; if (sp > XB_SPIN_CAP) { atomicAdd(&bar[XB_TMO], 1u); break; } }
    }
    nloc = mine > 0u ? mine : 1u; nx = cnt > 0u ? cnt : 1u;
}
__device__ __forceinline__ void xcd_barrier(const XcdBarrier& b, const bool leader) {
    asm volatile("s_waitcnt vmcnt(0)" ::: "memory");
    __syncthreads();
    if (leader) {
        unsigned* bar = b.bar;
        __builtin_amdgcn_s_waitcnt(0);
        unsigned nloc = b.st[0], nx = b.st[1];
        if (nloc == 0u) { xcd_barrier_complete(bar, b.x, nloc, nx); b.st[0] = nloc; b.st[1] = nx; }
        const unsigned old = xb_add(&bar[XB_XSUB(b.x)], 1u);
        const unsigned gen = old / nloc;
        if (old + 1u == (gen + 1u) * nloc) {
            __builtin_amdgcn_fence(__ATOMIC_RELEASE, "agent");
            asm volatile("s_waitcnt vmcnt(0)" ::: "memory");
            const unsigned og = xb_add(&bar[XB_TOP], 1u);
            const unsigned tg = og / nx;
            if (og + 1u == (tg + 1u) * nx) xb_add(&bar[XB_TOPGEN], 1u);
            else XB_SPIN(xb_ld(&bar[XB_TOPGEN]) == tg, bar);
            __builtin_amdgcn_fence(__ATOMIC_ACQUIRE, "agent");
            xb_add(&bar[XB_XGEN(b.x)], 1u);
            asm volatile("s_waitcnt vmcnt(0)" ::: "memory");
        } else {
            XB_SPIN(xb_ld(&bar[XB_XGEN(b.x)]) == gen, bar);
            __builtin_amdgcn_fence(__ATOMIC_ACQUIRE, "agent");
            asm volatile("s_waitcnt vmcnt(0)" ::: "memory");
        }
    }
    __syncthreads();
}

namespace pg8 {
constexpr int BM = 256, BK = 64, HALF = 128, HTB = HALF * BK * 2, STAGE_BYTES = 8 * HTB;
__host__ __device__ __forceinline__ int lds_byte(int r, int c) { const int st = (r >> 4) * 2 + (c >> 5), rr = r & 15, cc = c & 31, ob = rr * 64 + cc * 2; return st * 1024 + (ob ^ (((ob >> 9) & 1) << 5)); }
__host__ __device__ __forceinline__ void stage_rc(int b, int& R, int& C) { const int st = b / 1024, sb = b % 1024, swz = sb ^ (((sb >> 9) & 1) << 5); R = (st >> 1) * 16 + swz / 64; C = (st & 1) * 32 + (swz % 64) / 2; }
__host__ __device__ __forceinline__ int perm32(int rho) { const int n = rho >> 4, i = rho & 15; return 8 * (i >> 2) + 4 * n + (i & 3); }
struct Unit { int pm, pn, seg; };
__device__ __forceinline__ void tile_map(int L, int nwg, int nM, int nN, int& pm, int& pn) {
    const int q = nwg / 8, r = nwg % 8, xcd = L % 8, off = L / 8;
    const int wgid = (xcd < r ? xcd * (q + 1) : r * (q + 1) + (xcd - r) * q) + off;
    const int sh = (nN <= 8) ? 2 : 3, WG = 1 << sh;
    const int nig = WG * nN, gid = wgid / nig, rem = wgid - gid * nig; (void)nM;
    pm = gid * WG + (rem & (WG - 1)); pn = rem >> sh;
}

template <class P>
__device__ __forceinline__ void gemm_phase(LAS unsigned char* lds, const P& p, const int tid) {
    const int wid = __builtin_amdgcn_readfirstlane(tid >> 6), lane = tid & 63, wr = wid >> 2, wc = wid & 3, fr = lane & 15, fq = lane >> 4;
    constexpr int nt = P::NT;
    unsigned voffA[2], voffB[2];
#pragma unroll
    for (int i = 0; i < 2; ++i) { int R, C; stage_rc(tid * 16 + i * 8192, R, C); const int Rb = P::PERM ? ((R & ~31) + perm32(R & 31)) : R;
        if (P::FP8) C ^= ((R >> 1) & 1) << 3;
        voffA[i] = (unsigned)(R * p.lda + C) * 2u; voffB[i] = (unsigned)(Rb * p.ldb + C) * 2u; }
    const size_t kstepA = (size_t)p.kstepA, kstepB = (size_t)p.kstepB;
    const size_t hstepA = (size_t)HALF * p.lda * 2, hstepB = (size_t)HALF * p.ldb * 2;
    const unsigned ldsw = (unsigned)wid * 1024u;
    const int aoff = P::FP8 ? lds_byte(wr * 64 + fr, fq * 16) : lds_byte(wr * 64 + fr, fq * 8), boff = P::FP8 ? lds_byte(wc * 32 + fr, fq * 16) : lds_byte(wc * 32 + fr, fq * 8);
#define PG8_SA(b, h) (((b) * 2 + (h)) * HTB)
#define PG8_SB(b, h) ((4 + (b) * 2 + (h)) * HTB)
#define PG8_STAGE(bufoff, gbase, voff) do { _Pragma("unroll") for (int _i = 0; _i < 2; ++_i) \
        __builtin_amdgcn_global_load_lds((const unsigned*)((const char*)(gbase) + (voff)[_i]), (LAS unsigned*)(lds + (bufoff) + ldsw + _i * 8192), 16, 0, 0); } while (0)
typedef int i32x4_t __attribute__((ext_vector_type(4)));
    const int w16 = P::FP8 ? ((fr >> 1) & 1) * 16 : 0;
#define PG8_LD32(p) __builtin_shufflevector(*(const LAS i32x4_t*)((p) + w16), *(const LAS i32x4_t*)((p) + (16 - w16)), 0, 1, 2, 3, 4, 5, 6, 7)
#define PG8_LDA(dst, b, h) do { if constexpr (P::FP8) { _Pragma("unroll") for (int m = 0; m < 4; ++m) dst##8[m] = PG8_LD32(lds + PG8_SA(b, h) + aoff + m * 2048); } \
        else { _Pragma("unroll") for (int m = 0; m < 4; ++m) _Pragma("unroll") for (int k = 0; k < 2; ++k) dst[m][k] = *(const LAS bf16x8*)(lds + PG8_SA(b, h) + aoff + m * 2048 + k * 1024); } } while (0)
#define PG8_LDB(dst, b, h) do { if constexpr (P::FP8) { _Pragma("unroll") for (int n = 0; n < 2; ++n) dst##8[n] = PG8_LD32(lds + PG8_SB(b, h) + boff + n * 2048); } \
        else { _Pragma("unroll") for (int n = 0; n < 2; ++n) _Pragma("unroll") for (int k = 0; k < 2; ++k) dst[n][k] = *(const LAS bf16x8*)(lds + PG8_SB(b, h) + boff + n * 2048 + k * 1024); } } while (0)
#define PG8_MMA(ai, bj, At, Bt) do { __builtin_amdgcn_s_setprio(1); _Pragma("unroll") for (int m = 0; m < 4; ++m) _Pragma("unroll") for (int n = 0; n < 2; ++n) { \
        if constexpr (P::FP8) asm volatile("v_mfma_f32_16x16x128_f8f6f4 %0, %1, %2, %0" : "+v"(acc[ai][bj][m][n]) : "v"(Bt##8[n]), "v"(At##8[m])); \
        else { _Pragma("unroll") for (int k = 0; k < 2; ++k) acc[ai][bj][m][n] = __builtin_amdgcn_mfma_f32_16x16x32_bf16(Bt[n][k], At[m][k], acc[ai][bj][m][n], 0, 0, 0); } } __builtin_amdgcn_s_setprio(0); } while (0)
#define PG8_WAIT_V(n) asm volatile("s_waitcnt vmcnt(" #n ")" ::: "memory")
#define PG8_WAIT_L(n) asm volatile("s_waitcnt lgkmcnt(" #n ")" ::: "memory")
#define PG8_BAR __builtin_amdgcn_s_barrier()
#define PG8_SCHED __builtin_amdgcn_sched_barrier(0)
    Unit cur, nxt; int ui = 0;
    if (!p.next(0, cur)) return;
    if (STAGGER_TICKS > 0) {
        const unsigned long long t0 = __builtin_amdgcn_s_memrealtime(), dl = (unsigned long long)(((unsigned)blockIdx.x >> 3) & 7u) * STAGGER_TICKS;
        while (__builtin_amdgcn_s_memrealtime() - t0 < dl) __builtin_amdgcn_s_sleep(4);
    }
    f32x4 acc[2][2][4][2];
#pragma unroll
    for (int a = 0; a < 2; ++a)
#pragma unroll
        for (int b = 0; b < 2; ++b)
#pragma unroll
            for (int m = 0; m < 4; ++m)
#pragma unroll
                for (int n = 0; n < 2; ++n) acc[a][b][m][n] = (f32x4){0.f, 0.f, 0.f, 0.f};
    bf16x8 At[4][2], B0[2][2], B1[2][2]; i32x8 At8[4], B08[2], B18[2]; (void)At; (void)B0; (void)B1; (void)At8; (void)B08; (void)B18;
    const char* cA = p.a_ptr(cur); const char* cB = p.b_ptr(cur);
    PG8_STAGE(PG8_SB(0, 0), cB, voffB); PG8_STAGE(PG8_SB(0, 1), cB + hstepB, voffB); PG8_STAGE(PG8_SA(0, 0), cA, voffA); PG8_STAGE(PG8_SA(0, 1), cA + hstepA, voffA);
    if (wr == 1) PG8_BAR;
    PG8_WAIT_V(2); PG8_BAR;
    PG8_STAGE(PG8_SB(1, 0), cB + kstepB, voffB); PG8_STAGE(PG8_SA(1, 0), cA + kstepA, voffA); PG8_STAGE(PG8_SB(1, 1), cB + hstepB + kstepB, voffB);
    PG8_WAIT_V(6); PG8_BAR;
    for (;;) {
        const bool has_next = p.next(ui + 1, nxt);
        const char* nA = has_next ? p.a_ptr(nxt) : cA; const char* nB = has_next ? p.b_ptr(nxt) : cB;
        _Pragma("nounroll") for (int t = 0; t < nt; t += 2) {
            const bool last = (t == nt - 2);
            const char* a1 = cA + (size_t)(t + 1) * kstepA;
            const char* a2 = last ? nA : cA + (size_t)(t + 2) * kstepA; const char* b2 = last ? nB : cB + (size_t)(t + 2) * kstepB;
            const char* a3 = a2 + kstepA; const char* b3 = b2 + kstepB;
            PG8_LDB(B0, 0, 0); PG8_LDB(B1, 0, 1); PG8_SCHED; PG8_LDA(At, 0, 0); PG8_STAGE(PG8_SA(1, 1), a1 + hstepA, voffA);
            PG8_WAIT_V(8); PG8_WAIT_L(0); PG8_BAR; PG8_MMA(0, 0, At, B0); PG8_MMA(0, 1, At, B1); PG8_BAR; PG8_SCHED;
            PG8_LDA(At, 0, 1); PG8_STAGE(PG8_SB(0, 0), b2, voffB); PG8_STAGE(PG8_SB(0, 1), b2 + hstepB, voffB); PG8_STAGE(PG8_SA(0, 0), a2, voffA);
            PG8_WAIT_V(8); PG8_WAIT_L(0); PG8_BAR; PG8_MMA(1, 0, At, B0); PG8_MMA(1, 1, At, B1); PG8_BAR; PG8_SCHED;
            PG8_LDB(B0, 1, 0); PG8_LDB(B1, 1, 1); PG8_SCHED; PG8_LDA(At, 1, 0); PG8_STAGE(PG8_SA(0, 1), a2 + hstepA, voffA);
            PG8_WAIT_V(8); PG8_WAIT_L(0); PG8_BAR; PG8_MMA(0, 0, At, B0); PG8_MMA(0, 1, At, B1); PG8_BAR; PG8_SCHED;
            PG8_LDA(At, 1, 1); PG8_STAGE(PG8_SB(1, 0), b3, voffB); PG8_STAGE(PG8_SB(1, 1), b3 + hstepB, voffB); PG8_STAGE(PG8_SA(1, 0), a3, voffA);
            PG8_WAIT_V(8); PG8_WAIT_L(0); PG8_BAR; PG8_MMA(1, 0, At, B0); PG8_MMA(1, 1, At, B1); PG8_BAR; PG8_SCHED;
        }
        if (wr == 0) PG8_BAR;
        if constexpr (P::FP8) asm volatile("s_nop 15\n\ts_nop 15" ::: "memory");
        p.epi(acc, cur, wr, wc, fr, fq);
        if (!has_next) break;
        if (!p.keep(cur)) {
#pragma unroll
            for (int a = 0; a < 2; ++a)
#pragma unroll
                for (int b = 0; b < 2; ++b)
#pragma unroll
                    for (int m = 0; m < 4; ++m)
#pragma unroll
                        for (int n = 0; n < 2; ++n) acc[a][b][m][n] = (f32x4){0.f, 0.f, 0.f, 0.f};
        }
        cur = nxt; cA = nA; cB = nB; ++ui;
        if (wr == 1) PG8_BAR;
    }
    PG8_WAIT_V(0);
    PG8_BAR;
#undef PG8_SA
#undef PG8_SB
#undef PG8_STAGE
#undef PG8_LDA
#undef PG8_LDB
#undef PG8_MMA
#undef PG8_WAIT_V
#undef PG8_WAIT_L
#undef PG8_BAR
#undef PG8_SCHED
}
}
using pg8::Unit;

struct TwoPart {
    int lat0, nNa, nMb, nNb, pn0b, G, c, pmb0;
    __device__ __forceinline__ bool map(int L, Unit& u) const {
        const int nA = PAN_CH * nNa, nB = nMb * nNb; int pm, pn;
        if (L < nA) { pg8::tile_map(L, nA, PAN_CH, nNa, pm, pn); u.pm = lat0 + pm; u.pn = pn; return true; }
        if (L < nA + nB) { pg8::tile_map(L - nA, nB, nMb, nNb, pm, pn); u.pm = pmb0 + pm; u.pn = pn0b + pn; return true; }
        return false;
    }
};
__device__ __forceinline__ int skew_deal(int i, int G, int c, int nlo, int cbase, int span) {
    if (i < nlo) return i * G + c;
    return ((unsigned)(c - cbase) < (unsigned)span) ? nlo * G + (i - nlo) * span + (c - cbase) : 0x3fffffff;
}
__device__ __forceinline__ float sigmoid_c(float x) { x = fminf(fmaxf(x, -30.f), 30.f); return __builtin_amdgcn_rcpf(1.f + __builtin_amdgcn_exp2f(-1.4426950408889634f * x)); }

__device__ __forceinline__ unsigned gate_u8(float x) { const unsigned q = (unsigned)(sigmoid_c(x) * 255.f + 0.5f); return q < 1u ? 1u : q; }
__device__ __forceinline__ void epi_z(const f32x4 (&acc)[2][2][4][2], bf16_t* base, int pn, bool gate, float scale, int wr, int wc, int fr, int fq) {
    int row0 = wr * 64 + fr, col0 = pn * 256 + wc * 32 + 8 * fq;
    asm volatile("" : "+v"(row0), "+v"(col0));
#pragma unroll
    for (int ai = 0; ai < 2; ++ai)
#pragma unroll
        for (int m = 0; m < 4; ++m) { bf16_t* rowp = base + (size_t)(row0 + ai * 128 + m * 16) * INW + col0;
#pragma unroll
            for (int bj = 0; bj < 2; ++bj) { f32x4 v0 = acc[ai][bj][m][0], v1 = acc[ai][bj][m][1];
                v0 = v0 * scale; v1 = v1 * scale;
                if (gate) {
                    u32x2 w; w.x = gate_u8(v0[0]) | (gate_u8(v0[1]) << 8) | (gate_u8(v0[2]) << 16) | (gate_u8(v0[3]) << 24);
                    w.y = gate_u8(v1[0]) | (gate_u8(v1[1]) << 8) | (gate_u8(v1[2]) << 16) | (gate_u8(v1[3]) << 24);
                    *(u32x2*)((unsigned char*)(rowp - col0 + G0) + (col0 - G0) + bj * 128) = w;
                } else {
                u32x4 w; w.x = cvt_pk_bf16(v0[0], v0[1]); w.y = cvt_pk_bf16(v0[2], v0[3]); w.z = cvt_pk_bf16(v1[0], v1[1]); w.w = cvt_pk_bf16(v1[2], v1[3]);
                *(u32x4*)(rowp + bj * 128) = w; } } }
}
struct GInProj {
    static constexpr int NT = DM / 64; static constexpr bool PERM = true, FP8 = false;
    const bf16_t* H; const bf16_t* W; bf16_t* Z; bf16_t* ZC; TwoPart tp; int lda, ldb, dry, kstepA, kstepB;
    __device__ __forceinline__ bool next(int i, Unit& u) const { u.seg = 0; return tp.map(i * tp.G + tp.c, u); }
    __device__ __forceinline__ const char* a_ptr(const Unit& u) const { return (const char*)(H + (size_t)u.pm * 256 * DM); }
    __device__ __forceinline__ const char* b_ptr(const Unit& u) const { return (const char*)(W + (size_t)u.pn * 256 * DM); }
    __device__ __forceinline__ bool keep(const Unit&) const { return false; }
    __device__ __forceinline__ void epi(const f32x4 (&acc)[2][2][4][2], const Unit& u, int wr, int wc, int fr, int fq) const {
        if (PROBE_DUP && dry) return;
        bf16_t* base = (u.pm < PAN_LAT) ? Z + (size_t)(u.pm - tp.lat0) * 256 * INW : ZC + (size_t)(u.pm - PAN_LAT) * 256 * INW;
        epi_z(acc, base, NQKV + u.pn, false, 1.f, wr, wc, fr, fq);
    }
};
struct GGate8 {
    static constexpr int NT = DM / 128; static constexpr bool PERM = true, FP8 = true;
    const unsigned char* H8; const unsigned char* W8; bf16_t* Z; bf16_t* ZC; TwoPart tp; int lda, ldb, dry, kstepA, kstepB;
    int nlo, cbase, span;
    __device__ __forceinline__ bool next(int i, Unit& u) const { u.seg = 0; return tp.map(skew_deal(i, tp.G, tp.c, nlo, cbase, span), u); }
    __device__ __forceinline__ const char* a_ptr(const Unit& u) const { return (const char*)(H8 + (size_t)u.pm * 256 * DM); }
    __device__ __forceinline__ const char* b_ptr(const Unit& u) const { return (const char*)(W8 + (size_t)u.pn * 256 * DM); }
    __device__ __forceinline__ bool keep(const Unit&) const { return false; }
    __device__ __forceinline__ void epi(const f32x4 (&acc)[2][2][4][2], const Unit& u, int wr, int wc, int fr, int fq) const {
        bf16_t* base = (u.pm < PAN_LAT) ? Z + (size_t)(u.pm - tp.lat0) * 256 * INW : ZC + (size_t)(u.pm - PAN_LAT) * 256 * INW;
        if (u.pn < NQKV) epi_z(acc, base, u.pn, false, 1.0f / G8_WSCALE, wr, wc, fr, fq);
        else epi_z(acc, base, u.pn + NCV, true, 1.0f / G8_WSCALE, wr, wc, fr, fq);
    }
};

#define UB0(x) ((float)(((x) >> 0) & 0xffu))
#define UB1(x) ((float)(((x) >> 8) & 0xffu))
#define UB2(x) ((float)(((x) >> 16) & 0xffu))
#define UB3(x) ((float)(((x) >> 24) & 0xffu))
struct GBranch {
    static constexpr int NT = 1024 / 64; static constexpr bool PERM = true, FP8 = false;
    const bf16_t* Z; const bf16_t* ZC; const bf16_t* W; bf16_t* Hout; TwoPart tp; int lda, ldb, dry, kstepA, kstepB;
    __device__ __forceinline__ bool next(int i, Unit& u) const { const int t = i / 3; u.seg = i - 3 * t; return tp.map(t * tp.G + tp.c, u); }
    __device__ __forceinline__ const bf16_t* zrow(const Unit& u) const { return (u.pm < PAN_LAT) ? Z + (size_t)(u.pm - tp.lat0) * 256 * INW : ZC + (size_t)(u.pm - PAN_LAT) * 256 * INW; }
    __device__ __forceinline__ const char* a_ptr(const Unit& u) const { return (const char*)(zrow(u) + (u.seg == 0 ? QA0 : (u.seg == 1 ? QB0 : CB0))); }
    __device__ __forceinline__ const char* b_ptr(const Unit& u) const { return (const char*)(W + (size_t)u.pn * 256 * 3072 + u.seg * 1024); }
    __device__ __forceinline__ bool keep(const Unit& u) const { return u.seg < 2; }
    __device__ __forceinline__ void epi(f32x4 (&acc)[2][2][4][2], const Unit& u, int wr, int wc, int fr, int fq) const {
        if (PROBE_DUP && dry) return;
        const unsigned char* zb = (const unsigned char*)(zrow(u) + G0); const int row0 = wr * 64 + fr, col0 = u.pn * 256 + wc * 32 + 8 * fq;
        const int seg = u.seg;
#pragma unroll
        for (int ai = 0; ai < 2; ++ai)
#pragma unroll
            for (int m = 0; m < 4; ++m) { const unsigned char* zr = zb + (size_t)(row0 + ai * 128 + m * 16) * (INW * 2) + col0;
                if (seg < 2) {
#pragma unroll
                    for (int bj = 0; bj < 2; ++bj) { const u32x2 gp = *(const u32x2*)(zr + seg * 2048 + bj * 128), gn = *(const u32x2*)(zr + (seg + 1) * 2048 + bj * 128);
                        f32x4 r0, r1;
                        r0[0] = UB0(gp.x) * __builtin_amdgcn_rcpf(UB0(gn.x)); r0[1] = UB1(gp.x) * __builtin_amdgcn_rcpf(UB1(gn.x));
                        r0[2] = UB2(gp.x) * __builtin_amdgcn_rcpf(UB2(gn.x)); r0[3] = UB3(gp.x) * __builtin_amdgcn_rcpf(UB3(gn.x));
                        r1[0] = UB0(gp.y) * __builtin_amdgcn_rcpf(UB0(gn.y)); r1[1] = UB1(gp.y) * __builtin_amdgcn_rcpf(UB1(gn.y));
                        r1[2] = UB2(gp.y) * __builtin_amdgcn_rcpf(UB2(gn.y)); r1[3] = UB3(gp.y) * __builtin_amdgcn_rcpf(UB3(gn.y));
                        acc[ai][bj][m][0] *= r0; acc[ai][bj][m][1] *= r1; }
                } else {
                    bf16_t* orow = Hout + (size_t)(u.pm * 256 + row0 + ai * 128 + m * 16) * DM + col0;
#pragma unroll
                    for (int bj = 0; bj < 2; ++bj) { const u32x2 g = *(const u32x2*)(zr + 2 * 2048 + bj * 128);
                        const f32x4 v0 = acc[ai][bj][m][0] * ((f32x4){UB0(g.x), UB1(g.x), UB2(g.x), UB3(g.x)} * (1.0f / 255.f)), v1 = acc[ai][bj][m][1] * ((f32x4){UB0(g.y), UB1(g.y), UB2(g.y), UB3(g.y)} * (1.0f / 255.f));
                        u32x4 w; w.x = cvt_pk_bf16(v0[0], v0[1]); w.y = cvt_pk_bf16(v0[2], v0[3]); w.z = cvt_pk_bf16(v1[0], v1[1]); w.w = cvt_pk_bf16(v1[2], v1[3]);
                        *(u32x4*)(orow + bj * 128) = w; }
                }
                asm volatile("" ::: "memory"); }
    }
};

typedef unsigned short half_t;
template <bool LNRES>
__device__ __forceinline__ void epi_residual(const f32x4 (&acc)[2][2][4][2], const void* res, half_t* out, const float* modv, const float* stats, const float* lg, const float* lb, int pn, int wr, int wc, int fr, int fq) {
    int row0 = wr * 64 + fr, col0 = pn * 256 + wc * 32 + 8 * fq;
    asm volatile("" : "+v"(row0), "+v"(col0));
    f32x4 gv[2][2], gl[2][2], bl[2][2];
#pragma unroll
    for (int bj = 0; bj < 2; ++bj)
#pragma unroll
        for (int n = 0; n < 2; ++n) { gv[bj][n] = *(const f32x4*)(modv + col0 + bj * 128 + n * 4);
            if (LNRES) { gl[bj][n] = *(const f32x4*)(lg + col0 + bj * 128 + n * 4) * DN_ALPHA; bl[bj][n] = *(const f32x4*)(lb + col0 + bj * 128 + n * 4) * DN_ALPHA; } }
#pragma unroll
    for (int ai = 0; ai < 2; ++ai)
#pragma unroll
        for (int m = 0; m < 4; ++m) { const int rr = row0 + ai * 128 + m * 16; const size_t off = (size_t)rr * DM + col0;
            f32x2 st = (f32x2){0.f, 1.f}; if (LNRES) st = *(const f32x2*)(stats + 2 * rr);
#pragma unroll
            for (int bj = 0; bj < 2; ++bj) { f32x4 r0, r1, o0, o1;
                if (LNRES) { un_h8(*(const u32x4*)((const half_t*)res + off + bj * 128), r0, r1);
                    o0 = ((r0 - st.x) * st.y) * gl[bj][0] + bl[bj][0] + gv[bj][0] * acc[ai][bj][m][0]; o1 = ((r1 - st.x) * st.y) * gl[bj][1] + bl[bj][1] + gv[bj][1] * acc[ai][bj][m][1]; }
                else { r0 = *(const f32x4*)((const float*)res + off + bj * 128); r1 = *(const f32x4*)((const float*)res + off + bj * 128 + 4);
                    o0 = r0 * DN_ALPHA + gv[bj][0] * acc[ai][bj][m][0]; o1 = r1 * DN_ALPHA + gv[bj][1] * acc[ai][bj][m][1]; }
                u32x4 w; w.x = pk_h2(o0[0], o0[1]); w.y = pk_h2(o0[2], o0[3]); w.z = pk_h2(o1[0], o1[1]); w.w = pk_h2(o1[2], o1[3]);
                *(u32x4*)(out + off + bj * 128) = w; }
            asm volatile("" ::: "memory"); }
}
struct GRes {
    static constexpr bool PERM = true, FP8 = false;
    const bf16_t* A_lat; const bf16_t* A_ctx;
    int a_lat0; const bf16_t* W; const void* res_lat; const void* res_ctx; half_t* out_lat; half_t* out_ctx; const float* mod; int modj; TwoPart tp; int lda, ldb, dry, kstepA, kstepB;
    int apan;
    const float* stats; const float* lg; const float* lb; int lnres;
    __device__ __forceinline__ bool nextu(int i, Unit& u) const { u.seg = 0; return tp.map(i * tp.G + tp.c, u); }
    __device__ __forceinline__ const char* a_ptr(const Unit& u) const { return (const char*)((u.pm < PAN_LAT) ? A_lat + (size_t)(u.pm - a_lat0) * apan : A_ctx + (size_t)(u.pm - PAN_LAT) * apan); }
    __device__ __forceinline__ const char* b_ptr(const Unit& u) const { return (const char*)(W + (size_t)u.pn * 256 * ldb); }
    __device__ __forceinline__ bool keep(const Unit&) const { return false; }
    __device__ __forceinline__ void epi(const f32x4 (&acc)[2][2][4][2], const Unit& u, int wr, int wc, int fr, int fq) const {
        if (PROBE_DUP && dry) return;
        const bool lat = u.pm < PAN_LAT; const size_t prow = (size_t)(lat ? u.pm : u.pm - PAN_LAT) * 256;
        half_t* o = (lat ? out_lat : out_ctx) + prow * DM;
        const float* mv = mod + (size_t)(lat ? (u.pm >> 3) : 16) * MODW + modj * DM; const float* st = stats + (size_t)u.pm * 256 * 2;
        if (lnres) epi_residual<true>(acc, (const half_t*)(lat ? res_lat : res_ctx) + prow * DM, o, mv, st, lg, lb, u.pn, wr, wc, fr, fq);
        else epi_residual<false>(acc, (const float*)(lat ? res_lat : res_ctx) + prow * DM, o, mv, st, lg, lb, u.pn, wr, wc, fr, fq);
    }
};
struct GWo : GRes { static constexpr int NT = DM / 64; __device__ __forceinline__ bool next(int i, Unit& u) const { return nextu(i, u); } };
struct GDown : GRes { static constexpr int NT = HID / 64; __device__ __forceinline__ bool next(int i, Unit& u) const { return nextu(i, u); } };

struct GUp {
    static constexpr int NT = DM / 64; static constexpr bool PERM = true, FP8 = false;
    const bf16_t* H; const bf16_t* W; bf16_t* U; TwoPart tp; int lda, ldb, dry, kstepA, kstepB; int nlo, cbase, span;
    __device__ __forceinline__ bool next(int i, Unit& u) const { u.seg = 0; return tp.map(skew_deal(i, tp.G, tp.c, nlo, cbase, span), u); }
    __device__ __forceinline__ const char* a_ptr(const Unit& u) const { return (const char*)(H + (size_t)u.pm * 256 * DM); }
    __device__ __forceinline__ const char* b_ptr(const Unit& u) const { return (const char*)(W + (size_t)u.pn * 256 * DM); }
    __device__ __forceinline__ bool keep(const Unit&) const { return false; }
    __device__ __forceinline__ void epi(const f32x4 (&acc)[2][2][4][2], const Unit& u, int wr, int wc, int fr, int fq) const {
        if (PROBE_DUP && dry) return;
        bf16_t* base = U + (size_t)((u.pm < PAN_LAT) ? (u.pm - tp.lat0) : (PAN_CH + u.pm - PAN_LAT)) * 256 * HID;
        const int row0 = wr * 64 + fr, col0 = u.pn * 256 + wc * 32 + 8 * fq;
#pragma unroll
        for (int ai = 0; ai < 2; ++ai)
#pragma unroll
            for (int m = 0; m < 4; ++m) { bf16_t* rowp = base + (size_t)(col0 >> 6) * (256 * 64) + (size_t)(row0 + ai * 128 + m * 16) * 64 + (col0 & 63);
#pragma unroll
                for (int bj = 0; bj < 2; ++bj) { f32x4 v0 = acc[ai][bj][m][0], v1 = acc[ai][bj][m][1];
                    v0 = __builtin_elementwise_max(v0, (f32x4){0.f, 0.f, 0.f, 0.f}); v1 = __builtin_elementwise_max(v1, (f32x4){0.f, 0.f, 0.f, 0.f}); v0 = v0 * v0; v1 = v1 * v1;
                    u32x4 w; w.x = cvt_pk_bf16(v0[0], v0[1]); w.y = cvt_pk_bf16(v0[2], v0[3]); w.z = cvt_pk_bf16(v1[0], v1[1]); w.w = cvt_pk_bf16(v1[2], v1[3]);
                    *(u32x4*)(rowp + bj * 2 * (256 * 64)) = w; } }
    }
};

namespace att {
constexpr int NW = 8, QBLK = 32, KVBLK = 64, LDZ = INW;
constexpr float SCALE = ATT_SCALE, THR = 8.f, NEG = -1e30f;
constexpr int SHM_V = 16384, SHM_K = 16384, OFF_WS = 65536, OFF_TAB = OFF_WS + 2048, LDS_ATTN = OFF_TAB + 15 * 512;
static_assert(LDS_ATTN <= SCR_BYTES, "attention LDS");
struct AUnit { const bf16_t* Q; const bf16_t* P0; const bf16_t* P1; int nfirst, NT, vofs; int r0, lo; const float* rpb; int dry; const float* qgain; const float* ropec; int pos0; };
#define KSWZ(row, colB) ((row) * 256 + ((colB) ^ (((row) & 7) << 4)))
#define SBAR() __builtin_amdgcn_sched_barrier(0)
__device__ __forceinline__ int crow(int r, int hi) { return (r & 3) + 8 * (r >> 2) + 4 * hi; }
__device__ __forceinline__ void partialSM(f32x16& p0, f32x16& p1, float& m_reg, float& mn, float& alpha) {
  constexpr float C = SCALE * 1.4426950408889634f;
  float pmax = p0[0];
#pragma unroll
  for (int r = 1; r < 16; ++r) pmax = fmaxf(pmax, p0[r]);
#pragma unroll
  for (int r = 0; r < 16; ++r) pmax = fmaxf(pmax, p1[r]);
  { auto rr = __builtin_amdgcn_permlane32_swap(__float_as_uint(pmax), __float_as_uint(pmax), false, false);
    pmax = fmaxf(__uint_as_float(rr[0]), __uint_as_float(rr[1])); }
  if (__builtin_expect(__all(pmax - m_reg <= THR / SCALE), 1)) { mn = m_reg; alpha = 1.f; }
  else { mn = fmaxf(m_reg, pmax); alpha = __builtin_amdgcn_exp2f((m_reg - mn) * C); m_reg = mn; }
  float mnC = -mn * C;
#pragma unroll
  for (int r = 0; r < 16; ++r) p0[r] = fmaf(p0[r], C, mnC);
#pragma unroll
  for (int r = 0; r < 16; ++r) p1[r] = fmaf(p1[r], C, mnC);
#pragma unroll
  for (int r = 0; r < 16; ++r) p0[r] = __builtin_amdgcn_exp2f(p0[r]);
}
__device__ __forceinline__ void finishSM(f32x16& p0, f32x16& p1, float alpha, float& l_reg, bf16x8& pa0, bf16x8& pa1, bf16x8& pa2, bf16x8& pa3) {
#pragma unroll
  for (int r = 0; r < 16; ++r) p1[r] = __builtin_amdgcn_exp2f(p1[r]);
  float ps = 0;
#pragma unroll
  for (int r = 0; r < 16; ++r) ps += p0[r];
#pragma unroll
  for (int r = 0; r < 16; ++r) ps += p1[r];
  { auto rr = __builtin_amdgcn_permlane32_swap(__float_as_uint(ps), __float_as_uint(ps), false, false);
    ps = __uint_as_float(rr[0]) + __uint_as_float(rr[1]); }
  l_reg = l_reg * alpha + ps;
#define PK4(P, BASE, OUT) do { unsigned a0 = cvt_pk_bf16(P[BASE + 0], P[BASE + 1]), a1 = cvt_pk_bf16(P[BASE + 2], P[BASE + 3]);   \
    unsigned b0 = cvt_pk_bf16(P[BASE + 4], P[BASE + 5]), b1 = cvt_pk_bf16(P[BASE + 6], P[BASE + 7]);                              \
    auto r0 = __builtin_amdgcn_permlane32_swap(a0, b0, false, false); auto r1 = __builtin_amdgcn_permlane32_swap(a1, b1, false, false); \
    u32x4 w = {r0[0], r1[0], r0[1], r1[1]}; OUT = *reinterpret_cast<bf16x8*>(&w); } while (0)
  PK4(p0, 0, pa0); PK4(p0, 8, pa1); PK4(p1, 0, pa2); PK4(p1, 8, pa3);
#undef PK4
}
__device__ __forceinline__ void qkt(f32x16& p0, f32x16& p1, const char* Ks, const bf16x8* qr, int r32, int hi) {
  p0 = f32x16{}; p1 = f32x16{};
#pragma unroll
  for (int d0 = 0; d0 < 8; ++d0) { int cb = (d0 * 16 + hi * 8) * 2;
    bf16x8 b0 = *reinterpret_cast<const bf16x8*>(Ks + KSWZ(r32, cb));
    bf16x8 b1 = *reinterpret_cast<const bf16x8*>(Ks + KSWZ(32 + r32, cb));
    p0 = __builtin_amdgcn_mfma_f32_32x32x16_bf16(b0, qr[d0], p0, 0, 0, 0);
    p1 = __builtin_amdgcn_mfma_f32_32x32x16_bf16(b1, qr[d0], p1, 0, 0, 0); }
}
__device__ __forceinline__ int v_st(int k, int c) { const int kk = (k & ~0xC) | ((k & 4) << 1) | ((k & 8) >> 1); return ((kk >> 3) * 4 + (c >> 5)) * 512 + ((kk & 7) * 32 + (c & 31)) * 2; }
__device__ __forceinline__ int v_rd_base(int lane) { return ((lane & 3) << 3) | (((lane >> 2) & 3) << 6) | (((lane >> 4) & 1) << 5) | (((lane >> 5) & 1) << 8); }
constexpr int v_rd_off(int d0, int ks, int half) { return d0 * 512 + ks * 4096 + half * 2048; }
template <int OFF> __device__ __forceinline__ s16x4 tr_read(int vb) {
  s16x4 r; asm volatile("ds_read_b64_tr_b16 %0, %1 offset:%2" : "=&v"(r) : "v"(vb), "i"(OFF) : "memory"); return r;
}
template <int D0> __device__ __forceinline__ void pv_one(f32x16& od, int vb, bf16x8 pa0, bf16x8 pa1, bf16x8 pa2, bf16x8 pa3) {
  const s16x4 l0 = tr_read<v_rd_off(D0, 0, 0)>(vb), h0 = tr_read<v_rd_off(D0, 0, 1)>(vb), l1 = tr_read<v_rd_off(D0, 1, 0)>(vb), h1 = tr_read<v_rd_off(D0, 1, 1)>(vb);
  const s16x4 l2 = tr_read<v_rd_off(D0, 2, 0)>(vb), h2 = tr_read<v_rd_off(D0, 2, 1)>(vb), l3 = tr_read<v_rd_off(D0, 3, 0)>(vb), h3 = tr_read<v_rd_off(D0, 3, 1)>(vb);
  asm volatile("s_waitcnt lgkmcnt(0)" ::: "memory"); SBAR();
#define PK(L, H) (bf16x8){L[0], L[1], L[2], L[3], H[0], H[1], H[2], H[3]}
  od = __builtin_amdgcn_mfma_f32_32x32x16_bf16(pa0, PK(l0, h0), od, 0, 0, 0);
  od = __builtin_amdgcn_mfma_f32_32x32x16_bf16(pa1, PK(l1, h1), od, 0, 0, 0);
  od = __builtin_amdgcn_mfma_f32_32x32x16_bf16(pa2, PK(l2, h2), od, 0, 0, 0);
  od = __builtin_amdgcn_mfma_f32_32x32x16_bf16(pa3, PK(l3, h3), od, 0, 0, 0);
#undef PK
}
__device__ __forceinline__ void pv_d0(f32x16* o, int vb, bf16x8 pa0, bf16x8 pa1, bf16x8 pa2, bf16x8 pa3) {
  pv_one<0>(o[0], vb, pa0, pa1, pa2, pa3); pv_one<1>(o[1], vb, pa0, pa1, pa2, pa3); pv_one<2>(o[2], vb, pa0, pa1, pa2, pa3); pv_one<3>(o[3], vb, pa0, pa1, pa2, pa3);
}
__device__ __forceinline__ void na_fix(f32x16& p0, f32x16& p1, int j, int lo, int qrow, int rsq, const float* tabl  , int cs4  ) {
  if (j < 4) return;
  const int kr = lo + (j - 4);
  if (kr < rsq || kr >= rsq + 8) {
#pragma unroll
    for (int r = 0; r < 16; ++r) { p0[r] = NEG; p1[r] = NEG; }
    return;
  }
  const float* tb = tabl + (kr - qrow + 7) * 128;
#pragma unroll
  for (int r = 0; r < 16; ++r) { const int kcc = (r & 3) + 8 * (r >> 2);
    const float b0 = tb[kcc], b1 = tb[kcc + 32];
    p0[r] = ((unsigned)(kcc - cs4) < 16u) ? p0[r] + b0 : NEG; p1[r] = ((unsigned)(kcc + 32 - cs4) < 16u) ? p1[r] + b1 : NEG; }
}

__device__ __forceinline__ void q_norm_rope(bf16x8 (&qr)[8], const float* gain, const float* ropec, int pos, int hi) {
  float ss = 0.f;
#pragma unroll
  for (int d0 = 0; d0 < 8; ++d0) { const u32x4 w = __builtin_bit_cast(u32x4, qr[d0]);
    ss += bflo(w.x) * bflo(w.x) + bfhi(w.x) * bfhi(w.x) + bflo(w.y) * bflo(w.y) + bfhi(w.y) * bfhi(w.y) + bflo(w.z) * bflo(w.z) + bfhi(w.z) * bfhi(w.z) + bflo(w.w) * bflo(w.w) + bfhi(w.w) * bfhi(w.w); }
  { auto rr = __builtin_amdgcn_permlane32_swap(__float_as_uint(ss), __float_as_uint(ss), false, false); ss = __uint_as_float(rr[0]) + __uint_as_float(rr[1]); }
  const float rinv = 1.0f / sqrtf(ss * (1.f / 128.f) + LN_EPS);
#pragma unroll
  for (int p = 0; p < 4; ++p) { const int a = (p & 1) + 4 * (p >> 1), b = a + 2, da = a * 16 + hi * 8;
    const f32x4 ga0 = *(const f32x4*)(gain + da), ga1 = *(const f32x4*)(gain + da + 4), gb0 = *(const f32x4*)(gain + da + 32), gb1 = *(const f32x4*)(gain + da + 36);
    f32x4 c0 = {1.f, 1.f, 1.f, 1.f}, c1 = c0, s0 = {0.f, 0.f, 0.f, 0.f}, s1 = s0;
    if (ropec) { const float* tc = ropec + ((a >= 4) ? 32 + (pos & 63) : (pos >> 6)) * 32 + (da & 31); c0 = *(const f32x4*)tc; c1 = *(const f32x4*)(tc + 4); s0 = *(const f32x4*)(tc + 96 * 32); s1 = *(const f32x4*)(tc + 96 * 32 + 4); }
    const u32x4 wa = __builtin_bit_cast(u32x4, qr[a]), wb = __builtin_bit_cast(u32x4, qr[b]);
    f32x4 xa0 = (f32x4){bflo(wa.x), bfhi(wa.x), bflo(wa.y), bfhi(wa.y)} * rinv * ga0, xa1 = (f32x4){bflo(wa.z), bfhi(wa.z), bflo(wa.w), bfhi(wa.w)} * rinv * ga1;
    f32x4 xb0 = (f32x4){bflo(wb.x), bfhi(wb.x), bflo(wb.y), bfhi(wb.y)} * rinv * gb0, xb1 = (f32x4){bflo(wb.z), bfhi(wb.z), bflo(wb.w), bfhi(wb.w)} * rinv * gb1;
    const f32x4 ya0 = xa0 * c0 - xb0 * s0, ya1 = xa1 * c1 - xb1 * s1, yb0 = xb0 * c0 + xa0 * s0, yb1 = xb1 * c1 + xa1 * s1;
    u32x4 oa, ob; oa.x = cvt_pk_bf16(ya0[0], ya0[1]); oa.y = cvt_pk_bf16(ya0[2], ya0[3]); oa.z = cvt_pk_bf16(ya1[0], ya1[1]); oa.w = cvt_pk_bf16(ya1[2], ya1[3]);
    ob.x = cvt_pk_bf16(yb0[0], yb0[1]); ob.y = cvt_pk_bf16(yb0[2], yb0[3]); ob.z = cvt_pk_bf16(yb1[0], yb1[1]); ob.w = cvt_pk_bf16(yb1[2], yb1[3]);
    qr[a] = __builtin_bit_cast(bf16x8, oa); qr[b] = __builtin_bit_cast(bf16x8, ob); }
}
template <bool NA>
__device__ __forceinline__ void attn_unit(const AUnit& U, char* lds, LAS unsigned char* ldl, int tid) {
  asm volatile("" : "+v"(tid));
  const int wid = tid >> 6, lane = tid & 63, r32 = lane & 31, hi = lane >> 5;
  char* V_lds = lds; char* K_lds = lds + 2 * SHM_V;
  float* ws = (float*)(lds + OFF_WS) + wid * 64; float* li_l = ws; float* al_l = ws + 32;
  float* tab = (float*)(lds + OFF_TAB);
  float m_reg = NEG, l_reg = 0; f32x16 o[4] = {}; bf16x8 qr[8];
  const bf16_t* Qw = U.Q + (size_t)(wid * QBLK + r32) * LDZ + hi * 8;
#pragma unroll
  for (int d0 = 0; d0 < 8; ++d0) qr[d0] = *reinterpret_cast<const bf16x8*>(Qw + d0 * 16);
  if constexpr (!NA) { if (U.qgain) q_norm_rope(qr, U.qgain, U.ropec, U.pos0 + wid * QBLK + r32, hi); }
  int qrow = 0, rsq = 0, cs4 = 0; const float* tabl = tab;
  if constexpr (NA) {
    const int wu = __builtin_amdgcn_readfirstlane(wid);
    qrow = U.r0 + (wu >> 1); rsq = min(max(qrow - 4, 0), 24);
    const int qc = (wu & 1) * 32 + r32, cs = min(max(qc - 8, 0), 48);
    cs4 = cs - 4 * hi;
    tabl = tab + (4 * hi - qc + 64);
    for (int e = tid; e < 15 * 128; e += 512) { const int dri = e >> 7, dc = (e & 127) - 64; tab[e] = (dc >= -15 && dc <= 15) ? U.rpb[dri * 31 + dc + 15] * (1.0f / SCALE) : 0.f; }
  }
  const int vb0 = (int)(uintptr_t)V_lds + v_rd_base(lane);
  const int wq = __builtin_amdgcn_readfirstlane(wid);
  int kof[2], vof[2];
#pragma unroll
  for (int i = 0; i < 2; ++i) { const int row = wq * 8 + i * 4 + (lane >> 4); kof[i] = row * LDZ + (((lane & 15) ^ (row & 7)) << 3);
    const int sl = (wq * 2 + i) * 64 + lane, blk = sl >> 5, kk = ((blk >> 2) << 3) | ((sl >> 2) & 7), k = (kk & ~0xC) | ((kk & 4) << 1) | ((kk & 8) >> 1), c = ((blk & 3) << 5) | ((sl & 3) << 3);
    vof[i] = k * LDZ + c + U.vofs; }
  const int nfirst = U.nfirst; const bf16_t* P0 = U.P0; const bf16_t* P1 = U.P1;
  LAS unsigned char* const lV = ldl + wq * 2048; LAS unsigned char* const lK = ldl + 2 * SHM_V + wq * 2048;
#define TILEB(j) ((j) < nfirst ? P0 + (size_t)(j) * 64 * LDZ : P1 + (size_t)((j) - nfirst) * 64 * LDZ)
#define DMA_K(b, j) do { const bf16_t* tp_ = TILEB(j); _Pragma("unroll") for (int i_ = 0; i_ < 2; ++i_) \
    __builtin_amdgcn_global_load_lds((const unsigned*)(tp_ + kof[i_]), (LAS unsigned*)(lK + (b) * SHM_K + i_ * 1024), 16, 0, 0); } while (0)
#define DMA_V(b, j) do { const bf16_t* tp_ = TILEB(j); _Pragma("unroll") for (int i_ = 0; i_ < 2; ++i_) \
    __builtin_amdgcn_global_load_lds((const unsigned*)(tp_ + vof[i_]), (LAS unsigned*)(lV + (b) * SHM_V + i_ * 1024), 16, 0, 0); } while (0)
#define STEP_END() do { asm volatile("s_waitcnt vmcnt(0)" ::: "memory"); __syncthreads(); } while (0)
#define RESC(a) do { if (__any((a) < 1.f)) { if (hi == 0) al_l[r32] = (a); asm volatile("s_waitcnt lgkmcnt(0)" ::: "memory"); \
    _Pragma("unroll") for (int d = 0; d < 4; ++d) _Pragma("unroll") for (int r = 0; r < 16; ++r) o[d][r] *= al_l[crow(r, hi)]; } } while (0)
#define NAFIX(PA, PB, j) do { if constexpr (NA) na_fix(PA, PB, (j), U.lo, qrow, rsq, tabl, cs4); } while (0)
  f32x16 pA0, pA1, pB0, pB1; float mnA, mnB, alA, alB; bf16x8 pa0, pa1, pa2, pa3; const int NT = U.NT;
  DMA_K(0, 0); STEP_END();
  DMA_K(1, 1); DMA_V(0, 0); SBAR();
  qkt(pA0, pA1, K_lds, qr, r32, hi); NAFIX(pA0, pA1, 0); partialSM(pA0, pA1, m_reg, mnA, alA);
  STEP_END();
  for (int j = 1; j + 1 < NT; j += 2) {
    DMA_K(0, j + 1); DMA_V(1, j);
    SBAR(); qkt(pB0, pB1, K_lds + SHM_K, qr, r32, hi);
    finishSM(pA0, pA1, alA, l_reg, pa0, pa1, pa2, pa3); SBAR();
    pv_d0(o, vb0, pa0, pa1, pa2, pa3); NAFIX(pB0, pB1, j); partialSM(pB0, pB1, m_reg, mnB, alB);
    RESC(alB); STEP_END();
    if (j + 2 < NT) DMA_K(1, j + 2);
    DMA_V(0, j + 1);
    SBAR(); qkt(pA0, pA1, K_lds, qr, r32, hi);
    finishSM(pB0, pB1, alB, l_reg, pa0, pa1, pa2, pa3); SBAR();
    pv_d0(o, vb0 + SHM_V, pa0, pa1, pa2, pa3); NAFIX(pA0, pA1, j + 1); partialSM(pA0, pA1, m_reg, mnA, alA);
    RESC(alA); STEP_END();
  }
  DMA_V(1, NT - 1);
  SBAR(); qkt(pB0, pB1, K_lds + SHM_K, qr, r32, hi);
  finishSM(pA0, pA1, alA, l_reg, pa0, pa1, pa2, pa3); SBAR();
  pv_d0(o, vb0, pa0, pa1, pa2, pa3); NAFIX(pB0, pB1, NT - 1); partialSM(pB0, pB1, m_reg, mnB, alB);
  RESC(alB); STEP_END();
  finishSM(pB0, pB1, alB, l_reg, pa0, pa1, pa2, pa3); SBAR();
  pv_d0(o, vb0 + SHM_V, pa0, pa1, pa2, pa3);
  if (hi == 0) li_l[r32] = l_reg; asm volatile("s_waitcnt lgkmcnt(0)" ::: "memory");
  float rli[16];
#pragma unroll
  for (int r = 0; r < 16; ++r) rli[r] = __builtin_amdgcn_rcpf(li_l[crow(r, hi)]);
  __syncthreads();
  bf16_t* ost = (bf16_t*)(lds + wid * 8192);
#pragma unroll
  for (int r = 0; r < 16; ++r) { const int orow = crow(r, hi);
#pragma unroll
    for (int d0 = 0; d0 < 4; ++d0) { const unsigned w = cvt_pk_bf16(o[d0][r] * rli[r], 0.f); ost[orow * 128 + d0 * 32 + r32] = (bf16_t)(w & 0xffffu); } }
  asm volatile("s_waitcnt lgkmcnt(0)" ::: "memory");
  bf16_t* Ow = (bf16_t*)U.Q + (size_t)(wid * QBLK) * LDZ;
  if (!(PROBE_DUP && U.dry)) {
#pragma unroll
  for (int i = 0; i < 8; ++i) { const int id = i * 64 + lane, row = id >> 4, c16 = id & 15;
    *(u32x4*)(Ow + (size_t)row * LDZ + c16 * 8) = *(const u32x4*)(ost + row * 128 + c16 * 8); } }
  __syncthreads();
#undef TILEB
#undef DMA_K
#undef DMA_V
#undef STEP_END
#undef RESC
#undef NAFIX
}
}

struct Args { const float* in[17]; float* out; unsigned char* ws; int ph_lo, ph_hi; };
static_assert(sizeof(Args) == 17 * 8 + 8 + 8 + 8, "Args has no padding");


__device__ __forceinline__ void transpose_item(const float* W, int N, bf16_t* WT, int ldt, LAS float* scr, int kb, int nb, int lane) {
    const int k0 = 64 * kb, n0 = 32 * nb;
#pragma unroll 8
    for (int i = 0; i < 32; ++i) { const int kk = 2 * i + (lane >> 5); scr[kk * 33 + (lane & 31)] = W[(size_t)(k0 + kk) * N + n0 + (lane & 31)]; }
    LDS_WAIT(); asm volatile("" ::: "memory");
    const int c = lane & 7;
#pragma unroll
    for (int j = 0; j < 4; ++j) { const int n = (lane >> 3) + 8 * j; const LAS float* s = scr + (8 * c) * 33 + n;
        u32x4 o; o.x = cvt_pk_bf16(s[0 * 33], s[1 * 33]); o.y = cvt_pk_bf16(s[2 * 33], s[3 * 33]); o.z = cvt_pk_bf16(s[4 * 33], s[5 * 33]); o.w = cvt_pk_bf16(s[6 * 33], s[7 * 33]);
        *(u32x4*)(WT + (size_t)(n0 + n) * ldt + k0 + 8 * c) = o; }
    LDS_WAIT(); asm volatile("" ::: "memory");
}
__device__ __forceinline__ void transpose_item8(const float* W, int N, unsigned char* WT8, int ldt, LAS float* scr, int kb, int nb, int nrow0, int lane) {
    const int k0 = 64 * kb, n0 = 32 * nb;
#pragma unroll 8
    for (int i = 0; i < 32; ++i) { const int kk = 2 * i + (lane >> 5); scr[kk * 33 + (lane & 31)] = W[(size_t)(k0 + kk) * N + n0 + (lane & 31)]; }
    LDS_WAIT(); asm volatile("" ::: "memory");
    const int c = lane & 7;
#pragma unroll
    for (int j = 0; j < 4; ++j) { const int n = (lane >> 3) + 8 * j; const LAS float* s = scr + (8 * c) * 33 + n;
        u32x2 o; o.x = pk_fp8x4(s[0 * 33] * G8_WSCALE, s[1 * 33] * G8_WSCALE, s[2 * 33] * G8_WSCALE, s[3 * 33] * G8_WSCALE); o.y = pk_fp8x4(s[4 * 33] * G8_WSCALE, s[5 * 33] * G8_WSCALE, s[6 * 33] * G8_WSCALE, s[7 * 33] * G8_WSCALE);
        *(u32x2*)(WT8 + (size_t)(n0 - nrow0 + n) * ldt + k0 + 8 * c) = o; }
    LDS_WAIT(); asm volatile("" ::: "memory");
}

__device__ __forceinline__ void row_stats(const f32x4 (&v)[8], float& mean, float& rstd, int lane) {
    float s = 0.f;
#pragma unroll
    for (int j = 0; j < 8; ++j) s += (v[j].x + v[j].y) + (v[j].z + v[j].w);
    mean = wave_sum(s, lane) * (1.f / DM); float s2 = 0.f;
#pragma unroll
    for (int j = 0; j < 8; ++j) { const f32x4 d = v[j] - mean; s2 += (d.x * d.x + d.y * d.y) + (d.z * d.z + d.w * d.w); }
    rstd = 1.0f / sqrtf(wave_sum(s2, lane) * (1.f / DM) + LN_EPS);
}
struct LnArgs { int nrows; const void* src_lat; const void* src_ctx; float* dst_lat; float* dst_ctx; bf16_t* H; unsigned char* H8; float* stats; const float* g; const float* b; const float* modl; int shift_j, scale_j; };
template <int MODE>
__device__ __forceinline__ void ln_load(const LnArgs& a, int m, f32x4 (&v)[8], int lane) {
    if (MODE == 0) {
        const f32x4* sp = (const f32x4*)(m < NLAT ? (const float*)a.src_lat + (size_t)m * DM : (const float*)a.src_ctx + (size_t)(m - NLAT) * DM) + 2 * lane;
#pragma unroll
        for (int j = 0; j < 4; ++j) { v[2 * j] = sp[128 * j]; v[2 * j + 1] = sp[128 * j + 1]; }
    } else {
        const u32x4* sp = (const u32x4*)(m < NLAT ? (const half_t*)a.src_lat + (size_t)m * DM : (const half_t*)a.src_ctx + (size_t)(m - NLAT) * DM) + lane;
#pragma unroll
        for (int j = 0; j < 4; ++j) v[2 * j] = __builtin_bit_cast(f32x4, sp[64 * j]);
    }
}
template <int MODE>
__device__ __forceinline__ void ln_unpack(f32x4 (&v)[8]) {
    if (MODE != 0) {
#pragma unroll
        for (int j = 0; j < 4; ++j) { const u32x4 w = __builtin_bit_cast(u32x4, v[2 * j]); un_h8(w, v[2 * j], v[2 * j + 1]); }
    }
}
struct LnVecs { f32x4 gg[8], bb[8], sc[8], sh[8]; };
template <int MODE>
__device__ __forceinline__ void ln_process(const LnArgs& a, int m, f32x4 (&v)[8], const LnVecs& V, int lane) {
    const bool lat = m < NLAT;
    ln_unpack<MODE>(v);
    float mean, rstd; row_stats(v, mean, rstd, lane);
    if (MODE >= 1) {
        if (MODE == 1 && lane == 0) *(f32x2*)(a.stats + 2 * (size_t)m) = (f32x2){mean, rstd};
        f32x4* dp = (f32x4*)(lat ? a.dst_lat + (size_t)m * DM : a.dst_ctx + (size_t)(m - NLAT) * DM) + 2 * lane;
#pragma unroll
        for (int j = 0; j < 4; ++j)
#pragma unroll
            for (int e = 0; e < 2; ++e) { v[2 * j + e] = (v[2 * j + e] - mean) * rstd * V.gg[2 * j + e] + V.bb[2 * j + e]; if (MODE == 2) dp[128 * j + e] = v[2 * j + e]; }
        if (MODE == 1) row_stats(v, mean, rstd, lane);
    }
    if (MODE <= 1) {
        u32x4* hp = (u32x4*)(a.H + (size_t)m * DM) + lane;
#pragma unroll
        for (int j = 0; j < 4; ++j) { const f32x4 h0 = (v[2 * j] - mean) * rstd * V.sc[2 * j] + V.sh[2 * j], h1 = (v[2 * j + 1] - mean) * rstd * V.sc[2 * j + 1] + V.sh[2 * j + 1];
            u32x4 o; o.x = cvt_pk_bf16(h0.x, h0.y); o.y = cvt_pk_bf16(h0.z, h0.w); o.z = cvt_pk_bf16(h1.x, h1.y); o.w = cvt_pk_bf16(h1.z, h1.w); hp[64 * j] = o;
            if (a.H8) { u32x2 o8; o8.x = pk_fp8x4(h0.x, h0.y, h0.z, h0.w); o8.y = pk_fp8x4(h1.x, h1.y, h1.z, h1.w); ((u32x2*)(a.H8 + (size_t)m * DM))[lane + 64 * j] = o8; } }
    }
}
__device__ __forceinline__ void ln_modvecs(const LnArgs& a, int bi, LnVecs& V, int lane) {
    const float* md = a.modl + (size_t)bi * MODW; const f32x4* scp = (const f32x4*)(md + a.scale_j * DM) + 2 * lane; const f32x4* shp = (const f32x4*)(md + a.shift_j * DM) + 2 * lane;
#pragma unroll
    for (int j = 0; j < 4; ++j)
#pragma unroll
        for (int e = 0; e < 2; ++e) { V.sc[2 * j + e] = scp[128 * j + e] + 1.0f; V.sh[2 * j + e] = shp[128 * j + e]; }
}
template <int MODE>
__device__ __forceinline__ void ln_block(const LnArgs& a, int m0, int R, int bi, int lane) {
    LnVecs V;
    if (MODE >= 1) { const f32x4* gp = (const f32x4*)a.g + 2 * lane; const f32x4* bp = (const f32x4*)a.b + 2 * lane;
#pragma unroll
        for (int j = 0; j < 4; ++j)
#pragma unroll
            for (int e = 0; e < 2; ++e) { V.gg[2 * j + e] = gp[128 * j + e]; V.bb[2 * j + e] = bp[128 * j + e]; } }
    if (MODE <= 1) ln_modvecs(a, bi, V, lane);
    if constexpr (MODE != 2) {
    f32x4 va[8], vb[8];
    ln_load<MODE>(a, m0, va, lane);
    for (int k = 0; k + 2 < R; k += 2) {
        ln_load<MODE>(a, m0 + k + 1, vb, lane);
        asm volatile("" ::: "memory");
        ln_process<MODE>(a, m0 + k, va, V, lane);
        ln_load<MODE>(a, m0 + k + 2, va, lane);
        asm volatile("" ::: "memory");
        ln_process<MODE>(a, m0 + k + 1, vb, V, lane);
    }
    ln_load<MODE>(a, m0 + R - 1, vb, lane);
    asm volatile("" ::: "memory");
    ln_process<MODE>(a, m0 + R - 2, va, V, lane);
    ln_process<MODE>(a, m0 + R - 1, vb, V, lane);
    } else {
    f32x4 va[8], vb[8], vc[8];
    ln_load<MODE>(a, m0, va, lane); ln_load<MODE>(a, m0 + 1, vb, lane);
    int k = 0;
    for (; k + 5 <= R; k += 3) {
        ln_load<MODE>(a, m0 + k + 2, vc, lane);
        asm volatile("" ::: "memory");
        ln_process<MODE>(a, m0 + k, va, V, lane);
        ln_load<MODE>(a, m0 + k + 3, va, lane);
        asm volatile("" ::: "memory");
        ln_process<MODE>(a, m0 + k + 1, vb, V, lane);
        ln_load<MODE>(a, m0 + k + 4, vb, lane);
        asm volatile("" ::: "memory");
        ln_process<MODE>(a, m0 + k + 2, vc, V, lane);
    }
    const int rem = R - k;
    if (rem >= 3) ln_load<MODE>(a, m0 + k + 2, vc, lane);
    asm volatile("" ::: "memory");
    ln_process<MODE>(a, m0 + k, va, V, lane);
    if (rem >= 4) ln_load<MODE>(a, m0 + k + 3, va, lane);
    asm volatile("" ::: "memory");
    ln_process<MODE>(a, m0 + k + 1, vb, V, lane);
    if (rem >= 3) ln_process<MODE>(a, m0 + k + 2, vc, V, lane);
    if (rem >= 4) ln_process<MODE>(a, m0 + k + 3, va, V, lane);
    }
}
template <int MODE>
__device__ __forceinline__ void ln_phase(const LnArgs& a, int gw, int NGW, int lane) {
    const int Rl = NLAT / NGW, Rc = NCTX / NGW;
    if (Rl * NGW == NLAT && (Rl & 1) == 0 && Rl >= 2 && SEQ % Rl == 0 && Rc * NGW == NCTX && (Rc & 1) == 0 && Rc >= 2) {
        ln_block<MODE>(a, gw * Rl, Rl, (gw * Rl) >> 11, lane);
        if (a.nrows > NLAT) ln_block<MODE>(a, NLAT + gw * Rc, Rc, 16, lane);
    } else {
        for (int m = gw; m < a.nrows; m += NGW) { LnVecs V; const int bi = (m < NLAT) ? (m >> 11) : 16;
            if (MODE >= 1) { const f32x4* gp = (const f32x4*)a.g + 2 * lane; const f32x4* bp = (const f32x4*)a.b + 2 * lane;
#pragma unroll
                for (int j = 0; j < 8; ++j) { V.gg[j] = gp[128 * (j >> 1) + (j & 1)]; V.bb[j] = bp[128 * (j >> 1) + (j & 1)]; } }
            if (MODE <= 1) ln_modvecs(a, bi, V, lane);
            f32x4 v[8]; ln_load<MODE>(a, m, v, lane); ln_process<MODE>(a, m, v, V, lane); }
    }
}

struct Raw16 { u32x4 a, b; };
__device__ __forceinline__ Raw16 ldraw(const bf16_t* p) { Raw16 r; r.a = *(const u32x4*)p; r.b = *(const u32x4*)(p + 8); return r; }
__device__ __forceinline__ void dec16(const Raw16& r, float (&v)[16]) {
    v[0] = bflo(r.a.x); v[1] = bfhi(r.a.x); v[2] = bflo(r.a.y); v[3] = bfhi(r.a.y); v[4] = bflo(r.a.z); v[5] = bfhi(r.a.z); v[6] = bflo(r.a.w); v[7] = bfhi(r.a.w);
    v[8] = bflo(r.b.x); v[9] = bfhi(r.b.x); v[10] = bflo(r.b.y); v[11] = bfhi(r.b.y); v[12] = bflo(r.b.z); v[13] = bfhi(r.b.z); v[14] = bflo(r.b.w); v[15] = bfhi(r.b.w);
}
__device__ __forceinline__ void store16(bf16_t* p, const float (&v)[16]) {
    u32x4 a, b; a.x = cvt_pk_bf16(v[0], v[1]); a.y = cvt_pk_bf16(v[2], v[3]); a.z = cvt_pk_bf16(v[4], v[5]); a.w = cvt_pk_bf16(v[6], v[7]);
    b.x = cvt_pk_bf16(v[8], v[9]); b.y = cvt_pk_bf16(v[10], v[11]); b.z = cvt_pk_bf16(v[12], v[13]); b.w = cvt_pk_bf16(v[14], v[15]);
    *(u32x4*)p = a; *(u32x4*)(p + 8) = b;
}
__device__ __forceinline__ void qk_norm_rope(const Raw16& raw, bf16_t* p, const float* gain, const float* ropec, const float* ropes, int pos, int lane, bool dry) {
    float v[16]; dec16(raw, v);
    float ss = 0.f;
#pragma unroll
    for (int j = 0; j < 16; ++j) ss += v[j] * v[j];
    ss += shfl_xor_l(ss, 1, lane); ss += shfl_xor_l(ss, 2, lane); ss += shfl_xor_l(ss, 4, lane);
    const float rinv = 1.0f / sqrtf(ss * (1.f / 128.f) + LN_EPS);
    const int l8 = lane & 7;
#pragma unroll
    for (int j = 0; j < 16; ++j) v[j] = v[j] * rinv * gain[l8 * 16 + j];
    if (pos >= 0) {
        const int ti = ((l8 & 4) ? 32 + (pos & 63) : (pos >> 6)) * 32 + 16 * (l8 & 1);
#pragma unroll
        for (int j = 0; j < 16; ++j) { const float pr = shfl_xor_l(v[j], 2, lane); const float c = ropec[ti + j], sn = ropes[ti + j]; v[j] = v[j] * c + ((l8 & 2) ? pr : -pr) * sn; }
    }
    if (!(PROBE_DUP && dry)) store16(p, v);
}
__device__ __forceinline__ void prep_row(bf16_t* zr, int pos, int seqlen, bool rope, bool do_q, bool do_conv, const float* qg, const float* kg, const float* cw, const float* ropec, const float* ropes, int lane, bool dry = false) {
    const int ch = lane * 16; const bool hp = pos > 0, hn = pos < seqlen - 1;
    Raw16 rq, rk, rb, rc, ru, rcp, rup, rcn, run;
    rq = rk = rb = rc = ru = rcp = rup = rcn = run = Raw16{(u32x4){0u, 0u, 0u, 0u}, (u32x4){0u, 0u, 0u, 0u}};
    if (do_q) rq = ldraw(zr + QB0 + ch);
    if (lane < 16) rk = ldraw(zr + KB0 + ch);
    if (do_conv) { rb = ldraw(zr + CB0 + ch); rc = ldraw(zr + CC0 + ch); ru = ldraw(zr + CX0 + ch);
        if (hp) { rcp = ldraw(zr - INW + CC0 + ch); rup = ldraw(zr - INW + CX0 + ch); }
        if (hn) { rcn = ldraw(zr + INW + CC0 + ch); run = ldraw(zr + INW + CX0 + ch); } }
    asm volatile("" ::: "memory");
    if (do_q) qk_norm_rope(rq, zr + QB0 + ch, qg, ropec, ropes, rope ? pos : -1, lane, dry);
    if (lane < 16) qk_norm_rope(rk, zr + KB0 + ch, kg, ropec, ropes, rope ? pos : -1, lane, dry);
    if (do_conv) {
        float bg[16], c1[16], u1[16], accv[16];
        dec16(rb, bg); dec16(rc, c1); dec16(ru, u1);
#pragma unroll
        for (int j = 0; j < 16; ++j) accv[j] = cw[1024 + ch + j] * (c1[j] * u1[j]);
        dec16(rcp, c1); dec16(rup, u1);
#pragma unroll
        for (int j = 0; j < 16; ++j) accv[j] += cw[ch + j] * (c1[j] * u1[j]);
        dec16(rcn, c1); dec16(run, u1);
#pragma unroll
        for (int j = 0; j < 16; ++j) accv[j] += cw[2048 + ch + j] * (c1[j] * u1[j]);
#pragma unroll
        for (int j = 0; j < 16; ++j) accv[j] *= bg[j];
        if (!(PROBE_DUP && dry)) store16(zr + CB0 + ch, accv);
    }
}

typedef const __attribute__((address_space(4))) Args* KArgs;
#define PHASE_CTX \
    KArgs ap = (KArgs)__builtin_amdgcn_kernarg_segment_ptr(); asm volatile("" : "+s"(ap)); \
    const int lane = lane_id_opaque(); const int wave = wave_s; int tid = wave_s * 64 + lane; asm volatile("" : "+v"(tid)); \
    const int G = gridDim.x, bx = blockIdx.x, vcu = (G % 8 == 0) ? (bx % 8) * (G / 8) + bx / 8 : bx; \
    const int gw = vcu * 8 + wave, NGW = G * 8; \
    unsigned char* ws = ap->ws; (void)lane; (void)gw; (void)NGW;
#define WSP(T, off) ((T*)(ws + (off)))

__global__ void __launch_bounds__(512, 2) mk_fwd(Args args) {
    extern __shared__ __attribute__((aligned(16))) unsigned char lds[];
    LAS unsigned char* const ldsl = (LAS unsigned char*)lds;
    {
        const int t0 = threadIdx.x;
        for (int u = t0; u < (LDS_BYTES - LDSCTL_OFF) / 4; u += 512) ((LAS unsigned*)(ldsl + LDSCTL_OFF))[u] = 0u;
    }
    __syncthreads();
    const int wave_s = __builtin_amdgcn_readfirstlane((int)threadIdx.x >> 6);
    const int lo = args.ph_lo, hi = args.ph_hi;
    XcdBarrier bar; bar.bar = (unsigned*)(args.ws + WS_CTL) + CW_BAR; bar.x = 0; bar.st = (volatile LAS unsigned*)(ldsl + MISC_OFF + 32);
    if (hi - lo > 1) bar = xcd_barrier_post((unsigned*)(args.ws + WS_CTL) + CW_BAR, (volatile LAS unsigned*)(ldsl + MISC_OFF + 32));
    int pid = 0;
#define PHASE_BEGIN if (lo <= pid && pid < hi) { PHASE_CTX
#define PHASE_END   if (pid + 1 < hi) { xcd_barrier(bar, tid == 0); if (PROBE_DUP & 16) xcd_barrier(bar, tid == 0); } } ++pid;

    PHASE_BEGIN
    _Pragma("unroll 1") for (int rep = (PROBE_DUP & 4) ? 0 : 1; rep < 2; ++rep)
    {
        const float* c_in = ap->in[1]; const float* cctx_in = ap->in[3]; const float* w_mod = ap->in[4]; const float* b_mod = ap->in[5];
        float* MOD = WSP(float, WS_MOD); float* ROPEC = WSP(float, WS_ROPE); float* ROPES = ROPEC + 96 * 32;
        if (bx < 192) {
            const int l = bx / 96, n0 = (bx % 96) * 128;
            LAS float* cact = (LAS float*)ldsl;
            for (int i = tid; i < 17 * DM; i += 512) { const int b = i >> 11, k = i & 2047; const float v = (b < 16) ? c_in[b * DM + k] : cctx_in[k]; cact[i] = v / (1.0f + __expf(-v)); }
            __syncthreads();
            const int c4 = tid & 31, kg = tid >> 5;
            f32x4 acc[17];
#pragma unroll
            for (int b = 0; b < 17; ++b) acc[b] = (f32x4){0.f, 0.f, 0.f, 0.f};
            const float* wp = w_mod + ((size_t)l * DM + kg * 128) * MODW + n0 + 4 * c4;
            for (int kk = 0; kk < 128; kk += 4) {
                const f32x4 w0 = *(const f32x4*)(wp + (size_t)(kk + 0) * MODW), w1 = *(const f32x4*)(wp + (size_t)(kk + 1) * MODW), w2 = *(const f32x4*)(wp + (size_t)(kk + 2) * MODW), w3 = *(const f32x4*)(wp + (size_t)(kk + 3) * MODW);
#pragma unroll
                for (int b = 0; b < 17; ++b) { const f32x4 a = *(const LAS f32x4*)(cact + b * DM + kg * 128 + kk); acc[b] += w0 * a.x + w1 * a.y + w2 * a.z + w3 * a.w; }
            }
            __syncthreads();
            LAS float* part = (LAS float*)ldsl;
            const int tid2 = wave_s * 64 + lane_id_opaque(), c4b = tid2 & 31, kgb = tid2 >> 5;
#pragma unroll
            for (int b = 0; b < 17; ++b) *(LAS f32x4*)(part + (kgb * 17 + b) * 128 + 4 * c4b) = acc[b];
            __syncthreads();
            for (int o = tid2; o < 17 * 128; o += 512) { const int b = o >> 7, n = o & 127; float sacc = b_mod[l * MODW + n0 + n];
#pragma unroll
                for (int g = 0; g < 16; ++g) sacc += part[(g * 17 + b) * 128 + n];
                MOD[((size_t)l * 17 + b) * MODW + n0 + n] = sacc; }
            __syncthreads();
        } else if (bx == 192) {
            for (int i = tid; i < 96 * 32; i += 512) { const int pos = i >> 5, fi = i & 31; const float p = (float)(pos < 32 ? pos : pos - 32);
                const float freq = powf(10000.0f, -(float)(2 * fi) / 64.0f); const float ang = p * freq; ROPEC[i] = cosf(ang); ROPES[i] = sinf(ang); }
        }
        const float* w_in = ap->in[6]; const float* w_branch = ap->in[11]; const float* w_o = ap->in[12]; const float* w_up = ap->in[13]; const float* w_down = ap->in[14];
        LAS float* scr = (LAS float*)(ldsl + wave * 16384);
        constexpr int I_IN = (DM / 64) * (INW / 32), I_BR = (1024 / 64) * (DM / 32), I_O = (DM / 64) * (DM / 32), I_UP = (DM / 64) * (HID / 32), I_DN = (HID / 64) * (DM / 32);
        constexpr int I_LAYER = I_IN + 3 * I_BR + I_O + I_UP + I_DN;
        for (int it = gw; it < 2 * I_LAYER; it += NGW) {
            const int l = it / I_LAYER; int r = it - l * I_LAYER; unsigned char* wl = ws + WS_W + (size_t)l * W_LAYER;
            if (r < I_IN) { const int kb_ = r / (INW / 32), nb_ = r % (INW / 32), n0_ = 32 * nb_;
                if (n0_ >= CB0 && n0_ < G0) transpose_item(w_in + (size_t)l * DM * INW + CB0, INW, (bf16_t*)(wl + W_IN), DM, scr, kb_, nb_ - CB0 / 32, lane);
                else if ((kb_ & 1) == 0) {
                    const int row0_ = (n0_ < CB0) ? 0 : (G0 - CB0);
                    transpose_item8(w_in + (size_t)l * DM * INW, INW, wl + W_G8, DM, scr, kb_, nb_, row0_, lane); transpose_item8(w_in + (size_t)l * DM * INW, INW, wl + W_G8, DM, scr, kb_ + 1, nb_, row0_, lane); }
                continue; } r -= I_IN;
            if (r < 3 * I_BR) { const int i = r / I_BR, rr = r % I_BR; transpose_item(w_branch + ((size_t)l * 3 + i) * 1024 * DM, DM, (bf16_t*)(wl + W_BR) + i * 1024, 3072, scr, rr / (DM / 32), rr % (DM / 32), lane); continue; } r -= 3 * I_BR;
            if (r < I_O) { transpose_item(w_o + (size_t)l * DM * DM, DM, (bf16_t*)(wl + W_O), DM, scr, r / (DM / 32), r % (DM / 32), lane); continue; } r -= I_O;
            if (r < I_UP) { transpose_item(w_up + (size_t)l * DM * HID, HID, (bf16_t*)(wl + W_UP), DM, scr, r / (HID / 32), r % (HID / 32), lane); continue; } r -= I_UP;
            transpose_item(w_down + (size_t)l * HID * DM, DM, (bf16_t*)(wl + W_DN), HID, scr, r / (DM / 32), r % (DM / 32), lane);
        }
        if (PROBE_DUP & 4) __syncthreads();
    }
    PHASE_END

    PHASE_BEGIN
    {
        const float* x_in = ap->in[0]; const float* ctx_in = ap->in[2]; const float* MOD = WSP(float, WS_MOD); bf16_t* H = WSP(bf16_t, WS_H);
        const LnArgs la{MALL, x_in, ctx_in, nullptr, nullptr, H, WSP(unsigned char, WS_H8), nullptr, nullptr, nullptr, MOD, 0, 1};
        _Pragma("unroll 1") for (int rep = (PROBE_DUP & 8) ? 0 : 1; rep < 2; ++rep)
        ln_phase<0>(la, gw, NGW, lane);
    }
    PHASE_END

    for (int l = 0; l < DEPTH; ++l) {
        const bool with_ctx = (l == 0);
        for (int k = -1; k < 2; ++k) {
            PHASE_BEGIN
            {
                if (k >= 0) {
                    const int ch = k; const bool ctx_here = (ch == 0);
                GWo P; P.A_lat = WSP(bf16_t, WS_H); P.A_ctx = P.A_lat + (size_t)NLAT * DM; P.a_lat0 = 0; P.W = (const bf16_t*)(ws + WS_W + (size_t)l * W_LAYER + W_O); P.lda = DM; P.ldb = DM; P.kstepA = 128; P.kstepB = 128; P.apan = 256 * DM;
                P.res_lat = (l == 0) ? (const void*)ap->in[0] : (const void*)ap->out; P.res_ctx = ap->in[2]; P.out_lat = (half_t*)ap->out; P.out_ctx = WSP(half_t, WS_CTXS);   P.mod = WSP(float, WS_MOD) + (size_t)l * 17 * MODW; P.modj = 2;
                P.lnres = (l > 0); P.stats = WSP(float, WS_STATS); P.lg = ap->in[15] + (size_t)((l > 0 ? l - 1 : 0) * 2 + 1) * DM; P.lb = ap->in[16] + (size_t)((l > 0 ? l - 1 : 0) * 2 + 1) * DM;
                P.tp = TwoPart{ch * PAN_CH, DM / 256, (with_ctx && ctx_here) ? PAN_CTX : 0, DM / 256, 0, G, bx, PAN_LAT};
                P.dry = 0; pg8::gemm_phase<GWo>(ldsl, P, tid);
                }
                if (k + 1 < 2) {
                    const int ch = k + 1; const bool ctx_here = (ch == 0);
                    const int skn = with_ctx ? (ch == 0 ? 13 : 10) : (1 << 20), skc = with_ctx ? (ch == 0 ? 192 : 128) : 0, sks = with_ctx ? (ch == 0 ? 64 : 128) : 1;
                {
                GInProj P; P.H = WSP(bf16_t, WS_H); P.W = (const bf16_t*)(ws + WS_W + (size_t)l * W_LAYER + W_IN); P.Z = WSP(bf16_t, WS_Z); P.ZC = WSP(bf16_t, WS_ZC); P.lda = DM; P.ldb = DM; P.kstepA = 128; P.kstepB = 128; P.dry = 0;
                P.tp = TwoPart{ch * PAN_CH, NCV, (with_ctx && ctx_here) ? PAN_CTX : 0, NCV, 0, G, bx, PAN_LAT};
                int tid_c = wave_s * 64 + lane_id_opaque(); asm volatile("" : "+v"(tid_c));
                pg8::gemm_phase<GInProj>(ldsl, P, tid_c);
                }
                {
                GGate8 P; P.H8 = WSP(unsigned char, WS_H8); P.W8 = ws + WS_W + (size_t)l * W_LAYER + W_G8; P.Z = WSP(bf16_t, WS_Z); P.ZC = WSP(bf16_t, WS_ZC); P.lda = DM / 2; P.ldb = DM / 2; P.kstepA = 128; P.kstepB = 128; P.dry = 0;
                P.tp = with_ctx ? TwoPart{ch * PAN_CH, N8, ctx_here ? PAN_CTX : 0, N8, 0, G, bx, PAN_LAT}
                                : TwoPart{ch * PAN_CH, N8, PAN_CTX / 2, (CB0 - KA0) / 256, KA0 / 256, G, bx, PAN_LAT + ch * (PAN_CTX / 2)};
                P.nlo = skn; P.cbase = skc; P.span = sks;
                int tid_g = wave_s * 64 + lane_id_opaque(); asm volatile("" : "+v"(tid_g));
                pg8::gemm_phase<GGate8>(ldsl, P, tid_g);
                }
                }
            }
            PHASE_END
            if (k + 1 >= 2) break;
            const int ch = k + 1; const bool ctx_here = (ch == 0);
            PHASE_BEGIN
            {
                const float* qg = ap->in[8] + l * 128; const float* kg = ap->in[9] + l * 128; const float* cw = ap->in[10] + (size_t)l * 3 * 1024;
                const float* ROPEC = WSP(float, WS_ROPE); const float* ROPES = ROPEC + 96 * 32; bf16_t* Z = WSP(bf16_t, WS_Z); bf16_t* ZC = WSP(bf16_t, WS_ZC);
                const int nctx = with_ctx ? (ctx_here ? NCTX : 0) : NCTX / 2, ctx0 = with_ctx ? 0 : ch * (NCTX / 2);
                const int nrows = CHROWS + nctx;
                _Pragma("unroll 1") for (int rep = (PROBE_DUP & 32) ? 0 : 1; rep < 2; ++rep)
                for (int m = gw; m < nrows; m += NGW) {
                    if (m < CHROWS) prep_row(Z + (size_t)m * INW, m & 2047, SEQ, true, false, true, qg, kg, cw, ROPEC, ROPES, lane, rep == 0);
                    else { const int mc = ctx0 + m - CHROWS; prep_row(ZC + (size_t)mc * INW, mc & 255, CTXL, false, with_ctx, with_ctx, qg, kg, cw, ROPEC, ROPES, lane, rep == 0); }
                }
            }
            PHASE_END
            PHASE_BEGIN
            {
                bf16_t* Z = WSP(bf16_t, WS_Z); bf16_t* ZC = WSP(bf16_t, WS_ZC); const float* rpb = ap->in[7];
                const int n_dense = 512 + ((with_ctx && ctx_here) ? 256 : 0);
                _Pragma("unroll 1") for (int rep = (PROBE_DUP & 2) ? 0 : 1; rep < 2; ++rep) {
                for (int id = bx; id < n_dense; id += G) {
                    att::AUnit A; A.r0 = 0; A.lo = 0; A.rpb = nullptr; A.dry = (rep == 0); A.qgain = nullptr; A.ropec = nullptr; A.pos0 = 0;
                    if (id < 512) {
                        const int it = id >> 8, cc = id & 255, pair = (cc & 7) + 8 * it, j = cc >> 3;
                        const int bl = pair >> 1, qh = (pair & 1) * 4 + (j >> 3), qb = j & 7, b = ch * 8 + bl;
                        A.Q = Z + ((size_t)(bl * SEQ + qb * 256) * INW + QB0 + qh * 128);
                        A.P0 = Z + ((size_t)(bl * SEQ) * INW + KB0 + (qh >> 2) * 128); A.P1 = ZC + ((size_t)(b * CTXL) * INW + KB0 + (qh >> 2) * 128);
                        A.nfirst = 32; A.NT = 36; A.vofs = VB0 - KB0; A.qgain = ap->in[8] + l * 128; A.ropec = WSP(float, WS_ROPE); A.pos0 = qb * 256;
                    } else {
                        const int i2 = id - 512, b = i2 >> 4, hh = i2 & 15; const bf16_t* zb = ZC + (size_t)(b * CTXL) * INW;
                        if (hh < 8) { A.Q = zb + QA0 + hh * 128; A.P0 = zb + KA0 + hh * 128; A.vofs = VA0 - KA0; }
                        else { const int qh = hh - 8; A.Q = zb + QB0 + qh * 128; A.P0 = zb + KB0 + (qh >> 2) * 128; A.vofs = VB0 - KB0; }
                        A.P1 = A.P0; A.nfirst = 4; A.NT = 4;
                    }
                    att::attn_unit<false>(A, (char*)lds, ldsl, tid);
                }
                for (int id = bx; id < 512; id += G) {
                    const int it = id >> 8, cc = id & 255, pairn = (cc & 7) * 8 + 4 * it + (cc >> 6), r0 = 4 * ((cc >> 3) & 7);
                    const int bl = pairn >> 3, h = pairn & 7;
                    const int b = ch * 8 + bl; const bool edge = (r0 == 0 || r0 == 28); const int lo_ = (r0 == 0) ? 0 : (r0 == 28 ? 24 : r0 - 4);
                    att::AUnit A; A.Q = Z + ((size_t)(bl * SEQ + r0 * 64) * INW + QA0 + h * 128);
                    A.P0 = ZC + ((size_t)(b * CTXL) * INW + KA0 + h * 128); A.P1 = Z + ((size_t)(bl * SEQ + lo_ * 64) * INW + KA0 + h * 128);
                    A.nfirst = 4; A.NT = 4 + (edge ? 8 : 12); A.vofs = VA0 - KA0; A.r0 = r0; A.lo = lo_; A.rpb = rpb + ((size_t)l * 8 + h) * 15 * 31; A.dry = (rep == 0); A.qgain = nullptr; A.ropec = nullptr; A.pos0 = 0;
                    att::attn_unit<true>(A, (char*)lds, ldsl, tid);
                }
                }
            }
            PHASE_END
            PHASE_BEGIN
            {
                GBranch P; P.Z = WSP(bf16_t, WS_Z); P.ZC = WSP(bf16_t, WS_ZC); P.W = (const bf16_t*)(ws + WS_W + (size_t)l * W_LAYER + W_BR); P.Hout = WSP(bf16_t, WS_H); P.lda = INW; P.ldb = 3072; P.kstepA = 128; P.kstepB = 128;
                P.tp = TwoPart{ch * PAN_CH, DM / 256, (with_ctx && ctx_here) ? PAN_CTX : 0, DM / 256, 0, G, bx, PAN_LAT};
                _Pragma("unroll 1") for (int rep = (((PROBE_DUP & 1) != 0) && ((PROBE_GEMM_MASK & 2) != 0)) ? 0 : 1; rep < 2; ++rep) { P.dry = (rep == 0) && !PROBE_REAL; pg8::gemm_phase<GBranch>(ldsl, P, tid); }
            }
            PHASE_END
        }
        PHASE_BEGIN
        {
            const int nrows = with_ctx ? MALL : NLAT; const float* g = ap->in[15] + (size_t)(l * 2 + 0) * DM; const float* bb = ap->in[16] + (size_t)(l * 2 + 0) * DM;
            float* OUT = ap->out; float* CTXS = WSP(float, WS_CTXS); bf16_t* H = WSP(bf16_t, WS_H); const float* MODL = WSP(float, WS_MOD) + (size_t)l * 17 * MODW;
            const LnArgs la{nrows, (const void*)OUT, (const void*)CTXS, OUT, CTXS, H, nullptr, WSP(float, WS_STATS), g, bb, MODL, 3, 4};
            _Pragma("unroll 1") for (int rep = (PROBE_DUP & 64) ? 0 : 1; rep < 2; ++rep)
            ln_phase<1>(la, gw, NGW, lane);
        }
        PHASE_END
        for (int st = 0; st < 3; ++st) {
            PHASE_BEGIN
            {
                if (st >= 1) {
                    const int ch = st - 1; const bool ctx_here = (ch == 0) && with_ctx;
                GDown P; P.A_lat = WSP(bf16_t, ch == 0 ? WS_U0 : WS_U1); P.A_ctx = P.A_lat + (size_t)CHROWS * HID; P.a_lat0 = ch * PAN_CH; P.W = (const bf16_t*)(ws + WS_W + (size_t)l * W_LAYER + W_DN); P.lda = 64; P.ldb = HID; P.kstepA = 256 * 64 * 2; P.kstepB = 128; P.apan = 256 * HID;
                P.res_lat = ap->out; P.res_ctx = WSP(half_t, WS_CTXS); P.out_lat = (l + 1 < DEPTH) ? (half_t*)ap->out : WSP(half_t, WS_H); P.out_ctx = WSP(half_t, WS_CTXS);   P.mod = WSP(float, WS_MOD) + (size_t)l * 17 * MODW; P.modj = 5;
                P.lnres = 1; P.stats = WSP(float, WS_STATS); P.lg = ap->in[15] + (size_t)(l * 2 + 0) * DM; P.lb = ap->in[16] + (size_t)(l * 2 + 0) * DM;
                P.tp = TwoPart{ch * PAN_CH, DM / 256, ctx_here ? PAN_CTX : 0, DM / 256, 0, G, bx, PAN_LAT};
                P.dry = 0; pg8::gemm_phase<GDown>(ldsl, P, tid);
                }
                if (st < 2) {
                    const int ch = st; const bool ctx_here = (ch == 0) && with_ctx;
                GUp P; P.H = WSP(bf16_t, WS_H); P.W = (const bf16_t*)(ws + WS_W + (size_t)l * W_LAYER + W_UP); P.U = WSP(bf16_t, ch == 0 ? WS_U0 : WS_U1); P.lda = DM; P.ldb = DM; P.kstepA = 128; P.kstepB = 128;
                P.tp = TwoPart{ch * PAN_CH, HID / 256, ctx_here ? PAN_CTX : 0, HID / 256, 0, G, bx, PAN_LAT};
                P.dry = 0; P.nlo = (with_ctx && ch == 1) ? 6 : (1 << 20); P.cbase = 128; P.span = 128;
                int tid_u = wave_s * 64 + lane_id_opaque(); asm volatile("" : "+v"(tid_u));
                pg8::gemm_phase<GUp>(ldsl, P, tid_u);
                }
            }
            PHASE_END
        }
        PHASE_BEGIN
        {
            const int nrows = with_ctx ? MALL : NLAT; const float* g = ap->in[15] + (size_t)(l * 2 + 1) * DM; const float* bb = ap->in[16] + (size_t)(l * 2 + 1) * DM;
            float* OUT = ap->out; float* CTXS = WSP(float, WS_CTXS); bf16_t* H = WSP(bf16_t, WS_H); const float* MODN = WSP(float, WS_MOD) + (size_t)(l + 1) * 17 * MODW;
            const LnArgs la{nrows, (l + 1 < DEPTH) ? (const void*)OUT : (const void*)H, (const void*)CTXS, OUT, CTXS, H, WSP(unsigned char, WS_H8), WSP(float, WS_STATS), g, bb, MODN, 0, 1};
            if (l + 1 < DEPTH) { _Pragma("unroll 1") for (int rep = (PROBE_DUP & 64) ? 0 : 1; rep < 2; ++rep) ln_phase<1>(la, gw, NGW, lane); }
            else ln_phase<2>(la, gw, NGW, lane);
        }
        PHASE_END
    }
#undef PHASE_BEGIN
#undef PHASE_END
}
constexpr int N_PHASES = 2 + DEPTH * (3 + 2 * 3 + 1 + 3 + 1);

extern "C" void kernel_launch(void* const* d_in, const int* in_sizes, int n_in, void* d_out, int out_size, void* d_ws, size_t ws_size, hipStream_t stream) {
    static int grid = 0;
    if (grid == 0) {
        if (n_in != 17 || in_sizes[0] != NLAT * DM || out_size != NLAT * DM || ws_size < WS_END) { fprintf(stderr, "kernel_launch: shape / workspace mismatch (ws %zu, need %zu)\n", ws_size, (size_t)WS_END); grid = -1; return; }
        int dev = 0, cus = 0, per_cu = 0;
        if (hipGetDevice(&dev) != hipSuccess || hipDeviceGetAttribute(&cus, hipDeviceAttributeMultiprocessorCount, dev) != hipSuccess) { grid = -1; return; }
        if (hipFuncSetAttribute((const void*)mk_fwd, hipFuncAttributeMaxDynamicSharedMemorySize, LDS_BYTES) != hipSuccess) { fprintf(stderr, "kernel_launch: hipFuncSetAttribute failed\n"); grid = -1; return; }
        if (hipOccupancyMaxActiveBlocksPerMultiprocessor(&per_cu, (const void*)mk_fwd, 512, LDS_BYTES) != hipSuccess || per_cu < 1) fprintf(stderr, "kernel_launch: occupancy query says %d\n", per_cu);
        (void)hipGetLastError();
        if (cus != 256) { fprintf(stderr, "kernel_launch: the skewed unit deals are laid out for 256 CUs (have %d)\n", cus); grid = -1; return; }
        grid = cus;
    }
    if (grid < 0) return;
    if (hipMemsetAsync((char*)d_ws + WS_CTL, 0, CTL_ZERO_BYTES, stream) != hipSuccess) return;
    Args a{};
    for (int i = 0; i < 17; ++i) a.in[i] = (const float*)d_in[i];
    a.out = (float*)d_out; a.ws = (unsigned char*)d_ws;
#if MK_PER_PHASE
    for (int p = 0; p < N_PHASES; ++p) { a.ph_lo = p; a.ph_hi = p + 1; hipLaunchKernelGGL(mk_fwd, dim3(grid), dim3(512), LDS_BYTES, stream, a); }
#else
    a.ph_lo = 0; a.ph_hi = N_PHASES;
    hipLaunchKernelGGL(mk_fwd, dim3(grid), dim3(512), LDS_BYTES, stream, a);
#endif
    const hipError_t le = hipPeekAtLastError();
    if (le != hipSuccess) fprintf(stderr, "kernel_launch: launch failed: %s\n", hipGetErrorName(le));
}
```
